# Optimizing an MI355X kernel written in HIP

```python
import jax, jax.numpy as jnp
from jax import lax
import numpy as np

D_MODEL = 1024
BATCH = 8
SEQ = 4096
DEPTH = 2

DN_ALPHA = (2 * DEPTH) ** 0.25
DN_BETA = (8 * DEPTH) ** -0.25
LN_EPS = 1e-5
RMS_EPS = 1e-6

CONV_CH = D_MODEL // 2
CONV_WIDTH = 31

MLA_HEADS = 8
QK_NOPE = 64
QK_ROPE = 32
V_DIM = 64
Q_LORA = D_MODEL // 4
KV_LORA = D_MODEL // 8
ROPE_THETA = 10000.0

L0_IN = 2 * CONV_CH + Q_LORA + KV_LORA + QK_ROPE
L0_MIX = CONV_CH + MLA_HEADS * V_DIM

FOX_HEADS = 16
FOX_HD = D_MODEL // FOX_HEADS
L1_IN = 3 * FOX_HEADS * FOX_HD + FOX_HEADS
L1_MIX = FOX_HEADS * FOX_HD

BLOCK_Q = 128

N_EXPERTS = 64
TOP_K = 6
N_GROUPS = 8
TOPK_GROUPS = 4
EXPERT_HID = D_MODEL // 4
SHARED_HID = EXPERT_HID
ROUTED_SCALE = 2.5

kernel_name = "hybrid_conv_mla_fox_moe_deepnorm"


def layer_norm(x, g, b):
    xf = x.astype(jnp.float32)
    mu = jnp.mean(xf, axis=-1, keepdims=True)
    var = jnp.mean(jnp.square(xf - mu), axis=-1, keepdims=True)
    return ((xf - mu) * lax.rsqrt(var + LN_EPS) * g + b).astype(x.dtype)


def rms_norm(x, g):
    xf = x.astype(jnp.float32)
    return (xf * lax.rsqrt(jnp.mean(jnp.square(xf), axis=-1, keepdims=True) + RMS_EPS) * g).astype(x.dtype)


def rope(x, cos, sin):
    x1, x2 = jnp.split(x, 2, axis=-1)
    return jnp.concatenate([x1 * cos - x2 * sin, x2 * cos + x1 * sin], axis=-1)


def causal_block_attention(q, k, v, scale, log_fcum=None):
    seq = q.shape[2]
    outs = []
    for i in range(seq // BLOCK_Q):
        q0, q1 = i * BLOCK_Q, (i + 1) * BLOCK_Q
        s = jnp.einsum('bhqd,bhkd->bhqk', q[:, :, q0:q1], k[:, :, :q1],
                       preferred_element_type=jnp.float32) * scale
        if log_fcum is not None:
            s = s + (log_fcum[:, :, q0:q1, None] - log_fcum[:, :, None, :q1])
        mask = (q0 + jnp.arange(BLOCK_Q))[:, None] >= jnp.arange(q1)[None, :]
        p = jax.nn.softmax(jnp.where(mask, s, -jnp.inf), axis=-1)
        outs.append(jnp.einsum('bhqk,bhkd->bhqd', p.astype(v.dtype), v[:, :, :q1]))
    return jnp.concatenate(outs, axis=2)


def conv_mla_mixer(x, cos, sin, w_in, b_in, conv_w, conv_b, conv_ln_g, conv_ln_b,
                   q_norm_g, w_uq, kv_norm_g, w_ukv, w_out, b_out):
    bsz, seq, _ = x.shape
    h = x @ w_in + b_in
    i1 = 2 * CONV_CH
    i2 = i1 + Q_LORA
    i3 = i2 + KV_LORA
    conv_in, q_lat, kv_lat, k_rope = h[..., :i1], h[..., i1:i2], h[..., i2:i3], h[..., i3:]

    a, g = jnp.split(conv_in, 2, axis=-1)
    u = a * jax.nn.sigmoid(g)
    u = lax.conv_general_dilated(
        u, conv_w[:, None, :].astype(u.dtype), window_strides=(1,),
        padding=[(CONV_WIDTH - 1, 0)], dimension_numbers=('NWC', 'WIO', 'NWC'),
        feature_group_count=CONV_CH) + conv_b
    u = jax.nn.silu(layer_norm(u, conv_ln_g, conv_ln_b))

    q = (rms_norm(q_lat, q_norm_g) @ w_uq).reshape(bsz, seq, MLA_HEADS, QK_NOPE + QK_ROPE)
    q = jnp.concatenate([q[..., :QK_NOPE], rope(q[..., QK_NOPE:], cos, sin)], axis=-1)
    kv = (rms_norm(kv_lat, kv_norm_g) @ w_ukv).reshape(bsz, seq, MLA_HEADS, QK_NOPE + V_DIM)
    k_pe = jnp.broadcast_to(rope(k_rope[:, :, None, :], cos, sin), (bsz, seq, MLA_HEADS, QK_ROPE))
    k = jnp.concatenate([kv[..., :QK_NOPE], k_pe], axis=-1)
    v = kv[..., QK_NOPE:]
    o = causal_block_attention(q.transpose(0, 2, 1, 3), k.transpose(0, 2, 1, 3),
                               v.transpose(0, 2, 1, 3), (QK_NOPE + QK_ROPE) ** -0.5)
    o = o.transpose(0, 2, 1, 3).reshape(bsz, seq, MLA_HEADS * V_DIM)

    return jnp.concatenate([u, o], axis=-1) @ w_out + b_out


def fox_mixer(x, w_in, b_in, w_out, b_out):
    bsz, seq, _ = x.shape
    h = x @ w_in + b_in
    qkv = h[..., :3 * L1_MIX].reshape(bsz, seq, 3, FOX_HEADS, FOX_HD).transpose(2, 0, 3, 1, 4)
    log_f = jax.nn.log_sigmoid(h[..., 3 * L1_MIX:].astype(jnp.float32))
    log_fcum = jnp.cumsum(log_f, axis=1).transpose(0, 2, 1)
    o = causal_block_attention(qkv[0], qkv[1], qkv[2], FOX_HD ** -0.5, log_fcum)
    return o.transpose(0, 2, 1, 3).reshape(bsz, seq, L1_MIX) @ w_out + b_out


def moe(x, router_w, router_bias, exp_w_gate, exp_w_up, exp_w_down, sh_w_gate, sh_w_up, sh_w_down):
    bsz, seq, d = x.shape
    t = x.reshape(-1, d)
    n_tok = t.shape[0]
    s = jax.nn.sigmoid((t @ router_w).astype(jnp.float32))
    choice = s + router_bias.astype(jnp.float32)
    grp = choice.reshape(n_tok, N_GROUPS, N_EXPERTS // N_GROUPS)
    gscore = jnp.sum(lax.top_k(grp, 2)[0], axis=-1)
    _, gidx = lax.top_k(gscore, TOPK_GROUPS)
    gmask = jnp.sum(jax.nn.one_hot(gidx, N_GROUPS, dtype=jnp.float32), axis=1) > 0
    emask = jnp.repeat(gmask, N_EXPERTS // N_GROUPS, axis=-1)
    _, eidx = lax.top_k(jnp.where(emask, choice, -jnp.inf), TOP_K)
    w = jnp.take_along_axis(s, eidx, axis=-1)
    w = w / jnp.sum(w, axis=-1, keepdims=True) * ROUTED_SCALE
    gates = jnp.sum(jax.nn.one_hot(eidx, N_EXPERTS, dtype=jnp.float32) * w[..., None], axis=1)

    def expert_step(acc, p):
        wg, wu, wd, g = p
        hid = jax.nn.silu(t @ wg) * (t @ wu)
        return acc + (hid @ wd) * g[:, None].astype(t.dtype), None

    routed, _ = lax.scan(expert_step, jnp.zeros_like(t), (exp_w_gate, exp_w_up, exp_w_down, gates.T))
    shared = (jax.nn.silu(t @ sh_w_gate) * (t @ sh_w_up)) @ sh_w_down
    return (routed + shared).reshape(bsz, seq, d)


def setup_inputs(seed: int = 0) -> dict:
    key = jax.random.key(seed)
    ks = iter(jax.random.split(key, 64))

    def nrm(shape, scale):
        return jax.random.normal(next(ks), shape, jnp.float32) * scale

    def gain(n):
        return 1.0 + nrm((n,), 0.02)

    def small(n):
        return nrm((n,), 0.02)

    def moe_params(prefix):
        return {
            prefix + "router_w": nrm((D_MODEL, N_EXPERTS), D_MODEL ** -0.5),
            prefix + "router_bias": nrm((N_EXPERTS,), 0.01),
            prefix + "exp_w_gate": nrm((N_EXPERTS, D_MODEL, EXPERT_HID), D_MODEL ** -0.5),
            prefix + "exp_w_up": nrm((N_EXPERTS, D_MODEL, EXPERT_HID), D_MODEL ** -0.5),
            prefix + "exp_w_down": nrm((N_EXPERTS, EXPERT_HID, D_MODEL), EXPERT_HID ** -0.5 * DN_BETA),
            prefix + "sh_w_gate": nrm((D_MODEL, SHARED_HID), D_MODEL ** -0.5),
            prefix + "sh_w_up": nrm((D_MODEL, SHARED_HID), D_MODEL ** -0.5),
            prefix + "sh_w_down": nrm((SHARED_HID, D_MODEL), SHARED_HID ** -0.5 * DN_BETA),
            prefix + "ln2_g": gain(D_MODEL),
            prefix + "ln2_b": small(D_MODEL),
        }

    inp = {}
    inp["x"] = nrm((BATCH, SEQ, D_MODEL), 1.0)
    offset = jax.random.randint(next(ks), (BATCH, 1), 0, 1024, dtype=jnp.int32)
    inp["positions"] = offset + jnp.arange(SEQ, dtype=jnp.int32)[None, :]
    inp["l0_w_in"] = nrm((D_MODEL, L0_IN), D_MODEL ** -0.5)
    inp["l0_b_in"] = small(L0_IN)
    inp["l0_conv_w"] = nrm((CONV_WIDTH, CONV_CH), CONV_WIDTH ** -0.5)
    inp["l0_conv_b"] = small(CONV_CH)
    inp["l0_conv_ln_g"] = gain(CONV_CH)
    inp["l0_conv_ln_b"] = small(CONV_CH)
    inp["l0_q_norm_g"] = gain(Q_LORA)
    inp["l0_w_uq"] = nrm((Q_LORA, MLA_HEADS * (QK_NOPE + QK_ROPE)), Q_LORA ** -0.5)
    inp["l0_kv_norm_g"] = gain(KV_LORA)
    inp["l0_w_ukv"] = nrm((KV_LORA, MLA_HEADS * (QK_NOPE + V_DIM)), KV_LORA ** -0.5)
    inp["l0_w_out"] = nrm((L0_MIX, D_MODEL), L0_MIX ** -0.5 * DN_BETA)
    inp["l0_b_out"] = small(D_MODEL)
    inp["l0_ln1_g"] = gain(D_MODEL)
    inp["l0_ln1_b"] = small(D_MODEL)
    inp.update(moe_params("l0_"))
    inp["l1_w_in"] = nrm((D_MODEL, L1_IN), D_MODEL ** -0.5)
    inp["l1_b_in"] = small(L1_IN)
    inp["l1_w_out"] = nrm((L1_MIX, D_MODEL), L1_MIX ** -0.5 * DN_BETA)
    inp["l1_b_out"] = small(D_MODEL)
    inp["l1_ln1_g"] = gain(D_MODEL)
    inp["l1_ln1_b"] = small(D_MODEL)
    inp.update(moe_params("l1_"))
    return inp


def reference(x, positions,
              l0_w_in, l0_b_in, l0_conv_w, l0_conv_b, l0_conv_ln_g, l0_conv_ln_b,
              l0_q_norm_g, l0_w_uq, l0_kv_norm_g, l0_w_ukv, l0_w_out, l0_b_out,
              l0_ln1_g, l0_ln1_b,
              l0_router_w, l0_router_bias, l0_exp_w_gate, l0_exp_w_up, l0_exp_w_down,
              l0_sh_w_gate, l0_sh_w_up, l0_sh_w_down, l0_ln2_g, l0_ln2_b,
              l1_w_in, l1_b_in, l1_w_out, l1_b_out, l1_ln1_g, l1_ln1_b,
              l1_router_w, l1_router_bias, l1_exp_w_gate, l1_exp_w_up, l1_exp_w_down,
              l1_sh_w_gate, l1_sh_w_up, l1_sh_w_down, l1_ln2_g, l1_ln2_b):
    inv_freq = 1.0 / (ROPE_THETA ** (jnp.arange(0, QK_ROPE, 2, dtype=jnp.float32) / QK_ROPE))
    ang = positions.astype(jnp.float32)[..., None] * inv_freq
    cos = jnp.cos(ang)[:, :, None, :].astype(x.dtype)
    sin = jnp.sin(ang)[:, :, None, :].astype(x.dtype)

    mixer_params = [
        (l0_w_in, l0_b_in, l0_conv_w, l0_conv_b, l0_conv_ln_g, l0_conv_ln_b,
         l0_q_norm_g, l0_w_uq, l0_kv_norm_g, l0_w_ukv, l0_w_out, l0_b_out),
        (l1_w_in, l1_b_in, l1_w_out, l1_b_out),
    ]
    ln1 = [(l0_ln1_g, l0_ln1_b), (l1_ln1_g, l1_ln1_b)]
    moe_p = [
        (l0_router_w, l0_router_bias, l0_exp_w_gate, l0_exp_w_up, l0_exp_w_down,
         l0_sh_w_gate, l0_sh_w_up, l0_sh_w_down),
        (l1_router_w, l1_router_bias, l1_exp_w_gate, l1_exp_w_up, l1_exp_w_down,
         l1_sh_w_gate, l1_sh_w_up, l1_sh_w_down),
    ]
    ln2 = [(l0_ln2_g, l0_ln2_b), (l1_ln2_g, l1_ln2_b)]

    for layer in range(DEPTH):
        if layer % 2 == 0:
            mix = conv_mla_mixer(x, cos, sin, *mixer_params[layer])
        else:
            mix = fox_mixer(x, *mixer_params[layer])
        x = layer_norm(DN_ALPHA * x + mix, *ln1[layer])
        x = layer_norm(DN_ALPHA * x + moe(x, *moe_p[layer]), *ln2[layer])
    return x
```

```cpp
#include <hip/hip_runtime.h>
#include <cstdio>
#include <cstdint>
#include <cmath>

#define LAS __attribute__((address_space(3)))
#define DI __device__ __forceinline__
typedef unsigned short bf16_t;
typedef short bf16x8 __attribute__((ext_vector_type(8)));
typedef short s16x4 __attribute__((ext_vector_type(4)));
typedef float f32x4 __attribute__((ext_vector_type(4)));
typedef float f32x16 __attribute__((ext_vector_type(16)));
typedef unsigned u32x4 __attribute__((ext_vector_type(4)));
typedef unsigned u32x2 __attribute__((ext_vector_type(2)));
typedef float f32x2_t __attribute__((ext_vector_type(2)));
typedef __bf16 bf16x2_t __attribute__((ext_vector_type(2)));

constexpr int NTOK = 32768, DM = 1024, NBATCH = 8, SEQ = 4096;
constexpr int NEXP = 64, TOPK = 6, EHID = 256;
constexpr float ALPHA = 1.4142135623730951f;
constexpr float LN_EPS = 1e-5f, RMS_EPS = 1e-6f;
constexpr float LOG2E = 1.4426950408889634f;
constexpr float C2_MLA = 0.10206207261596577f * LOG2E;
constexpr float C2_FOX = 0.125f * LOG2E;
constexpr int N_IN0 = 1536, N_IN1 = 3328;
constexpr int LISTCAP = 32768;
constexpr int HROWS = 212992;

constexpr size_t MiB = 1u << 20;
constexpr size_t WS_CTL = 0;
constexpr size_t WS_TAB = 1 * MiB;
constexpr size_t WS_COS = 2 * MiB, WS_SIN = 4 * MiB;
constexpr size_t WS_W = 6 * MiB;
constexpr size_t W_GU = WS_W + 0, W_D = WS_W + 64 * MiB, W_RHI = WS_W + 96 * MiB, W_RLO = W_RHI + 128 * 1024,
                 W_SGU = WS_W + 97 * MiB, W_SD = WS_W + 98 * MiB, W_IN = WS_W + 99 * MiB, W_OUT = WS_W + 106 * MiB,
                 W_UQ = WS_W + 108 * MiB, W_UKV = WS_W + 108 * MiB + 512 * 1024;
constexpr size_t WS_XB = 116 * MiB;
constexpr size_t WS_BIG = 180 * MiB;
constexpr size_t B_UPRE = WS_BIG, B_QL = WS_BIG + 32 * MiB, B_KVL = WS_BIG + 48 * MiB, B_Q0 = WS_BIG + 64 * MiB, B_K0 = WS_BIG + 112 * MiB,
                 B_V0 = WS_BIG + 160 * MiB, B_UO = WS_BIG + 192 * MiB;
constexpr size_t B_Q1 = WS_BIG, B_K1 = WS_BIG + 64 * MiB, B_V1 = WS_BIG + 128 * MiB, B_O1 = WS_BIG + 192 * MiB, B_GL = WS_BIG + 256 * MiB, B_CK = WS_BIG + 258 * MiB;
constexpr size_t B_H = WS_BIG, B_SH = WS_BIG + 104 * MiB, B_YT = WS_BIG + 120 * MiB, B_LIST = WS_BIG + 312 * MiB, B_TOKW = WS_BIG + 320 * MiB;
constexpr size_t WS_END = WS_BIG + 321 * MiB;

struct Args { const void* in[42]; float* out; unsigned char* ws; };

DI unsigned pk2(float lo, float hi) { f32x2_t v = {lo, hi}; bf16x2_t b = __builtin_convertvector(v, bf16x2_t); return __builtin_bit_cast(unsigned, b); }
DI float bf2f(unsigned short b) { return __uint_as_float(((unsigned)b) << 16); }
DI unsigned short f2bf(float f) { return (unsigned short)(pk2(f, 0.f) & 0xffffu); }
DI float sigmoidf_(float x) { return 1.0f / (1.0f + __expf(-x)); }
DI float siluf_(float x) { return x * sigmoidf_(x); }
DI float wave_sum(float v) {
#pragma unroll
    for (int o = 1; o < 64; o <<= 1) v += __shfl_xor(v, o);
    return v;
}
DI int crow(int r, int hi) { return (r & 3) + 8 * (r >> 2) + 4 * hi; }
DI f32x16 mfma32(bf16x8 a, bf16x8 b, f32x16 c) { return __builtin_amdgcn_mfma_f32_32x32x16_bf16(a, b, c, 0, 0, 0); }
DI f32x4 mfma16(bf16x8 a, bf16x8 b, f32x4 c) { return __builtin_amdgcn_mfma_f32_16x16x32_bf16(a, b, c, 0, 0, 0); }
DI u32x2 pk4(f32x4 v) { u32x2 r; r.x = pk2(v[0], v[1]); r.y = pk2(v[2], v[3]); return r; }

DI int map_ident(int n) { return n; }
DI int map_gu(int n) { const int tile = n >> 8, w = n & 255, half = w >> 7, idx = tile * 128 + (w & 127); return idx | (half << 20); }
DI int map_in0(int n) {
    const int tile = n >> 8, w = n & 255;
    if (tile < 4) { const int half = w >> 7, idx = tile * 128 + (w & 127); return half * 512 + idx; }
    if (tile == 4) return 1024 + w;
    if (w < 128) return 1280 + w;
    if (w < 160) { const int i = w - 128; return 1408 + (i & 1) * 16 + (i >> 1); }
    return -1;
}
DI int map_q(int n) { const int h = n / 96, d = n % 96; if (d < 64) return h * 96 + d; const int i = d - 64; return h * 96 + 64 + (i & 1) * 16 + (i >> 1); }
DI int map_kv(int n) {
    if (n < 768) { const int h = n / 96, d = n % 96; if (d < 64) return h * 128 + d; return -2 - (128 + d - 64); }
    const int m = n - 768; return (m >> 6) * 128 + 64 + (m & 63);
}
DI int map_in1(int n) { return n < 3088 ? n : -1; }

template <class MapF>
DI void prep_item(const float* W0, const float* W1, int ldw, int Ksrc, const float* gk, bf16_t* WT, int Kout, int Nout, MapF map, LAS float* scr, int item, int lane) {
    const int nblk = Nout / 32, kb = item / nblk, nb = item % nblk, k0 = 64 * kb, n0 = 32 * nb;
    const int sc = map(n0 + (lane & 31));
    const float* W = (sc >= 0 && (sc >> 20)) ? W1 : W0; const int col = sc & 0xFFFFF;
#pragma unroll 8
    for (int i = 0; i < 32; ++i) {
        const int kk = 2 * i + (lane >> 5), k = k0 + kk; float v = 0.f;
        if (sc >= 0) { if (k < Ksrc) { v = W[(size_t)k * ldw + col]; if (gk) v *= gk[k]; } }
        else if (sc <= -2) v = (k == -2 - sc) ? 1.f : 0.f;
        scr[kk * 33 + (lane & 31)] = v;
    }
    asm volatile("s_waitcnt lgkmcnt(0)" ::: "memory");
    const int c = lane & 7;
#pragma unroll
    for (int j = 0; j < 4; ++j) {
        const int n = (lane >> 3) + 8 * j; const LAS float* s = scr + (8 * c) * 33 + n;
        u32x4 o; o.x = pk2(s[0 * 33], s[1 * 33]); o.y = pk2(s[2 * 33], s[3 * 33]); o.z = pk2(s[4 * 33], s[5 * 33]); o.w = pk2(s[6 * 33], s[7 * 33]);
        *(u32x4*)(WT + (size_t)(n0 + n) * Kout + k0 + 8 * c) = o;
    }
    asm volatile("s_waitcnt lgkmcnt(0)" ::: "memory");
}

DI void prep_moe(const Args& a, int ib, LAS float* scr, int gw, int ngw, int lane, int gtid, int gthreads) {
    unsigned char* ws = a.ws;
    constexpr int I_GU = (1024 / 64) * (512 / 32), I_D = (256 / 64) * (1024 / 32);
    const int NIT = NEXP * (I_GU + I_D) + I_GU + I_D;
    for (int it = gw; it < NIT; it += ngw) {
        int r = it;
        if (r < NEXP * I_GU) { const int e = r / I_GU; r %= I_GU;
            prep_item((const float*)a.in[ib + 2] + (size_t)e * 1024 * 256, (const float*)a.in[ib + 3] + (size_t)e * 1024 * 256, 256, 1024, nullptr, (bf16_t*)(ws + W_GU) + (size_t)e * 512 * 1024, 1024, 512, map_gu, scr, r, lane); continue; }
        r -= NEXP * I_GU;
        if (r < NEXP * I_D) { const int e = r / I_D; r %= I_D;
            prep_item((const float*)a.in[ib + 4] + (size_t)e * 256 * 1024, nullptr, 1024, 256, nullptr, (bf16_t*)(ws + W_D) + (size_t)e * 1024 * 256, 256, 1024, map_ident, scr, r, lane); continue; }
        r -= NEXP * I_D;
        if (r < I_GU) { prep_item((const float*)a.in[ib + 5], (const float*)a.in[ib + 6], 256, 1024, nullptr, (bf16_t*)(ws + W_SGU), 1024, 512, map_gu, scr, r, lane); continue; }
        r -= I_GU;
        prep_item((const float*)a.in[ib + 7], nullptr, 1024, 256, nullptr, (bf16_t*)(ws + W_SD), 256, 1024, map_ident, scr, r, lane);
    }
    const float* rw = (const float*)a.in[ib];
    bf16_t* rhi = (bf16_t*)(ws + W_RHI); bf16_t* rlo = (bf16_t*)(ws + W_RLO);
    for (int idx = gtid; idx < 64 * 1024; idx += gthreads) { const int n = idx >> 10, k = idx & 1023; const float v = rw[k * 64 + n]; const unsigned short h = f2bf(v); rhi[idx] = h; rlo[idx] = f2bf(v - bf2f(h)); }
}

constexpr int SG_LDS = 49152;
template <class Epi>
DI void sgemm_unit(LAS unsigned char* lds, const bf16_t* ap, const bf16_t* bp0, const bf16_t* bp1, int K, const Epi& epi) {
    const int tid = threadIdx.x, lane = tid & 63, wid = tid >> 6, wr = wid >> 2, wc = wid & 3, fr = lane & 15, fq = lane >> 4;
    const int sr = tid >> 2, sc = (tid & 3) * 16;
    u32x4 ra, rb0, rb1;
    f32x4 acc[4][4];
#pragma unroll
    for (int m = 0; m < 4; ++m)
#pragma unroll
        for (int n = 0; n < 4; ++n) acc[m][n] = (f32x4){0.f, 0.f, 0.f, 0.f};
    const int nk = K / 32;
    ra = *(const u32x4*)(ap); rb0 = *(const u32x4*)(bp0); rb1 = *(const u32x4*)(bp1);
    *(LAS u32x4*)(lds + sr * 64 + sc) = ra; *(LAS u32x4*)(lds + 8192 + sr * 64 + sc) = rb0; *(LAS u32x4*)(lds + 8192 + (sr + 128) * 64 + sc) = rb1;
    __syncthreads();
    for (int kt = 0; kt < nk; ++kt) {
        if (kt + 1 < nk) { ra = *(const u32x4*)(ap + (kt + 1) * 32); rb0 = *(const u32x4*)(bp0 + (kt + 1) * 32); rb1 = *(const u32x4*)(bp1 + (kt + 1) * 32); }
        LAS unsigned char* base = lds + (kt & 1) * 24576;
        bf16x8 af[4], bfr[4];
#pragma unroll
        for (int m = 0; m < 4; ++m) af[m] = *(LAS bf16x8*)(base + (64 * wr + 16 * m + fr) * 64 + fq * 16);
#pragma unroll
        for (int n = 0; n < 4; ++n) bfr[n] = *(LAS bf16x8*)(base + 8192 + ((n >> 1) * 128 + 32 * wc + 16 * (n & 1) + fr) * 64 + fq * 16);
#pragma unroll
        for (int m = 0; m < 4; ++m)
#pragma unroll
            for (int n = 0; n < 4; ++n) acc[m][n] = mfma16(bfr[n], af[m], acc[m][n]);
        if (kt + 1 < nk) {
            LAS unsigned char* nb = lds + ((kt + 1) & 1) * 24576;
            *(LAS u32x4*)(nb + sr * 64 + sc) = ra; *(LAS u32x4*)(nb + 8192 + sr * 64 + sc) = rb0; *(LAS u32x4*)(nb + 8192 + (sr + 128) * 64 + sc) = rb1;
        }
        __syncthreads();
    }
#pragma unroll
    for (int m = 0; m < 4; ++m)
#pragma unroll
        for (int nl = 0; nl < 2; ++nl) epi(64 * wr + 16 * m + fr, 32 * wc + 16 * nl + 4 * fq, acc[m][nl], acc[m][nl + 2]);
}

template <int DK, int QP, int KP, int VP, int OP, bool BIAS>
DI void attn_simple_unit(LAS unsigned char* lds, const bf16_t* Q, const bf16_t* K, const bf16_t* V, bf16_t* O, const float* CK, int b, int hq, int hv, int hc, int ho, int qb) {
    constexpr int KS = DK + 8, VS = 72;
    LAS bf16_t* Ks = (LAS bf16_t*)lds;
    LAS bf16_t* VT = (LAS bf16_t*)(lds + 64 * KS * 2);
    LAS float* ckl = (LAS float*)(lds + 64 * KS * 2 + 64 * VS * 2);
    const int tid = threadIdx.x, lane = tid & 63, wid = tid >> 6, r32 = lane & 31, hi = lane >> 5;
    const size_t rowbase = (size_t)b * SEQ; const int q0 = qb * 256, qw = q0 + 32 * wid;
    bf16x8 qr[DK / 16];
#pragma unroll
    for (int d0 = 0; d0 < DK / 16; ++d0) qr[d0] = *(const bf16x8*)(Q + (rowbase + qw + r32) * QP + hq + 16 * d0 + 8 * hi);
    f32x16 o0, o1;
#pragma unroll
    for (int i = 0; i < 16; ++i) { o0[i] = 0.f; o1[i] = 0.f; }
    float m = -INFINITY, l = 0.f;
    const int ntile = (q0 + 256) / 64;
    for (int jt = 0; jt < ntile; ++jt) {
        const int kv0 = jt * 64;
        __syncthreads();
        for (int c = tid; c < 64 * (DK / 8); c += 512) { const int r = c / (DK / 8), ch = c % (DK / 8);
            const u32x4 v = *(const u32x4*)(K + (rowbase + kv0 + r) * KP + hq + ch * 8); *(LAS u32x4*)(Ks + r * KS + ch * 8) = v; }
        { const int r = tid >> 3, ch = tid & 7; const u32x4 v = *(const u32x4*)(V + (rowbase + kv0 + r) * VP + hv + ch * 8);
#pragma unroll
          for (int i = 0; i < 4; ++i) { VT[(ch * 8 + 2 * i) * VS + r] = (bf16_t)(v[i] & 0xffffu); VT[(ch * 8 + 2 * i + 1) * VS + r] = (bf16_t)(v[i] >> 16); } }
        if (BIAS) { if (tid < 64) ckl[tid] = CK[(rowbase + kv0 + tid) * 16 + hc]; }
        __syncthreads();
        if (kv0 <= qw + 31) {
            f32x16 p0, p1;
#pragma unroll
            for (int i = 0; i < 16; ++i) { p0[i] = 0.f; p1[i] = 0.f; }
#pragma unroll
            for (int d0 = 0; d0 < DK / 16; ++d0) {
                const bf16x8 a0 = *(LAS bf16x8*)(Ks + r32 * KS + 16 * d0 + 8 * hi), a1 = *(LAS bf16x8*)(Ks + (32 + r32) * KS + 16 * d0 + 8 * hi);
                p0 = mfma32(a0, qr[d0], p0); p1 = mfma32(a1, qr[d0], p1);
            }
            if (BIAS) {
#pragma unroll
                for (int i = 0; i < 16; ++i) { p0[i] -= ckl[crow(i, hi)]; p1[i] -= ckl[32 + crow(i, hi)]; }
            }
            if (kv0 + 63 > qw) { const int q = qw + r32;
#pragma unroll
                for (int i = 0; i < 16; ++i) { const int kv = kv0 + crow(i, hi); if (kv > q) p0[i] = -INFINITY; if (kv + 32 > q) p1[i] = -INFINITY; } }
            float rm = p0[0];
#pragma unroll
            for (int i = 0; i < 16; ++i) { rm = fmaxf(rm, p0[i]); rm = fmaxf(rm, p1[i]); }
            rm = fmaxf(rm, __shfl_xor(rm, 32));
            const float mn = fmaxf(m, rm); const float f = __builtin_amdgcn_exp2f(m - mn);
            float rs = 0.f;
#pragma unroll
            for (int i = 0; i < 16; ++i) { p0[i] = __builtin_amdgcn_exp2f(p0[i] - mn); p1[i] = __builtin_amdgcn_exp2f(p1[i] - mn); rs += p0[i] + p1[i]; }
            rs += __shfl_xor(rs, 32);
            l = l * f + rs; m = mn;
#pragma unroll
            for (int i = 0; i < 16; ++i) { const float fi = __shfl(f, crow(i, hi)); o0[i] *= fi; o1[i] *= fi; }
            bf16x8 pf[4];
            { u32x4 t;
              t.x = pk2(p0[0], p0[1]); t.y = pk2(p0[2], p0[3]); t.z = pk2(p0[4], p0[5]); t.w = pk2(p0[6], p0[7]); pf[0] = __builtin_bit_cast(bf16x8, t);
              t.x = pk2(p0[8], p0[9]); t.y = pk2(p0[10], p0[11]); t.z = pk2(p0[12], p0[13]); t.w = pk2(p0[14], p0[15]); pf[1] = __builtin_bit_cast(bf16x8, t);
              t.x = pk2(p1[0], p1[1]); t.y = pk2(p1[2], p1[3]); t.z = pk2(p1[4], p1[5]); t.w = pk2(p1[6], p1[7]); pf[2] = __builtin_bit_cast(bf16x8, t);
              t.x = pk2(p1[8], p1[9]); t.y = pk2(p1[10], p1[11]); t.z = pk2(p1[12], p1[13]); t.w = pk2(p1[14], p1[15]); pf[3] = __builtin_bit_cast(bf16x8, t); }
#pragma unroll
            for (int ks = 0; ks < 4; ++ks) {
                { const s16x4 lo = *(LAS s16x4*)(VT + r32 * VS + 16 * ks + 4 * hi), hh = *(LAS s16x4*)(VT + r32 * VS + 16 * ks + 8 + 4 * hi);
                  const bf16x8 vf = __builtin_shufflevector(lo, hh, 0, 1, 2, 3, 4, 5, 6, 7); o0 = mfma32(pf[ks], vf, o0); }
                { const s16x4 lo = *(LAS s16x4*)(VT + (32 + r32) * VS + 16 * ks + 4 * hi), hh = *(LAS s16x4*)(VT + (32 + r32) * VS + 16 * ks + 8 + 4 * hi);
                  const bf16x8 vf = __builtin_shufflevector(lo, hh, 0, 1, 2, 3, 4, 5, 6, 7); o1 = mfma32(pf[ks], vf, o1); }
            }
        }
    }
    const float inv = 1.0f / l;
#pragma unroll
    for (int i = 0; i < 16; ++i) { const float ii = __shfl(inv, crow(i, hi)); const size_t row = rowbase + qw + crow(i, hi);
        O[row * OP + ho + r32] = f2bf(o0[i] * ii); O[row * OP + ho + 32 + r32] = f2bf(o1[i] * ii); }
}

DI void ln_rows(const float* src, const float* g, const float* b, float* dst, bf16_t* xb, int gw, int ngw, int lane) {
    f32x4 gv[4], bv[4];
#pragma unroll
    for (int j = 0; j < 4; ++j) { gv[j] = *(const f32x4*)(g + lane * 4 + 256 * j); bv[j] = *(const f32x4*)(b + lane * 4 + 256 * j); }
    for (int row = gw; row < NTOK; row += ngw) {
        f32x4 v[4]; float s = 0.f;
#pragma unroll
        for (int j = 0; j < 4; ++j) { v[j] = *(const f32x4*)(src + (size_t)row * DM + lane * 4 + 256 * j); s += (v[j][0] + v[j][1]) + (v[j][2] + v[j][3]); }
        const float mean = wave_sum(s) * (1.f / DM); float s2 = 0.f;
#pragma unroll
        for (int j = 0; j < 4; ++j) { v[j] = v[j] - mean; s2 += (v[j][0] * v[j][0] + v[j][1] * v[j][1]) + (v[j][2] * v[j][2] + v[j][3] * v[j][3]); }
        const float rstd = 1.0f / sqrtf(wave_sum(s2) * (1.f / DM) + LN_EPS);
#pragma unroll
        for (int j = 0; j < 4; ++j) { const f32x4 y = v[j] * rstd * gv[j] + bv[j];
            if (dst) *(f32x4*)(dst + (size_t)row * DM + lane * 4 + 256 * j) = y;
            if (xb) *(u32x2*)(xb + (size_t)row * DM + lane * 4 + 256 * j) = pk4(y); }
    }
}

DI void moe_tables(const unsigned* cnt, LAS int* tstart, LAS int* rstart, LAS int* cntl) {
    if (threadIdx.x == 0) {
        int t = 0, r = 0;
        for (int e = 0; e < NEXP; ++e) { const int c = (int)cnt[e]; cntl[e] = c; tstart[e] = t; rstart[e] = r; t += (c + 127) >> 7; r += ((c + 255) >> 8) << 8; }
        tstart[NEXP] = t; rstart[NEXP] = r;
    }
    __syncthreads();
}
DI int find_expert(const LAS int* tstart, int tile) { int e = 0;
#pragma unroll 1
    for (int s = 32; s > 0; s >>= 1) if (tstart[e + s] <= tile) e += s;
    return e; }

template <int PH> DI void run_phase(const Args& a, LAS unsigned char* lds) {
    const int tid = threadIdx.x, lane = tid & 63, wid = tid >> 6;
    const int G = gridDim.x, bid = blockIdx.x;
    const int gw = bid * 8 + wid, ngw = G * 8, gtid = bid * 512 + tid, gthreads = G * 512;
    unsigned char* ws = a.ws;
    constexpr int L = (PH >= 13) ? 1 : 0;
    constexpr int IB_MOE = L ? 32 : 16;
    unsigned* cnt = (unsigned*)(ws + WS_CTL) + 64 * L;
    bf16_t* XB = (bf16_t*)(ws + WS_XB);

    if constexpr (PH == 0) {
        LAS float* scr = (LAS float*)(lds + wid * 8448);
        constexpr int I_IN = (1024 / 64) * (N_IN0 / 32), I_UQ = (256 / 64) * (768 / 32), I_UKV = (256 / 64) * (1280 / 32), I_OUT = (1024 / 64) * (1024 / 32);
        for (int it = gw; it < I_IN + I_UQ + I_UKV + I_OUT; it += ngw) {
            int r = it;
            if (r < I_IN) { prep_item((const float*)a.in[2], nullptr, 1440, 1024, nullptr, (bf16_t*)(ws + W_IN), 1024, N_IN0, map_in0, scr, r, lane); continue; } r -= I_IN;
            if (r < I_UQ) { prep_item((const float*)a.in[9], nullptr, 768, 256, (const float*)a.in[8], (bf16_t*)(ws + W_UQ), 256, 768, map_q, scr, r, lane); continue; } r -= I_UQ;
            if (r < I_UKV) { prep_item((const float*)a.in[11], nullptr, 1024, 128, (const float*)a.in[10], (bf16_t*)(ws + W_UKV), 256, 1280, map_kv, scr, r, lane); continue; } r -= I_UKV;
            prep_item((const float*)a.in[12], nullptr, 1024, 1024, nullptr, (bf16_t*)(ws + W_OUT), 1024, 1024, map_ident, scr, r, lane);
        }
        prep_moe(a, 16, scr, gw, ngw, lane, gtid, gthreads);
        float* b0 = (float*)(ws + WS_TAB); float* b1 = (float*)(ws + WS_TAB + 8192);
        for (int n = gtid; n < N_IN0; n += gthreads) { const int s = map_in0(n); b0[n] = s >= 0 ? ((const float*)a.in[3])[s] : 0.f; }
        for (int n = gtid; n < N_IN1; n += gthreads) b1[n] = n < 3088 ? ((const float*)a.in[27])[n] : 0.f;
        float* ct = (float*)(ws + WS_COS); float* st = (float*)(ws + WS_SIN); const int* pos = (const int*)a.in[1];
        for (int idx = gtid; idx < NTOK * 16; idx += gthreads) {
            const int t = idx >> 4, p = idx & 15;
            const float inv = 1.0f / exp2f((float)p * (13.287712379549449f / 16.0f));
            const float ang = (float)pos[t] * inv;
            double rev = (double)ang * 0.15915494309189535; rev -= rint(rev);
            ct[idx] = __builtin_amdgcn_cosf((float)rev); st[idx] = __builtin_amdgcn_sinf((float)rev);
        }
        const float* x = (const float*)a.in[0];
        for (int idx = gtid; idx < NTOK * DM / 8; idx += gthreads) {
            const f32x4 v0 = *(const f32x4*)(x + (size_t)idx * 8), v1 = *(const f32x4*)(x + (size_t)idx * 8 + 4);
            u32x4 o; o.x = pk2(v0[0], v0[1]); o.y = pk2(v0[2], v0[3]); o.z = pk2(v1[0], v1[1]); o.w = pk2(v1[2], v1[3]);
            *(u32x4*)(XB + (size_t)idx * 8) = o;
        }
    }
    else if constexpr (PH == 1) {
        const bf16_t* Bt = (const bf16_t*)(ws + W_IN); const float* bias = (const float*)(ws + WS_TAB);
        bf16_t* UPRE = (bf16_t*)(ws + B_UPRE); bf16_t* QL = (bf16_t*)(ws + B_QL); bf16_t* KVL = (bf16_t*)(ws + B_KVL);
        for (int u = bid; u < 256 * 6; u += G) {
            const int mt = u / 6, nt = u % 6;
            auto epi = [&](int r, int c, f32x4 lo, f32x4 hi) {
                const size_t row = (size_t)mt * 128 + r;
                const f32x4 blo = *(const f32x4*)(bias + nt * 256 + c), bhi = *(const f32x4*)(bias + nt * 256 + 128 + c);
                lo = lo + blo; hi = hi + bhi;
                if (nt < 4) { f32x4 uu;
#pragma unroll
                    for (int i = 0; i < 4; ++i) uu[i] = lo[i] * sigmoidf_(hi[i]);
                    *(u32x2*)(UPRE + row * 512 + nt * 128 + c) = pk4(uu); }
                else if (nt == 4) { *(u32x2*)(QL + row * 256 + c) = pk4(lo); *(u32x2*)(QL + row * 256 + 128 + c) = pk4(hi); }
                else { *(u32x2*)(KVL + row * 256 + c) = pk4(lo); *(u32x2*)(KVL + row * 256 + 128 + c) = pk4(hi); }
            };
            sgemm_unit(lds, XB + ((size_t)mt * 128 + (tid >> 2)) * 1024 + (tid & 3) * 8, Bt + ((size_t)nt * 256 + (tid >> 2)) * 1024 + (tid & 3) * 8,
                       Bt + ((size_t)nt * 256 + 128 + (tid >> 2)) * 1024 + (tid & 3) * 8, 1024, epi);
        }
    }
    else if constexpr (PH == 2) {
        const bf16_t* UPRE = (const bf16_t*)(ws + B_UPRE); bf16_t* UO = (bf16_t*)(ws + B_UO);
        {
            const float* cw = (const float*)a.in[4]; const float* cb = (const float*)a.in[5]; const float* lg = (const float*)a.in[6]; const float* lb = (const float*)a.in[7];
            LAS bf16_t* U = (LAS bf16_t*)lds;
            LAS float* CO = (LAS float*)(lds + 94 * 512 * 2);
            float w[31];
#pragma unroll
            for (int j = 0; j < 31; ++j) w[j] = cw[j * 512 + tid];
            const float bch = cb[tid];
            f32x4 g0 = *(const f32x4*)(lg + lane * 8), g1 = *(const f32x4*)(lg + lane * 8 + 4), b0 = *(const f32x4*)(lb + lane * 8), b1 = *(const f32x4*)(lb + lane * 8 + 4);
            for (int u = bid; u < NTOK / 64; u += G) {
                const int tok0 = u * 64, s0 = tok0 % SEQ;
                __syncthreads();
                for (int c = tid; c < 94 * 64; c += 512) { const int r = c >> 6, ch = c & 63; const int s = s0 - 30 + r;
                    u32x4 v = (u32x4){0u, 0u, 0u, 0u}; if (s >= 0) v = *(const u32x4*)(UPRE + (size_t)(tok0 - 30 + r) * 512 + ch * 8);
                    *(LAS u32x4*)(U + r * 512 + ch * 8) = v; }
                __syncthreads();
                for (int sub = 0; sub < 4; ++sub) {
                    for (int tt = 0; tt < 16; ++tt) { const int tl = sub * 16 + tt; float acc = bch;
#pragma unroll
                        for (int j = 0; j < 31; ++j) acc += w[j] * bf2f(U[(tl + j) * 512 + tid]);
                        CO[tt * 512 + tid] = acc; }
                    __syncthreads();
#pragma unroll
                    for (int k = 0; k < 2; ++k) { const int tt = 2 * wid + k;
                        f32x4 v0 = *(LAS f32x4*)(CO + tt * 512 + lane * 8), v1 = *(LAS f32x4*)(CO + tt * 512 + lane * 8 + 4);
                        const float mean = wave_sum((v0[0] + v0[1]) + (v0[2] + v0[3]) + (v1[0] + v1[1]) + (v1[2] + v1[3])) * (1.f / 512.f);
                        v0 = v0 - mean; v1 = v1 - mean;
                        const float var = wave_sum((v0[0] * v0[0] + v0[1] * v0[1]) + (v0[2] * v0[2] + v0[3] * v0[3]) + (v1[0] * v1[0] + v1[1] * v1[1]) + (v1[2] * v1[2] + v1[3] * v1[3])) * (1.f / 512.f);
                        const float rstd = 1.0f / sqrtf(var + LN_EPS);
                        f32x4 y0 = v0 * rstd * g0 + b0, y1 = v1 * rstd * g1 + b1;
#pragma unroll
                        for (int i = 0; i < 4; ++i) { y0[i] = siluf_(y0[i]); y1[i] = siluf_(y1[i]); }
                        u32x4 o; o.x = pk2(y0[0], y0[1]); o.y = pk2(y0[2], y0[3]); o.z = pk2(y1[0], y1[1]); o.w = pk2(y1[2], y1[3]);
                        *(u32x4*)(UO + (size_t)(tok0 + sub * 16 + tt) * 1024 + lane * 8) = o; }
                    __syncthreads();
                }
            }
        }
        const float* ct = (const float*)(ws + WS_COS); const float* st = (const float*)(ws + WS_SIN);
        LAS float* rsl = (LAS float*)(lds + SG_LDS);
        {
            const bf16_t* QL = (const bf16_t*)(ws + B_QL); const bf16_t* Bt = (const bf16_t*)(ws + W_UQ); bf16_t* Q0 = (bf16_t*)(ws + B_Q0);
            for (int u = bid; u < 256 * 3; u += G) {
                const int mt = u / 3, nt = u % 3;
                __syncthreads();
                for (int rr = 0; rr < 16; ++rr) { const int r = 16 * wid + rr; const u32x2 v = *(const u32x2*)(QL + ((size_t)mt * 128 + r) * 256 + lane * 4);
                    const float x0 = bf2f(v.x & 0xffff), x1 = bf2f(v.x >> 16), x2 = bf2f(v.y & 0xffff), x3 = bf2f(v.y >> 16);
                    const float ss = wave_sum(x0 * x0 + x1 * x1 + x2 * x2 + x3 * x3); if (lane == 0) rsl[r] = 1.0f / sqrtf(ss * (1.f / 256.f) + RMS_EPS); }
                auto epi = [&](int r, int c, f32x4 lo, f32x4 hi) {
                    const size_t row = (size_t)mt * 128 + r; const float s = rsl[r];
#pragma unroll
                    for (int hh = 0; hh < 2; ++hh) { f32x4 v = (hh ? hi : lo) * s; const int col = nt * 256 + c + 128 * hh; const int d = col % 96;
                        if (d >= 64) { const int p = (d - 64) >> 1; const float c0 = ct[row * 16 + p], s0_ = st[row * 16 + p], c1 = ct[row * 16 + p + 1], s1 = st[row * 16 + p + 1];
                            const float a0 = v[0], a1 = v[1], a2 = v[2], a3 = v[3]; v[0] = a0 * c0 - a1 * s0_; v[1] = a1 * c0 + a0 * s0_; v[2] = a2 * c1 - a3 * s1; v[3] = a3 * c1 + a2 * s1; }
                        v = v * C2_MLA; *(u32x2*)(Q0 + row * 768 + col) = pk4(v); }
                };
                sgemm_unit(lds, QL + ((size_t)mt * 128 + (tid >> 2)) * 256 + (tid & 3) * 8, Bt + ((size_t)nt * 256 + (tid >> 2)) * 256 + (tid & 3) * 8,
                           Bt + ((size_t)nt * 256 + 128 + (tid >> 2)) * 256 + (tid & 3) * 8, 256, epi);
            }
        }
        {
            const bf16_t* KVL = (const bf16_t*)(ws + B_KVL); const bf16_t* Bt = (const bf16_t*)(ws + W_UKV); bf16_t* K0 = (bf16_t*)(ws + B_K0); bf16_t* V0 = (bf16_t*)(ws + B_V0);
            for (int u = bid; u < 256 * 5; u += G) {
                const int mt = u / 5, nt = u % 5;
                __syncthreads();
                for (int rr = 0; rr < 16; ++rr) { const int r = 16 * wid + rr; const unsigned v = *(const unsigned*)(KVL + ((size_t)mt * 128 + r) * 256 + lane * 2);
                    const float x0 = bf2f(v & 0xffff), x1 = bf2f(v >> 16);
                    const float ss = wave_sum(x0 * x0 + x1 * x1); if (lane == 0) rsl[r] = 1.0f / sqrtf(ss * (1.f / 128.f) + RMS_EPS); }
                auto epi = [&](int r, int c, f32x4 lo, f32x4 hi) {
                    const size_t row = (size_t)mt * 128 + r; const float s = rsl[r];
#pragma unroll
                    for (int hh = 0; hh < 2; ++hh) { f32x4 v = (hh ? hi : lo); const int col = nt * 256 + c + 128 * hh;
                        if (col < 768) { const int d = col % 96;
                            if (d >= 64) { const int p = (d - 64) >> 1; const float c0 = ct[row * 16 + p], s0_ = st[row * 16 + p], c1 = ct[row * 16 + p + 1], s1 = st[row * 16 + p + 1];
                                const float a0 = v[0], a1 = v[1], a2 = v[2], a3 = v[3]; v[0] = a0 * c0 - a1 * s0_; v[1] = a1 * c0 + a0 * s0_; v[2] = a2 * c1 - a3 * s1; v[3] = a3 * c1 + a2 * s1; }
                            else v = v * s;
                            *(u32x2*)(K0 + row * 768 + col) = pk4(v); }
                        else { v = v * s; *(u32x2*)(V0 + row * 512 + (col - 768)) = pk4(v); } }
                };
                sgemm_unit(lds, KVL + ((size_t)mt * 128 + (tid >> 2)) * 256 + (tid & 3) * 8, Bt + ((size_t)nt * 256 + (tid >> 2)) * 256 + (tid & 3) * 8,
                           Bt + ((size_t)nt * 256 + 128 + (tid >> 2)) * 256 + (tid & 3) * 8, 256, epi);
            }
        }
    }
    else if constexpr (PH == 3) {
        const bf16_t* Q0 = (const bf16_t*)(ws + B_Q0); const bf16_t* K0 = (const bf16_t*)(ws + B_K0); const bf16_t* V0 = (const bf16_t*)(ws + B_V0); bf16_t* UO = (bf16_t*)(ws + B_UO);
        for (int u = bid; u < 64 * 16; u += G) {
            const int i = u >> 8, gp = u & 255, s = gp >> 6, bh = gp & 63, base = 4 * (i >> 1) + s, qb = (i & 1) ? 15 - base : base;
            const int b = bh >> 3, h = bh & 7;
            attn_simple_unit<96, 768, 768, 512, 1024, false>(lds, Q0, K0, V0, UO, nullptr, b, h * 96, h * 64, 0, 512 + h * 64, qb);
        }
    }
    else if constexpr (PH == 4 || PH == 16) {
        const bf16_t* A = (const bf16_t*)(ws + (L ? B_O1 : B_UO)); const bf16_t* Bt = (const bf16_t*)(ws + W_OUT);
        const float* bias = (const float*)a.in[L ? 29 : 13]; const float* xres = L ? (const float*)a.out : (const float*)a.in[0]; float* pre = a.out;
        for (int u = bid; u < 256 * 4; u += G) {
            const int mt = u >> 2, nt = u & 3;
            auto epi = [&](int r, int c, f32x4 lo, f32x4 hi) {
                const size_t off = ((size_t)mt * 128 + r) * 1024 + nt * 256 + c;
                const f32x4 x0 = *(const f32x4*)(xres + off), x1 = *(const f32x4*)(xres + off + 128);
                const f32x4 b0 = *(const f32x4*)(bias + nt * 256 + c), b1 = *(const f32x4*)(bias + nt * 256 + 128 + c);
                *(f32x4*)(pre + off) = x0 * ALPHA + lo + b0; *(f32x4*)(pre + off + 128) = x1 * ALPHA + hi + b1;
            };
            sgemm_unit(lds, A + ((size_t)mt * 128 + (tid >> 2)) * 1024 + (tid & 3) * 8, Bt + ((size_t)nt * 256 + (tid >> 2)) * 1024 + (tid & 3) * 8,
                       Bt + ((size_t)nt * 256 + 128 + (tid >> 2)) * 1024 + (tid & 3) * 8, 1024, epi);
        }
    }
    else if constexpr (PH == 5 || PH == 17) {
        ln_rows(a.out, (const float*)a.in[L ? 30 : 14], (const float*)a.in[L ? 31 : 15], a.out, XB, gw, ngw, lane);
    }
    else if constexpr (PH == 6 || PH == 18) {
        {
            const float* x1 = a.out; const bf16_t* rhi = (const bf16_t*)(ws + W_RHI); const bf16_t* rlo = (const bf16_t*)(ws + W_RLO);
            const float* rbias = (const float*)a.in[IB_MOE + 1];
            int* LIST = (int*)(ws + B_LIST); float* TOKW = (float*)(ws + B_TOKW);
            LAS unsigned char* Ah = lds; LAS unsigned char* Al = lds + 8192; LAS unsigned char* Bh = lds + 16384; LAS unsigned char* Bl = lds + 20480;
            LAS float* lgl = (LAS float*)(lds + 24576);
            LAS int* lcnt = (LAS int*)(lds + 24576 + 33280);
            LAS int* lbase = lcnt + 64;
            LAS int* sel_e = lbase + 64;
            LAS int* sel_p = sel_e + 768;
            const int fr = lane & 15, fq = lane >> 4;
            const float mybias = rbias[lane];
            for (int u = bid; u < NTOK / 128; u += G) {
                const int t0 = u * 128;
                f32x4 acc[4];
#pragma unroll
                for (int n = 0; n < 4; ++n) acc[n] = (f32x4){0.f, 0.f, 0.f, 0.f};
                const int sr = tid >> 2, sc = (tid & 3) * 8;
                for (int kt = 0; kt < 32; ++kt) {
                    const f32x4 v0 = *(const f32x4*)(x1 + (size_t)(t0 + sr) * 1024 + kt * 32 + sc), v1 = *(const f32x4*)(x1 + (size_t)(t0 + sr) * 1024 + kt * 32 + sc + 4);
                    const u32x4 wv = *(const u32x4*)((tid < 256 ? rhi : rlo) + (size_t)((tid & 255) >> 2) * 1024 + kt * 32 + (tid & 3) * 8);
                    u32x4 h, lo_;
                    h.x = pk2(v0[0], v0[1]); h.y = pk2(v0[2], v0[3]); h.z = pk2(v1[0], v1[1]); h.w = pk2(v1[2], v1[3]);
                    lo_.x = pk2(v0[0] - __uint_as_float(h.x << 16), v0[1] - __uint_as_float(h.x & 0xffff0000u));
                    lo_.y = pk2(v0[2] - __uint_as_float(h.y << 16), v0[3] - __uint_as_float(h.y & 0xffff0000u));
                    lo_.z = pk2(v1[0] - __uint_as_float(h.z << 16), v1[1] - __uint_as_float(h.z & 0xffff0000u));
                    lo_.w = pk2(v1[2] - __uint_as_float(h.w << 16), v1[3] - __uint_as_float(h.w & 0xffff0000u));
                    __syncthreads();
                    *(LAS u32x4*)(Ah + sr * 64 + sc * 2) = h; *(LAS u32x4*)(Al + sr * 64 + sc * 2) = lo_;
                    *(LAS u32x4*)((tid < 256 ? Bh : Bl) + ((tid & 255) >> 2) * 64 + (tid & 3) * 16) = wv;
                    __syncthreads();
                    const bf16x8 ah = *(LAS bf16x8*)(Ah + (16 * wid + fr) * 64 + fq * 16), al = *(LAS bf16x8*)(Al + (16 * wid + fr) * 64 + fq * 16);
#pragma unroll
                    for (int n = 0; n < 4; ++n) { const bf16x8 bh = *(LAS bf16x8*)(Bh + (16 * n + fr) * 64 + fq * 16), bl = *(LAS bf16x8*)(Bl + (16 * n + fr) * 64 + fq * 16);
                        acc[n] = mfma16(bh, ah, acc[n]); acc[n] = mfma16(bh, al, acc[n]); acc[n] = mfma16(bl, ah, acc[n]); }
                }
#pragma unroll
                for (int n = 0; n < 4; ++n)
#pragma unroll
                    for (int j = 0; j < 4; ++j) lgl[(16 * wid + fr) * 65 + 16 * n + 4 * fq + j] = acc[n][j];
                if (tid < 64) lcnt[tid] = 0;
                __syncthreads();
                for (int tt = 0; tt < 16; ++tt) {
                    const int tl = 16 * wid + tt, t = t0 + tl;
                    const float sg = sigmoidf_(lgl[tl * 65 + lane]); const float ch = sg + mybias;
                    const int g = lane >> 3; int rk = 0;
#pragma unroll
                    for (int jj = 0; jj < 8; ++jj) { const int oj = (lane & ~7) + jj; const float o = __shfl(ch, oj); rk += ((o > ch) || (o == ch && oj < lane)) ? 1 : 0; }
                    float top = rk < 2 ? ch : 0.f; top += __shfl_xor(top, 1); top += __shfl_xor(top, 2); top += __shfl_xor(top, 4);
                    int grk = 0;
#pragma unroll
                    for (int gg = 0; gg < 8; ++gg) { const float o = __shfl(top, gg * 8); grk += ((o > top) || (o == top && gg < g)) ? 1 : 0; }
                    const bool gsel = grk < 4; const float mv = gsel ? ch : -INFINITY; int erk = 0;
#pragma unroll 8
                    for (int j = 0; j < 64; ++j) { const float o = __shfl(mv, j); erk += ((o > mv) || (o == mv && j < lane)) ? 1 : 0; }
                    const bool sel = gsel && erk < TOPK;
                    const float tot = wave_sum(sel ? sg : 0.f); const float w = sg / tot * 2.5f;
                    if (sel) { const int lp = __hip_atomic_fetch_add(lcnt + lane, 1, __ATOMIC_RELAXED, __HIP_MEMORY_SCOPE_WORKGROUP);
                        sel_e[tl * 6 + erk] = lane; sel_p[tl * 6 + erk] = lp; TOKW[(size_t)t * 8 + erk] = w; }
                }
                __syncthreads();
                if (tid < 64) { const int c = lcnt[tid]; lbase[tid] = c ? (int)atomicAdd(cnt + tid, (unsigned)c) : 0; }
                __syncthreads();
                for (int idx = tid; idx < 768; idx += 512) { const int e = sel_e[idx], pos = lbase[e] + sel_p[idx], tl = idx / 6, j = idx % 6; LIST[(size_t)e * LISTCAP + pos] = ((t0 + tl) << 3) | j; }
                __syncthreads();
            }
        }
        {
            const bf16_t* Bt = (const bf16_t*)(ws + W_SGU); bf16_t* SH = (bf16_t*)(ws + B_SH);
            for (int u = bid; u < 256 * 2; u += G) {
                const int mt = u >> 1, nt = u & 1;
                auto epi = [&](int r, int c, f32x4 lo, f32x4 hi) { f32x4 h;
#pragma unroll
                    for (int i = 0; i < 4; ++i) h[i] = siluf_(lo[i]) * hi[i];
                    *(u32x2*)(SH + ((size_t)mt * 128 + r) * 256 + nt * 128 + c) = pk4(h); };
                sgemm_unit(lds, XB + ((size_t)mt * 128 + (tid >> 2)) * 1024 + (tid & 3) * 8, Bt + ((size_t)nt * 256 + (tid >> 2)) * 1024 + (tid & 3) * 8,
                           Bt + ((size_t)nt * 256 + 128 + (tid >> 2)) * 1024 + (tid & 3) * 8, 1024, epi);
            }
        }
    }
    else if constexpr (PH == 7 || PH == 19) {
        LAS int* tstart = (LAS int*)(lds + SG_LDS); LAS int* rstart = tstart + 65; LAS int* cntl = rstart + 65;
        moe_tables(cnt, tstart, rstart, cntl);
        const int* LIST = (const int*)(ws + B_LIST); const bf16_t* Wgu = (const bf16_t*)(ws + W_GU); bf16_t* H = (bf16_t*)(ws + B_H);
        const int nunits = tstart[NEXP] * 2;
        for (int u = bid; u < nunits; u += G) {
            const int tile = u >> 1, nt = u & 1, e = find_expert(tstart, tile), i0 = (tile - tstart[e]) * 128, ce = cntl[e], r0 = rstart[e] + i0;
            const int myi = i0 + (tid >> 2); const int tok = myi < ce ? (LIST[(size_t)e * LISTCAP + myi] >> 3) : 0;
            const bf16_t* Bt = Wgu + ((size_t)e * 512 + nt * 256) * 1024;
            auto epi = [&](int r, int c, f32x4 lo, f32x4 hi) { f32x4 h;
#pragma unroll
                for (int i = 0; i < 4; ++i) h[i] = siluf_(lo[i]) * hi[i];
                *(u32x2*)(H + (size_t)(r0 + r) * 256 + nt * 128 + c) = pk4(h); };
            sgemm_unit(lds, XB + (size_t)tok * 1024 + (tid & 3) * 8, Bt + (size_t)(tid >> 2) * 1024 + (tid & 3) * 8, Bt + (size_t)(128 + (tid >> 2)) * 1024 + (tid & 3) * 8, 1024, epi);
        }
    }
    else if constexpr (PH == 8 || PH == 10 || PH == 20 || PH == 22) {
        constexpr int P = (PH == 10 || PH == 22) ? 1 : 0;
        LAS int* tstart = (LAS int*)(lds + SG_LDS); LAS int* rstart = tstart + 65; LAS int* cntl = rstart + 65;
        moe_tables(cnt, tstart, rstart, cntl);
        const int* LIST = (const int*)(ws + B_LIST); const float* TOKW = (const float*)(ws + B_TOKW); const bf16_t* Wd = (const bf16_t*)(ws + W_D);
        const bf16_t* H = (const bf16_t*)(ws + B_H); bf16_t* YT = (bf16_t*)(ws + B_YT);
        const int nunits = tstart[NEXP] * 2;
        for (int u = bid; u < nunits; u += G) {
            const int tile = u >> 1, nt = u & 1, e = find_expert(tstart, tile), i0 = (tile - tstart[e]) * 128, ce = cntl[e], r0 = rstart[e] + i0;
            const bf16_t* Bt = Wd + ((size_t)e * 1024 + 512 * P + nt * 256) * 256;
            auto epi = [&](int r, int c, f32x4 lo, f32x4 hi) {
                if (i0 + r < ce) { const int v = LIST[(size_t)e * LISTCAP + i0 + r]; const float w = TOKW[v]; const size_t dst = ((size_t)(v >> 3) * 6 + (v & 7)) * 512 + nt * 256 + c;
                    *(u32x2*)(YT + dst) = pk4(lo * w); *(u32x2*)(YT + dst + 128) = pk4(hi * w); } };
            sgemm_unit(lds, H + (size_t)(r0 + (tid >> 2)) * 256 + (tid & 3) * 8, Bt + (size_t)(tid >> 2) * 256 + (tid & 3) * 8, Bt + (size_t)(128 + (tid >> 2)) * 256 + (tid & 3) * 8, 256, epi);
        }
    }
    else if constexpr (PH == 9 || PH == 11 || PH == 21 || PH == 23) {
        constexpr int P = (PH == 11 || PH == 23) ? 1 : 0;
        const bf16_t* SH = (const bf16_t*)(ws + B_SH); const bf16_t* Wsd = (const bf16_t*)(ws + W_SD); const bf16_t* YT = (const bf16_t*)(ws + B_YT); float* xo = a.out;
        for (int u = bid; u < 256 * 2; u += G) {
            const int mt = u >> 1, nt = u & 1;
            const bf16_t* Bt = Wsd + ((size_t)512 * P + nt * 256) * 256;
            auto epi = [&](int r, int c, f32x4 lo, f32x4 hi) {
                const size_t row = (size_t)mt * 128 + r; const size_t off = row * 1024 + 512 * P + nt * 256 + c;
                f32x4 a0 = *(const f32x4*)(xo + off) * ALPHA + lo, a1 = *(const f32x4*)(xo + off + 128) * ALPHA + hi;
#pragma unroll
                for (int j = 0; j < 6; ++j) { const u32x2 y0 = *(const u32x2*)(YT + (row * 6 + j) * 512 + nt * 256 + c), y1 = *(const u32x2*)(YT + (row * 6 + j) * 512 + nt * 256 + c + 128);
                    a0[0] += __uint_as_float(y0.x << 16); a0[1] += __uint_as_float(y0.x & 0xffff0000u); a0[2] += __uint_as_float(y0.y << 16); a0[3] += __uint_as_float(y0.y & 0xffff0000u);
                    a1[0] += __uint_as_float(y1.x << 16); a1[1] += __uint_as_float(y1.x & 0xffff0000u); a1[2] += __uint_as_float(y1.y << 16); a1[3] += __uint_as_float(y1.y & 0xffff0000u); }
                *(f32x4*)(xo + off) = a0; *(f32x4*)(xo + off + 128) = a1;
            };
            sgemm_unit(lds, SH + ((size_t)mt * 128 + (tid >> 2)) * 256 + (tid & 3) * 8, Bt + (size_t)(tid >> 2) * 256 + (tid & 3) * 8, Bt + (size_t)(128 + (tid >> 2)) * 256 + (tid & 3) * 8, 256, epi);
        }
    }
    else if constexpr (PH == 12) {
        ln_rows(a.out, (const float*)a.in[24], (const float*)a.in[25], a.out, XB, gw, ngw, lane);
        LAS float* scr = (LAS float*)(lds + wid * 8448);
        constexpr int I_IN = (1024 / 64) * (N_IN1 / 32), I_OUT = (1024 / 64) * (1024 / 32);
        for (int it = gw; it < I_IN + I_OUT; it += ngw) {
            int r = it;
            if (r < I_IN) { prep_item((const float*)a.in[26], nullptr, 3088, 1024, nullptr, (bf16_t*)(ws + W_IN), 1024, N_IN1, map_in1, scr, r, lane); continue; } r -= I_IN;
            prep_item((const float*)a.in[28], nullptr, 1024, 1024, nullptr, (bf16_t*)(ws + W_OUT), 1024, 1024, map_ident, scr, r, lane);
        }
        prep_moe(a, 32, scr, gw, ngw, lane, gtid, gthreads);
    }
    else if constexpr (PH == 13) {
        const bf16_t* Bt = (const bf16_t*)(ws + W_IN); const float* bias = (const float*)(ws + WS_TAB + 8192);
        bf16_t* Q1 = (bf16_t*)(ws + B_Q1); bf16_t* K1 = (bf16_t*)(ws + B_K1); bf16_t* V1 = (bf16_t*)(ws + B_V1); float* GL = (float*)(ws + B_GL);
        for (int u = bid; u < 256 * 13; u += G) {
            const int mt = u / 13, nt = u % 13;
            auto epi = [&](int r, int c, f32x4 lo, f32x4 hi) {
                const size_t row = (size_t)mt * 128 + r;
                lo = lo + *(const f32x4*)(bias + nt * 256 + c); hi = hi + *(const f32x4*)(bias + nt * 256 + 128 + c);
                if (nt < 4) { *(u32x2*)(Q1 + row * 1024 + nt * 256 + c) = pk4(lo * C2_FOX); *(u32x2*)(Q1 + row * 1024 + nt * 256 + 128 + c) = pk4(hi * C2_FOX); }
                else if (nt < 8) { *(u32x2*)(K1 + row * 1024 + (nt - 4) * 256 + c) = pk4(lo); *(u32x2*)(K1 + row * 1024 + (nt - 4) * 256 + 128 + c) = pk4(hi); }
                else if (nt < 12) { *(u32x2*)(V1 + row * 1024 + (nt - 8) * 256 + c) = pk4(lo); *(u32x2*)(V1 + row * 1024 + (nt - 8) * 256 + 128 + c) = pk4(hi); }
                else if (c < 16) { f32x4 o;
#pragma unroll
                    for (int i = 0; i < 4; ++i) { const float x = lo[i]; o[i] = fminf(x, 0.f) - log1pf(__expf(-fabsf(x))); }
                    *(f32x4*)(GL + row * 16 + c) = o; }
            };
            sgemm_unit(lds, XB + ((size_t)mt * 128 + (tid >> 2)) * 1024 + (tid & 3) * 8, Bt + ((size_t)nt * 256 + (tid >> 2)) * 1024 + (tid & 3) * 8,
                       Bt + ((size_t)nt * 256 + 128 + (tid >> 2)) * 1024 + (tid & 3) * 8, 1024, epi);
        }
    }
    else if constexpr (PH == 14) {
        const float* GL = (const float*)(ws + B_GL); float* CK = (float*)(ws + B_CK);
        for (int sq = gw; sq < NBATCH * 16; sq += ngw) {
            const int b = sq >> 4, h = sq & 15; float carry = 0.f;
            for (int i = 0; i < SEQ / 64; ++i) { const size_t t = (size_t)b * SEQ + i * 64 + lane; float v = GL[t * 16 + h];
#pragma unroll
                for (int o = 1; o < 64; o <<= 1) { const float n = __shfl_up(v, o); if (lane >= o) v += n; }
                v += carry; CK[t * 16 + h] = v * LOG2E; carry = __shfl(v, 63); }
        }
    }
    else if constexpr (PH == 15) {
        const bf16_t* Q1 = (const bf16_t*)(ws + B_Q1); const bf16_t* K1 = (const bf16_t*)(ws + B_K1); const bf16_t* V1 = (const bf16_t*)(ws + B_V1); bf16_t* O1 = (bf16_t*)(ws + B_O1);
        const float* CK = (const float*)(ws + B_CK);
        for (int u = bid; u < 128 * 16; u += G) {
            const int i = u >> 8, gp = u & 255, s = gp >> 7, bh = gp & 127, base = 2 * (i >> 1) + s, qb = (i & 1) ? 15 - base : base;
            const int b = bh >> 4, h = bh & 15;
            attn_simple_unit<64, 1024, 1024, 1024, 1024, true>(lds, Q1, K1, V1, O1, CK, b, h * 64, h * 64, h, h * 64, qb);
        }
    }
    else if constexpr (PH == 24) {
        ln_rows(a.out, (const float*)a.in[40], (const float*)a.in[41], a.out, nullptr, gw, ngw, lane);
    }
}

constexpr int LDS_BYTES = 147456;
template <int PH> __global__ void __launch_bounds__(512, 2) k_phase(Args a) {
    extern __shared__ __attribute__((aligned(16))) unsigned char lds_raw[];
    run_phase<PH>(a, (LAS unsigned char*)lds_raw);
}

template <int PH> static void launch_phase(const Args& a, int grid, hipStream_t stream) {
    static bool attr_done = false;
    if (!attr_done) { (void)hipFuncSetAttribute((const void*)k_phase<PH>, hipFuncAttributeMaxDynamicSharedMemorySize, LDS_BYTES); attr_done = true; }
    hipLaunchKernelGGL(k_phase<PH>, dim3(grid), dim3(512), LDS_BYTES, stream, a);
}
template <int PH, int END> struct Seq { static void run(const Args& a, int grid, hipStream_t s) { launch_phase<PH>(a, grid, s); Seq<PH + 1, END>::run(a, grid, s); } };
template <int END> struct Seq<END, END> { static void run(const Args&, int, hipStream_t) {} };

extern "C" void kernel_launch(void* const* d_in, const int* in_sizes, int n_in, void* d_out, int out_size, void* d_ws, size_t ws_size, hipStream_t stream) {
    if (n_in != 42 || out_size != NTOK * DM || ws_size < WS_END) { fprintf(stderr, "kernel_launch: unexpected shapes (n_in %d, out %d, ws %zu < %zu)\n", n_in, out_size, ws_size, (size_t)WS_END); return; }
    (void)hipMemsetAsync((char*)d_ws + WS_CTL, 0, 1 * MiB, stream);
    Args a{};
    for (int i = 0; i < 42; ++i) a.in[i] = d_in[i];
    a.out = (float*)d_out; a.ws = (unsigned char*)d_ws;
    Seq<0, 25>::run(a, 256, stream);
}
```

```cpp
#include <hip/hip_runtime.h>
#include <cstdio>
#include <cstdint>
#include <cmath>

#define LAS __attribute__((address_space(3)))
#define DI __device__ __forceinline__
typedef unsigned short bf16_t;
typedef short bf16x8 __attribute__((ext_vector_type(8)));
typedef short s16x4 __attribute__((ext_vector_type(4)));
typedef float f32x4 __attribute__((ext_vector_type(4)));
typedef float f32x16 __attribute__((ext_vector_type(16)));
typedef unsigned u32x4 __attribute__((ext_vector_type(4)));
typedef unsigned u32x2 __attribute__((ext_vector_type(2)));
typedef float f32x2_t __attribute__((ext_vector_type(2)));
typedef __bf16 bf16x2_t __attribute__((ext_vector_type(2)));

constexpr int NTOK = 32768, DM = 1024, NBATCH = 8, SEQ = 4096;
constexpr int NEXP = 64, TOPK = 6, EHID = 256;
constexpr float ALPHA = 1.4142135623730951f;
constexpr float LN_EPS = 1e-5f, RMS_EPS = 1e-6f;
constexpr float LOG2E = 1.4426950408889634f;
constexpr float C2_MLA = 0.10206207261596577f * LOG2E;
constexpr float C2_FOX = 0.125f * LOG2E;
constexpr int N_IN0 = 1536, N_IN1 = 3328;
constexpr int LISTCAP = 32768;
constexpr int HROWS = 212992;

constexpr size_t MiB = 1u << 20;
constexpr size_t WS_CTL = 0;
constexpr size_t WS_TAB = 1 * MiB;
constexpr size_t WS_COS = 2 * MiB, WS_SIN = 4 * MiB;
constexpr size_t WS_W = 6 * MiB;
constexpr size_t W_GU = WS_W + 0, W_D = WS_W + 64 * MiB, W_RHI = WS_W + 96 * MiB, W_RLO = W_RHI + 128 * 1024,
                 W_SGU = WS_W + 97 * MiB, W_SD = WS_W + 98 * MiB, W_IN = WS_W + 99 * MiB, W_OUT = WS_W + 106 * MiB,
                 W_UQ = WS_W + 108 * MiB, W_UKV = WS_W + 108 * MiB + 512 * 1024;
constexpr size_t WS_XB = 116 * MiB;
constexpr size_t WS_BIG = 180 * MiB;
constexpr size_t B_UPRE = WS_BIG, B_QL = WS_BIG + 32 * MiB, B_KVL = WS_BIG + 48 * MiB, B_Q0 = WS_BIG + 64 * MiB, B_K0 = WS_BIG + 112 * MiB,
                 B_V0 = WS_BIG + 160 * MiB, B_UO = WS_BIG + 192 * MiB;
constexpr size_t B_Q1 = WS_BIG, B_K1 = WS_BIG + 64 * MiB, B_V1 = WS_BIG + 128 * MiB, B_O1 = WS_BIG + 192 * MiB, B_GL = WS_BIG + 256 * MiB, B_CK = WS_BIG + 258 * MiB;
constexpr size_t B_H = WS_BIG, B_SH = WS_BIG + 104 * MiB, B_YT = WS_BIG + 120 * MiB, B_LIST = WS_BIG + 312 * MiB, B_TOKW = WS_BIG + 320 * MiB;
constexpr size_t WS_END = WS_BIG + 321 * MiB;

struct Args { const void* in[42]; float* out; unsigned char* ws; };

DI unsigned pk2(float lo, float hi) { f32x2_t v = {lo, hi}; bf16x2_t b = __builtin_convertvector(v, bf16x2_t); return __builtin_bit_cast(unsigned, b); }
DI float bf2f(unsigned short b) { return __uint_as_float(((unsigned)b) << 16); }
DI unsigned short f2bf(float f) { return (unsigned short)(pk2(f, 0.f) & 0xffffu); }
DI float sigmoidf_(float x) { return 1.0f / (1.0f + __expf(-x)); }
DI float siluf_(float x) { return x * sigmoidf_(x); }
DI float wave_sum(float v) {
#pragma unroll
    for (int o = 1; o < 64; o <<= 1) v += __shfl_xor(v, o);
    return v;
}
DI int crow(int r, int hi) { return (r & 3) + 8 * (r >> 2) + 4 * hi; }
DI f32x16 mfma32(bf16x8 a, bf16x8 b, f32x16 c) { return __builtin_amdgcn_mfma_f32_32x32x16_bf16(a, b, c, 0, 0, 0); }
DI f32x4 mfma16(bf16x8 a, bf16x8 b, f32x4 c) { return __builtin_amdgcn_mfma_f32_16x16x32_bf16(a, b, c, 0, 0, 0); }
DI u32x2 pk4(f32x4 v) { u32x2 r; r.x = pk2(v[0], v[1]); r.y = pk2(v[2], v[3]); return r; }

DI int map_ident(int n) { return n; }
DI int map_gu(int n) { const int tile = n >> 8, w = n & 255, half = w >> 7, idx = tile * 128 + (w & 127); return idx | (half << 20); }
DI int map_in0(int n) {
    const int tile = n >> 8, w = n & 255;
    if (tile < 4) { const int half = w >> 7, idx = tile * 128 + (w & 127); return half * 512 + idx; }
    if (tile == 4) return 1024 + w;
    if (w < 128) return 1280 + w;
    if (w < 160) { const int i = w - 128; return 1408 + (i & 1) * 16 + (i >> 1); }
    return -1;
}
DI int map_q(int n) { const int h = n / 96, d = n % 96; if (d < 64) return h * 96 + d; const int i = d - 64; return h * 96 + 64 + (i & 1) * 16 + (i >> 1); }
DI int map_kv(int n) {
    if (n < 768) { const int h = n / 96, d = n % 96; if (d < 64) return h * 128 + d; return -2 - (128 + d - 64); }
    const int m = n - 768; return (m >> 6) * 128 + 64 + (m & 63);
}
DI int map_in1(int n) { return n < 3088 ? n : -1; }

template <class MapF>
DI void prep_item(const float* W0, const float* W1, int ldw, int Ksrc, const float* gk, bf16_t* WT, int Kout, int Nout, MapF map, LAS float* scr, int item, int lane) {
    const int nblk = Nout / 32, kb = item / nblk, nb = item % nblk, k0 = 64 * kb, n0 = 32 * nb;
    const int sc = map(n0 + (lane & 31));
    const float* W = (sc >= 0 && (sc >> 20)) ? W1 : W0; const int col = sc & 0xFFFFF;
#pragma unroll 8
    for (int i = 0; i < 32; ++i) {
        const int kk = 2 * i + (lane >> 5), k = k0 + kk; float v = 0.f;
        if (sc >= 0) { if (k < Ksrc) { v = W[(size_t)k * ldw + col]; if (gk) v *= gk[k]; } }
        else if (sc <= -2) v = (k == -2 - sc) ? 1.f : 0.f;
        scr[kk * 33 + (lane & 31)] = v;
    }
    asm volatile("s_waitcnt lgkmcnt(0)" ::: "memory");
    const int c = lane & 7;
#pragma unroll
    for (int j = 0; j < 4; ++j) {
        const int n = (lane >> 3) + 8 * j; const LAS float* s = scr + (8 * c) * 33 + n;
        u32x4 o; o.x = pk2(s[0 * 33], s[1 * 33]); o.y = pk2(s[2 * 33], s[3 * 33]); o.z = pk2(s[4 * 33], s[5 * 33]); o.w = pk2(s[6 * 33], s[7 * 33]);
        *(u32x4*)(WT + (size_t)(n0 + n) * Kout + k0 + 8 * c) = o;
    }
    asm volatile("s_waitcnt lgkmcnt(0)" ::: "memory");
}

DI void prep_moe(const Args& a, int ib, LAS float* scr, int gw, int ngw, int lane, int gtid, int gthreads) {
    unsigned char* ws = a.ws;
    constexpr int I_GU = (1024 / 64) * (512 / 32), I_D = (256 / 64) * (1024 / 32);
    const int NIT = NEXP * (I_GU + I_D) + I_GU + I_D;
    for (int it = gw; it < NIT; it += ngw) {
        int r = it;
        if (r < NEXP * I_GU) { const int e = r / I_GU; r %= I_GU;
            prep_item((const float*)a.in[ib + 2] + (size_t)e * 1024 * 256, (const float*)a.in[ib + 3] + (size_t)e * 1024 * 256, 256, 1024, nullptr, (bf16_t*)(ws + W_GU) + (size_t)e * 512 * 1024, 1024, 512, map_gu, scr, r, lane); continue; }
        r -= NEXP * I_GU;
        if (r < NEXP * I_D) { const int e = r / I_D; r %= I_D;
            prep_item((const float*)a.in[ib + 4] + (size_t)e * 256 * 1024, nullptr, 1024, 256, nullptr, (bf16_t*)(ws + W_D) + (size_t)e * 1024 * 256, 256, 1024, map_ident, scr, r, lane); continue; }
        r -= NEXP * I_D;
        if (r < I_GU) { prep_item((const float*)a.in[ib + 5], (const float*)a.in[ib + 6], 256, 1024, nullptr, (bf16_t*)(ws + W_SGU), 1024, 512, map_gu, scr, r, lane); continue; }
        r -= I_GU;
        prep_item((const float*)a.in[ib + 7], nullptr, 1024, 256, nullptr, (bf16_t*)(ws + W_SD), 256, 1024, map_ident, scr, r, lane);
    }
    const float* rw = (const float*)a.in[ib];
    bf16_t* rhi = (bf16_t*)(ws + W_RHI); bf16_t* rlo = (bf16_t*)(ws + W_RLO);
    for (int idx = gtid; idx < 64 * 1024; idx += gthreads) { const int n = idx >> 10, k = idx & 1023; const float v = rw[k * 64 + n]; const unsigned short h = f2bf(v); rhi[idx] = h; rlo[idx] = f2bf(v - bf2f(h)); }
}

constexpr int SG_LDS = 49152;
template <class Epi>
DI void sgemm_unit(LAS unsigned char* lds, const bf16_t* ap, const bf16_t* bp0, const bf16_t* bp1, int K, const Epi& epi) {
    const int tid = threadIdx.x, lane = tid & 63, wid = tid >> 6, wr = wid >> 2, wc = wid & 3, fr = lane & 15, fq = lane >> 4;
    const int sr = tid >> 2, sc = (tid & 3) * 16;
    u32x4 ra, rb0, rb1;
    f32x4 acc[4][4];
#pragma unroll
    for (int m = 0; m < 4; ++m)
#pragma unroll
        for (int n = 0; n < 4; ++n) acc[m][n] = (f32x4){0.f, 0.f, 0.f, 0.f};
    const int nk = K / 32;
    ra = *(const u32x4*)(ap); rb0 = *(const u32x4*)(bp0); rb1 = *(const u32x4*)(bp1);
    *(LAS u32x4*)(lds + sr * 64 + sc) = ra; *(LAS u32x4*)(lds + 8192 + sr * 64 + sc) = rb0; *(LAS u32x4*)(lds + 8192 + (sr + 128) * 64 + sc) = rb1;
    __syncthreads();
    for (int kt = 0; kt < nk; ++kt) {
        if (kt + 1 < nk) { ra = *(const u32x4*)(ap + (kt + 1) * 32); rb0 = *(const u32x4*)(bp0 + (kt + 1) * 32); rb1 = *(const u32x4*)(bp1 + (kt + 1) * 32); }
        LAS unsigned char* base = lds + (kt & 1) * 24576;
        bf16x8 af[4], bfr[4];
#pragma unroll
        for (int m = 0; m < 4; ++m) af[m] = *(LAS bf16x8*)(base + (64 * wr + 16 * m + fr) * 64 + fq * 16);
#pragma unroll
        for (int n = 0; n < 4; ++n) bfr[n] = *(LAS bf16x8*)(base + 8192 + ((n >> 1) * 128 + 32 * wc + 16 * (n & 1) + fr) * 64 + fq * 16);
#pragma unroll
        for (int m = 0; m < 4; ++m)
#pragma unroll
            for (int n = 0; n < 4; ++n) acc[m][n] = mfma16(bfr[n], af[m], acc[m][n]);
        if (kt + 1 < nk) {
            LAS unsigned char* nb = lds + ((kt + 1) & 1) * 24576;
            *(LAS u32x4*)(nb + sr * 64 + sc) = ra; *(LAS u32x4*)(nb + 8192 + sr * 64 + sc) = rb0; *(LAS u32x4*)(nb + 8192 + (sr + 128) * 64 + sc) = rb1;
        }
        __syncthreads();
    }
#pragma unroll
    for (int m = 0; m < 4; ++m)
#pragma unroll
        for (int nl = 0; nl < 2; ++nl) epi(64 * wr + 16 * m + fr, 32 * wc + 16 * nl + 4 * fq, acc[m][nl], acc[m][nl + 2]);
}

template <int DK, int QP, int KP, int VP, int OP, bool BIAS>
DI void attn_simple_unit(LAS unsigned char* lds, const bf16_t* Q, const bf16_t* K, const bf16_t* V, bf16_t* O, const float* CK, int b, int hq, int hv, int hc, int ho, int qb) {
    constexpr int KS = DK + 8, VS = 72;
    LAS bf16_t* Ks = (LAS bf16_t*)lds;
    LAS bf16_t* VT = (LAS bf16_t*)(lds + 64 * KS * 2);
    LAS float* ckl = (LAS float*)(lds + 64 * KS * 2 + 64 * VS * 2);
    const int tid = threadIdx.x, lane = tid & 63, wid = tid >> 6, r32 = lane & 31, hi = lane >> 5;
    const size_t rowbase = (size_t)b * SEQ; const int q0 = qb * 256, qw = q0 + 32 * wid;
    bf16x8 qr[DK / 16];
#pragma unroll
    for (int d0 = 0; d0 < DK / 16; ++d0) qr[d0] = *(const bf16x8*)(Q + (rowbase + qw + r32) * QP + hq + 16 * d0 + 8 * hi);
    f32x16 o0, o1;
#pragma unroll
    for (int i = 0; i < 16; ++i) { o0[i] = 0.f; o1[i] = 0.f; }
    float m = -INFINITY, l = 0.f;
    const int ntile = (q0 + 256) / 64;
    for (int jt = 0; jt < ntile; ++jt) {
        const int kv0 = jt * 64;
        __syncthreads();
        for (int c = tid; c < 64 * (DK / 8); c += 512) { const int r = c / (DK / 8), ch = c % (DK / 8);
            const u32x4 v = *(const u32x4*)(K + (rowbase + kv0 + r) * KP + hq + ch * 8); *(LAS u32x4*)(Ks + r * KS + ch * 8) = v; }
        { const int r = tid >> 3, ch = tid & 7; const u32x4 v = *(const u32x4*)(V + (rowbase + kv0 + r) * VP + hv + ch * 8);
#pragma unroll
          for (int i = 0; i < 4; ++i) { VT[(ch * 8 + 2 * i) * VS + r] = (bf16_t)(v[i] & 0xffffu); VT[(ch * 8 + 2 * i + 1) * VS + r] = (bf16_t)(v[i] >> 16); } }
        if (BIAS) { if (tid < 64) ckl[tid] = CK[(rowbase + kv0 + tid) * 16 + hc]; }
        __syncthreads();
        if (kv0 <= qw + 31) {
            f32x16 p0, p1;
#pragma unroll
            for (int i = 0; i < 16; ++i) { p0[i] = 0.f; p1[i] = 0.f; }
#pragma unroll
            for (int d0 = 0; d0 < DK / 16; ++d0) {
                const bf16x8 a0 = *(LAS bf16x8*)(Ks + r32 * KS + 16 * d0 + 8 * hi), a1 = *(LAS bf16x8*)(Ks + (32 + r32) * KS + 16 * d0 + 8 * hi);
                p0 = mfma32(a0, qr[d0], p0); p1 = mfma32(a1, qr[d0], p1);
            }
            if (BIAS) {
#pragma unroll
                for (int i = 0; i < 16; ++i) { p0[i] -= ckl[crow(i, hi)]; p1[i] -= ckl[32 + crow(i, hi)]; }
            }
            if (kv0 + 63 > qw) { const int q = qw + r32;
#pragma unroll
                for (int i = 0; i < 16; ++i) { const int kv = kv0 + crow(i, hi); if (kv > q) p0[i] = -INFINITY; if (kv + 32 > q) p1[i] = -INFINITY; } }
            float rm = p0[0];
#pragma unroll
            for (int i = 0; i < 16; ++i) { rm = fmaxf(rm, p0[i]); rm = fmaxf(rm, p1[i]); }
            rm = fmaxf(rm, __shfl_xor(rm, 32));
            const float mn = fmaxf(m, rm); const float f = __builtin_amdgcn_exp2f(m - mn);
            float rs = 0.f;
#pragma unroll
            for (int i = 0; i < 16; ++i) { p0[i] = __builtin_amdgcn_exp2f(p0[i] - mn); p1[i] = __builtin_amdgcn_exp2f(p1[i] - mn); rs += p0[i] + p1[i]; }
            rs += __shfl_xor(rs, 32);
            l = l * f + rs; m = mn;
#pragma unroll
            for (int i = 0; i < 16; ++i) { const float fi = __shfl(f, crow(i, hi)); o0[i] *= fi; o1[i] *= fi; }
            bf16x8 pf[4];
            { u32x4 t;
              t.x = pk2(p0[0], p0[1]); t.y = pk2(p0[2], p0[3]); t.z = pk2(p0[4], p0[5]); t.w = pk2(p0[6], p0[7]); pf[0] = __builtin_bit_cast(bf16x8, t);
              t.x = pk2(p0[8], p0[9]); t.y = pk2(p0[10], p0[11]); t.z = pk2(p0[12], p0[13]); t.w = pk2(p0[14], p0[15]); pf[1] = __builtin_bit_cast(bf16x8, t);
              t.x = pk2(p1[0], p1[1]); t.y = pk2(p1[2], p1[3]); t.z = pk2(p1[4], p1[5]); t.w = pk2(p1[6], p1[7]); pf[2] = __builtin_bit_cast(bf16x8, t);
              t.x = pk2(p1[8], p1[9]); t.y = pk2(p1[10], p1[11]); t.z = pk2(p1[12], p1[13]); t.w = pk2(p1[14], p1[15]); pf[3] = __builtin_bit_cast(bf16x8, t); }
#pragma unroll
            for (int ks = 0; ks < 4; ++ks) {
                { const s16x4 lo = *(LAS s16x4*)(VT + r32 * VS + 16 * ks + 4 * hi), hh = *(LAS s16x4*)(VT + r32 * VS + 16 * ks + 8 + 4 * hi);
                  const bf16x8 vf = __builtin_shufflevector(lo, hh, 0, 1, 2, 3, 4, 5, 6, 7); o0 = mfma32(pf[ks], vf, o0); }
                { const s16x4 lo = *(LAS s16x4*)(VT + (32 + r32) * VS + 16 * ks + 4 * hi), hh = *(LAS s16x4*)(VT + (32 + r32) * VS + 16 * ks + 8 + 4 * hi);
                  const bf16x8 vf = __builtin_shufflevector(lo, hh, 0, 1, 2, 3, 4, 5, 6, 7); o1 = mfma32(pf[ks], vf, o1); }
            }
        }
    }
    const float inv = 1.0f / l;
#pragma unroll
    for (int i = 0; i < 16; ++i) { const float ii = __shfl(inv, crow(i, hi)); const size_t row = rowbase + qw + crow(i, hi);
        O[row * OP + ho + r32] = f2bf(o0[i] * ii); O[row * OP + ho + 32 + r32] = f2bf(o1[i] * ii); }
}

DI void ln_rows(const float* src, const float* g, const float* b, float* dst, bf16_t* xb, int gw, int ngw, int lane) {
    f32x4 gv[4], bv[4];
#pragma unroll
    for (int j = 0; j < 4; ++j) { gv[j] = *(const f32x4*)(g + lane * 4 + 256 * j); bv[j] = *(const f32x4*)(b + lane * 4 + 256 * j); }
    for (int row = gw; row < NTOK; row += ngw) {
        f32x4 v[4]; float s = 0.f;
#pragma unroll
        for (int j = 0; j < 4; ++j) { v[j] = *(const f32x4*)(src + (size_t)row * DM + lane * 4 + 256 * j); s += (v[j][0] + v[j][1]) + (v[j][2] + v[j][3]); }
        const float mean = wave_sum(s) * (1.f / DM); float s2 = 0.f;
#pragma unroll
        for (int j = 0; j < 4; ++j) { v[j] = v[j] - mean; s2 += (v[j][0] * v[j][0] + v[j][1] * v[j][1]) + (v[j][2] * v[j][2] + v[j][3] * v[j][3]); }
        const float rstd = 1.0f / sqrtf(wave_sum(s2) * (1.f / DM) + LN_EPS);
#pragma unroll
        for (int j = 0; j < 4; ++j) { const f32x4 y = v[j] * rstd * gv[j] + bv[j];
            if (dst) *(f32x4*)(dst + (size_t)row * DM + lane * 4 + 256 * j) = y;
            if (xb) *(u32x2*)(xb + (size_t)row * DM + lane * 4 + 256 * j) = pk4(y); }
    }
}

DI void moe_tables(const unsigned* cnt, LAS int* tstart, LAS int* rstart, LAS int* cntl) {
    if (threadIdx.x == 0) {
        int t = 0, r = 0;
        for (int e = 0; e < NEXP; ++e) { const int c = (int)cnt[e]; cntl[e] = c; tstart[e] = t; rstart[e] = r; t += (c + 127) >> 7; r += ((c + 255) >> 8) << 8; }
        tstart[NEXP] = t; rstart[NEXP] = r;
    }
    __syncthreads();
}
DI int find_expert(const LAS int* tstart, int tile) { int e = 0;
#pragma unroll 1
    for (int s = 32; s > 0; s >>= 1) if (tstart[e + s] <= tile) e += s;
    return e; }


#define XB_TMO      128
#define XB_XCNT(j)  (256  + 64 * (j))
#define XB_XSUB(j)  (1280 + 64 * (j))
#define XB_XGEN(j)  (2304 + 64 * (j))
#define XB_TOP      3328
#define XB_TOPGEN   3392
#define XCD_BAR_WORDS 3456
#define XB_SPIN_CAP (1u << 18)
__device__ __forceinline__ unsigned xb_ld(unsigned* p)              { return __hip_atomic_load(p, __ATOMIC_RELAXED, __HIP_MEMORY_SCOPE_AGENT); }
__device__ __forceinline__ unsigned xb_add(unsigned* p, unsigned v) { return __hip_atomic_fetch_add(p, v, __ATOMIC_RELAXED, __HIP_MEMORY_SCOPE_AGENT); }
__device__ __forceinline__ unsigned xb_xcc_id() { return (unsigned)__builtin_amdgcn_s_getreg((3 << 11) | 20) & 0xFu; }
#define XB_SPIN(cond, bar) do { unsigned _sp = 0; while (cond) { __builtin_amdgcn_s_sleep(1); \
    if ((++_sp & 255u) == 0u) { if (xb_ld(&(bar)[XB_TMO])) break; if (_sp > XB_SPIN_CAP) { atomicAdd(&(bar)[XB_TMO], 1u); break; } } } } while (0)
struct XcdBarrier { unsigned* bar; unsigned x; volatile LAS unsigned* st; };
__device__ __forceinline__ XcdBarrier xcd_barrier_post(unsigned* bar, volatile LAS unsigned* st) {
    XcdBarrier b; b.bar = bar; b.x = xb_xcc_id(); b.st = st;
    if (threadIdx.x == 0) (void)xb_add(&bar[XB_XCNT(b.x)], 1u);
    return b;
}
__device__ __forceinline__ void xcd_barrier_complete(unsigned* bar, unsigned x, unsigned& nloc, unsigned& nx) {
    const unsigned G = gridDim.x * gridDim.y * gridDim.z;
    unsigned sum, cnt, mine, sp = 0u;
    for (;;) {
        sum = 0u; cnt = 0u; mine = 0u;
#pragma unroll
        for (unsigned j = 0; j < 16; ++j) { const unsigned c = xb_ld(&bar[XB_XCNT(j)]); sum += c; cnt += (c > 0u) ? 1u : 0u; mine = (j == x) ? c : mine; }
        if (sum == G) break;
        __builtin_amdgcn_s_sleep(1);
        if ((++sp & 255u) == 0u) { if (xb_ld(&bar[XB_TMO])) break; if (sp > XB_SPIN_CAP) { atomicAdd(&bar[XB_TMO], 1u); break; } }
    }
    nloc = mine > 0u ? mine : 1u; nx = cnt > 0u ? cnt : 1u;
}
__device__ __forceinline__ void xcd_barrier(const XcdBarrier& b) {
    asm volatile("s_waitcnt vmcnt(0)" ::: "memory");
    __syncthreads();
    if (threadIdx.x == 0) {
        unsigned* bar = b.bar;
        __builtin_amdgcn_s_waitcnt(0);
        unsigned nloc = b.st[0], nx = b.st[1];
        if (nloc == 0u) { xcd_barrier_complete(bar, b.x, nloc, nx); b.st[0] = nloc; b.st[1] = nx; }
        const unsigned old = xb_add(&bar[XB_XSUB(b.x)], 1u);
        const unsigned gen = old / nloc;
        if (old + 1u == (gen + 1u) * nloc) {
            __builtin_amdgcn_fence(__ATOMIC_RELEASE, "agent");
            asm volatile("s_waitcnt vmcnt(0)" ::: "memory");
            const unsigned og = xb_add(&bar[XB_TOP], 1u);
            const unsigned tg = og / nx;
            if (og + 1u == (tg + 1u) * nx) xb_add(&bar[XB_TOPGEN], 1u);
            else XB_SPIN(xb_ld(&bar[XB_TOPGEN]) == tg, bar);
            __builtin_amdgcn_fence(__ATOMIC_ACQUIRE, "agent");
            xb_add(&bar[XB_XGEN(b.x)], 1u);
            asm volatile("s_waitcnt vmcnt(0)" ::: "memory");
        } else {
            XB_SPIN(xb_ld(&bar[XB_XGEN(b.x)]) == gen, bar);
            __builtin_amdgcn_fence(__ATOMIC_ACQUIRE, "agent");
            asm volatile("s_waitcnt vmcnt(0)" ::: "memory");
        }
    }
    __syncthreads();
}

template <int PH> DI void run_phase(const Args& a, LAS unsigned char* lds) {
    const int tid = threadIdx.x, lane = tid & 63, wid = tid >> 6;
    const int G = gridDim.x, bid = blockIdx.x;
    const int gw = bid * 8 + wid, ngw = G * 8, gtid = bid * 512 + tid, gthreads = G * 512;
    unsigned char* ws = a.ws;
    constexpr int L = (PH >= 13) ? 1 : 0;
    constexpr int IB_MOE = L ? 32 : 16;
    unsigned* cnt = (unsigned*)(ws + WS_CTL) + 64 * L;
    bf16_t* XB = (bf16_t*)(ws + WS_XB);

    if constexpr (PH == 0) {
        LAS float* scr = (LAS float*)(lds + wid * 8448);
        constexpr int I_IN = (1024 / 64) * (N_IN0 / 32), I_UQ = (256 / 64) * (768 / 32), I_UKV = (256 / 64) * (1280 / 32), I_OUT = (1024 / 64) * (1024 / 32);
        for (int it = gw; it < I_IN + I_UQ + I_UKV + I_OUT; it += ngw) {
            int r = it;
            if (r < I_IN) { prep_item((const float*)a.in[2], nullptr, 1440, 1024, nullptr, (bf16_t*)(ws + W_IN), 1024, N_IN0, map_in0, scr, r, lane); continue; } r -= I_IN;
            if (r < I_UQ) { prep_item((const float*)a.in[9], nullptr, 768, 256, (const float*)a.in[8], (bf16_t*)(ws + W_UQ), 256, 768, map_q, scr, r, lane); continue; } r -= I_UQ;
            if (r < I_UKV) { prep_item((const float*)a.in[11], nullptr, 1024, 128, (const float*)a.in[10], (bf16_t*)(ws + W_UKV), 256, 1280, map_kv, scr, r, lane); continue; } r -= I_UKV;
            prep_item((const float*)a.in[12], nullptr, 1024, 1024, nullptr, (bf16_t*)(ws + W_OUT), 1024, 1024, map_ident, scr, r, lane);
        }
        prep_moe(a, 16, scr, gw, ngw, lane, gtid, gthreads);
        float* b0 = (float*)(ws + WS_TAB); float* b1 = (float*)(ws + WS_TAB + 8192);
        for (int n = gtid; n < N_IN0; n += gthreads) { const int s = map_in0(n); b0[n] = s >= 0 ? ((const float*)a.in[3])[s] : 0.f; }
        for (int n = gtid; n < N_IN1; n += gthreads) b1[n] = n < 3088 ? ((const float*)a.in[27])[n] : 0.f;
        float* ct = (float*)(ws + WS_COS); float* st = (float*)(ws + WS_SIN); const int* pos = (const int*)a.in[1];
        for (int idx = gtid; idx < NTOK * 16; idx += gthreads) {
            const int t = idx >> 4, p = idx & 15;
            const float inv = 1.0f / exp2f((float)p * (13.287712379549449f / 16.0f));
            const float ang = (float)pos[t] * inv;
            double rev = (double)ang * 0.15915494309189535; rev -= rint(rev);
            ct[idx] = __builtin_amdgcn_cosf((float)rev); st[idx] = __builtin_amdgcn_sinf((float)rev);
        }
        const float* x = (const float*)a.in[0];
        for (int idx = gtid; idx < NTOK * DM / 8; idx += gthreads) {
            const f32x4 v0 = *(const f32x4*)(x + (size_t)idx * 8), v1 = *(const f32x4*)(x + (size_t)idx * 8 + 4);
            u32x4 o; o.x = pk2(v0[0], v0[1]); o.y = pk2(v0[2], v0[3]); o.z = pk2(v1[0], v1[1]); o.w = pk2(v1[2], v1[3]);
            *(u32x4*)(XB + (size_t)idx * 8) = o;
        }
    }
    else if constexpr (PH == 1) {
        const bf16_t* Bt = (const bf16_t*)(ws + W_IN); const float* bias = (const float*)(ws + WS_TAB);
        bf16_t* UPRE = (bf16_t*)(ws + B_UPRE); bf16_t* QL = (bf16_t*)(ws + B_QL); bf16_t* KVL = (bf16_t*)(ws + B_KVL);
        for (int u = bid; u < 256 * 6; u += G) {
            const int mt = u / 6, nt = u % 6;
            auto epi = [&](int r, int c, f32x4 lo, f32x4 hi) {
                const size_t row = (size_t)mt * 128 + r;
                const f32x4 blo = *(const f32x4*)(bias + nt * 256 + c), bhi = *(const f32x4*)(bias + nt * 256 + 128 + c);
                lo = lo + blo; hi = hi + bhi;
                if (nt < 4) { f32x4 uu;
#pragma unroll
                    for (int i = 0; i < 4; ++i) uu[i] = lo[i] * sigmoidf_(hi[i]);
                    *(u32x2*)(UPRE + row * 512 + nt * 128 + c) = pk4(uu); }
                else if (nt == 4) { *(u32x2*)(QL + row * 256 + c) = pk4(lo); *(u32x2*)(QL + row * 256 + 128 + c) = pk4(hi); }
                else { *(u32x2*)(KVL + row * 256 + c) = pk4(lo); *(u32x2*)(KVL + row * 256 + 128 + c) = pk4(hi); }
            };
            sgemm_unit(lds, XB + ((size_t)mt * 128 + (tid >> 2)) * 1024 + (tid & 3) * 8, Bt + ((size_t)nt * 256 + (tid >> 2)) * 1024 + (tid & 3) * 8,
                       Bt + ((size_t)nt * 256 + 128 + (tid >> 2)) * 1024 + (tid & 3) * 8, 1024, epi);
        }
    }
    else if constexpr (PH == 2) {
        const bf16_t* UPRE = (const bf16_t*)(ws + B_UPRE); bf16_t* UO = (bf16_t*)(ws + B_UO);
        {
            const float* cw = (const float*)a.in[4]; const float* cb = (const float*)a.in[5]; const float* lg = (const float*)a.in[6]; const float* lb = (const float*)a.in[7];
            LAS bf16_t* U = (LAS bf16_t*)lds;
            LAS float* CO = (LAS float*)(lds + 94 * 512 * 2);
            float w[31];
#pragma unroll
            for (int j = 0; j < 31; ++j) w[j] = cw[j * 512 + tid];
            const float bch = cb[tid];
            f32x4 g0 = *(const f32x4*)(lg + lane * 8), g1 = *(const f32x4*)(lg + lane * 8 + 4), b0 = *(const f32x4*)(lb + lane * 8), b1 = *(const f32x4*)(lb + lane * 8 + 4);
            for (int u = bid; u < NTOK / 64; u += G) {
                const int tok0 = u * 64, s0 = tok0 % SEQ;
                __syncthreads();
                for (int c = tid; c < 94 * 64; c += 512) { const int r = c >> 6, ch = c & 63; const int s = s0 - 30 + r;
                    u32x4 v = (u32x4){0u, 0u, 0u, 0u}; if (s >= 0) v = *(const u32x4*)(UPRE + (size_t)(tok0 - 30 + r) * 512 + ch * 8);
                    *(LAS u32x4*)(U + r * 512 + ch * 8) = v; }
                __syncthreads();
                for (int sub = 0; sub < 4; ++sub) {
                    for (int tt = 0; tt < 16; ++tt) { const int tl = sub * 16 + tt; float acc = bch;
#pragma unroll
                        for (int j = 0; j < 31; ++j) acc += w[j] * bf2f(U[(tl + j) * 512 + tid]);
                        CO[tt * 512 + tid] = acc; }
                    __syncthreads();
#pragma unroll
                    for (int k = 0; k < 2; ++k) { const int tt = 2 * wid + k;
                        f32x4 v0 = *(LAS f32x4*)(CO + tt * 512 + lane * 8), v1 = *(LAS f32x4*)(CO + tt * 512 + lane * 8 + 4);
                        const float mean = wave_sum((v0[0] + v0[1]) + (v0[2] + v0[3]) + (v1[0] + v1[1]) + (v1[2] + v1[3])) * (1.f / 512.f);
                        v0 = v0 - mean; v1 = v1 - mean;
                        const float var = wave_sum((v0[0] * v0[0] + v0[1] * v0[1]) + (v0[2] * v0[2] + v0[3] * v0[3]) + (v1[0] * v1[0] + v1[1] * v1[1]) + (v1[2] * v1[2] + v1[3] * v1[3])) * (1.f / 512.f);
                        const float rstd = 1.0f / sqrtf(var + LN_EPS);
                        f32x4 y0 = v0 * rstd * g0 + b0, y1 = v1 * rstd * g1 + b1;
#pragma unroll
                        for (int i = 0; i < 4; ++i) { y0[i] = siluf_(y0[i]); y1[i] = siluf_(y1[i]); }
                        u32x4 o; o.x = pk2(y0[0], y0[1]); o.y = pk2(y0[2], y0[3]); o.z = pk2(y1[0], y1[1]); o.w = pk2(y1[2], y1[3]);
                        *(u32x4*)(UO + (size_t)(tok0 + sub * 16 + tt) * 1024 + lane * 8) = o; }
                    __syncthreads();
                }
            }
        }
        const float* ct = (const float*)(ws + WS_COS); const float* st = (const float*)(ws + WS_SIN);
        LAS float* rsl = (LAS float*)(lds + SG_LDS);
        {
            const bf16_t* QL = (const bf16_t*)(ws + B_QL); const bf16_t* Bt = (const bf16_t*)(ws + W_UQ); bf16_t* Q0 = (bf16_t*)(ws + B_Q0);
            for (int u = bid; u < 256 * 3; u += G) {
                const int mt = u / 3, nt = u % 3;
                __syncthreads();
                for (int rr = 0; rr < 16; ++rr) { const int r = 16 * wid + rr; const u32x2 v = *(const u32x2*)(QL + ((size_t)mt * 128 + r) * 256 + lane * 4);
                    const float x0 = bf2f(v.x & 0xffff), x1 = bf2f(v.x >> 16), x2 = bf2f(v.y & 0xffff), x3 = bf2f(v.y >> 16);
                    const float ss = wave_sum(x0 * x0 + x1 * x1 + x2 * x2 + x3 * x3); if (lane == 0) rsl[r] = 1.0f / sqrtf(ss * (1.f / 256.f) + RMS_EPS); }
                auto epi = [&](int r, int c, f32x4 lo, f32x4 hi) {
                    const size_t row = (size_t)mt * 128 + r; const float s = rsl[r];
#pragma unroll
                    for (int hh = 0; hh < 2; ++hh) { f32x4 v = (hh ? hi : lo) * s; const int col = nt * 256 + c + 128 * hh; const int d = col % 96;
                        if (d >= 64) { const int p = (d - 64) >> 1; const float c0 = ct[row * 16 + p], s0_ = st[row * 16 + p], c1 = ct[row * 16 + p + 1], s1 = st[row * 16 + p + 1];
                            const float a0 = v[0], a1 = v[1], a2 = v[2], a3 = v[3]; v[0] = a0 * c0 - a1 * s0_; v[1] = a1 * c0 + a0 * s0_; v[2] = a2 * c1 - a3 * s1; v[3] = a3 * c1 + a2 * s1; }
                        v = v * C2_MLA; *(u32x2*)(Q0 + row * 768 + col) = pk4(v); }
                };
                sgemm_unit(lds, QL + ((size_t)mt * 128 + (tid >> 2)) * 256 + (tid & 3) * 8, Bt + ((size_t)nt * 256 + (tid >> 2)) * 256 + (tid & 3) * 8,
                           Bt + ((size_t)nt * 256 + 128 + (tid >> 2)) * 256 + (tid & 3) * 8, 256, epi);
            }
        }
        {
            const bf16_t* KVL = (const bf16_t*)(ws + B_KVL); const bf16_t* Bt = (const bf16_t*)(ws + W_UKV); bf16_t* K0 = (bf16_t*)(ws + B_K0); bf16_t* V0 = (bf16_t*)(ws + B_V0);
            for (int u = bid; u < 256 * 5; u += G) {
                const int mt = u / 5, nt = u % 5;
                __syncthreads();
                for (int rr = 0; rr < 16; ++rr) { const int r = 16 * wid + rr; const unsigned v = *(const unsigned*)(KVL + ((size_t)mt * 128 + r) * 256 + lane * 2);
                    const float x0 = bf2f(v & 0xffff), x1 = bf2f(v >> 16);
                    const float ss = wave_sum(x0 * x0 + x1 * x1); if (lane == 0) rsl[r] = 1.0f / sqrtf(ss * (1.f / 128.f) + RMS_EPS); }
                auto epi = [&](int r, int c, f32x4 lo, f32x4 hi) {
                    const size_t row = (size_t)mt * 128 + r; const float s = rsl[r];
#pragma unroll
                    for (int hh = 0; hh < 2; ++hh) { f32x4 v = (hh ? hi : lo); const int col = nt * 256 + c + 128 * hh;
                        if (col < 768) { const int d = col % 96;
                            if (d >= 64) { const int p = (d - 64) >> 1; const float c0 = ct[row * 16 + p], s0_ = st[row * 16 + p], c1 = ct[row * 16 + p + 1], s1 = st[row * 16 + p + 1];
                                const float a0 = v[0], a1 = v[1], a2 = v[2], a3 = v[3]; v[0] = a0 * c0 - a1 * s0_; v[1] = a1 * c0 + a0 * s0_; v[2] = a2 * c1 - a3 * s1; v[3] = a3 * c1 + a2 * s1; }
                            else v = v * s;
                            *(u32x2*)(K0 + row * 768 + col) = pk4(v); }
                        else { v = v * s; *(u32x2*)(V0 + row * 512 + (col - 768)) = pk4(v); } }
                };
                sgemm_unit(lds, KVL + ((size_t)mt * 128 + (tid >> 2)) * 256 + (tid & 3) * 8, Bt + ((size_t)nt * 256 + (tid >> 2)) * 256 + (tid & 3) * 8,
                           Bt + ((size_t)nt * 256 + 128 + (tid >> 2)) * 256 + (tid & 3) * 8, 256, epi);
            }
        }
    }
    else if constexpr (PH == 3) {
        const bf16_t* Q0 = (const bf16_t*)(ws + B_Q0); const bf16_t* K0 = (const bf16_t*)(ws + B_K0); const bf16_t* V0 = (const bf16_t*)(ws + B_V0); bf16_t* UO = (bf16_t*)(ws + B_UO);
        for (int u = bid; u < 64 * 16; u += G) {
            const int i = u >> 8, gp = u & 255, s = gp >> 6, bh = gp & 63, base = 4 * (i >> 1) + s, qb = (i & 1) ? 15 - base : base;
            const int b = bh >> 3, h = bh & 7;
            attn_simple_unit<96, 768, 768, 512, 1024, false>(lds, Q0, K0, V0, UO, nullptr, b, h * 96, h * 64, 0, 512 + h * 64, qb);
        }
    }
    else if constexpr (PH == 4 || PH == 16) {
        const bf16_t* A = (const bf16_t*)(ws + (L ? B_O1 : B_UO)); const bf16_t* Bt = (const bf16_t*)(ws + W_OUT);
        const float* bias = (const float*)a.in[L ? 29 : 13]; const float* xres = L ? (const float*)a.out : (const float*)a.in[0]; float* pre = a.out;
        for (int u = bid; u < 256 * 4; u += G) {
            const int mt = u >> 2, nt = u & 3;
            auto epi = [&](int r, int c, f32x4 lo, f32x4 hi) {
                const size_t off = ((size_t)mt * 128 + r) * 1024 + nt * 256 + c;
                const f32x4 x0 = *(const f32x4*)(xres + off), x1 = *(const f32x4*)(xres + off + 128);
                const f32x4 b0 = *(const f32x4*)(bias + nt * 256 + c), b1 = *(const f32x4*)(bias + nt * 256 + 128 + c);
                *(f32x4*)(pre + off) = x0 * ALPHA + lo + b0; *(f32x4*)(pre + off + 128) = x1 * ALPHA + hi + b1;
            };
            sgemm_unit(lds, A + ((size_t)mt * 128 + (tid >> 2)) * 1024 + (tid & 3) * 8, Bt + ((size_t)nt * 256 + (tid >> 2)) * 1024 + (tid & 3) * 8,
                       Bt + ((size_t)nt * 256 + 128 + (tid >> 2)) * 1024 + (tid & 3) * 8, 1024, epi);
        }
    }
    else if constexpr (PH == 5 || PH == 17) {
        ln_rows(a.out, (const float*)a.in[L ? 30 : 14], (const float*)a.in[L ? 31 : 15], a.out, XB, gw, ngw, lane);
    }
    else if constexpr (PH == 6 || PH == 18) {
        {
            const float* x1 = a.out; const bf16_t* rhi = (const bf16_t*)(ws + W_RHI); const bf16_t* rlo = (const bf16_t*)(ws + W_RLO);
            const float* rbias = (const float*)a.in[IB_MOE + 1];
            int* LIST = (int*)(ws + B_LIST); float* TOKW = (float*)(ws + B_TOKW);
            LAS unsigned char* Ah = lds; LAS unsigned char* Al = lds + 8192; LAS unsigned char* Bh = lds + 16384; LAS unsigned char* Bl = lds + 20480;
            LAS float* lgl = (LAS float*)(lds + 24576);
            LAS int* lcnt = (LAS int*)(lds + 24576 + 33280);
            LAS int* lbase = lcnt + 64;
            LAS int* sel_e = lbase + 64;
            LAS int* sel_p = sel_e + 768;
            const int fr = lane & 15, fq = lane >> 4;
            const float mybias = rbias[lane];
            for (int u = bid; u < NTOK / 128; u += G) {
                const int t0 = u * 128;
                f32x4 acc[4];
#pragma unroll
                for (int n = 0; n < 4; ++n) acc[n] = (f32x4){0.f, 0.f, 0.f, 0.f};
                const int sr = tid >> 2, sc = (tid & 3) * 8;
                for (int kt = 0; kt < 32; ++kt) {
                    const f32x4 v0 = *(const f32x4*)(x1 + (size_t)(t0 + sr) * 1024 + kt * 32 + sc), v1 = *(const f32x4*)(x1 + (size_t)(t0 + sr) * 1024 + kt * 32 + sc + 4);
                    const u32x4 wv = *(const u32x4*)((tid < 256 ? rhi : rlo) + (size_t)((tid & 255) >> 2) * 1024 + kt * 32 + (tid & 3) * 8);
                    u32x4 h, lo_;
                    h.x = pk2(v0[0], v0[1]); h.y = pk2(v0[2], v0[3]); h.z = pk2(v1[0], v1[1]); h.w = pk2(v1[2], v1[3]);
                    lo_.x = pk2(v0[0] - __uint_as_float(h.x << 16), v0[1] - __uint_as_float(h.x & 0xffff0000u));
                    lo_.y = pk2(v0[2] - __uint_as_float(h.y << 16), v0[3] - __uint_as_float(h.y & 0xffff0000u));
                    lo_.z = pk2(v1[0] - __uint_as_float(h.z << 16), v1[1] - __uint_as_float(h.z & 0xffff0000u));
                    lo_.w = pk2(v1[2] - __uint_as_float(h.w << 16), v1[3] - __uint_as_float(h.w & 0xffff0000u));
                    __syncthreads();
                    *(LAS u32x4*)(Ah + sr * 64 + sc * 2) = h; *(LAS u32x4*)(Al + sr * 64 + sc * 2) = lo_;
                    *(LAS u32x4*)((tid < 256 ? Bh : Bl) + ((tid & 255) >> 2) * 64 + (tid & 3) * 16) = wv;
                    __syncthreads();
                    const bf16x8 ah = *(LAS bf16x8*)(Ah + (16 * wid + fr) * 64 + fq * 16), al = *(LAS bf16x8*)(Al + (16 * wid + fr) * 64 + fq * 16);
#pragma unroll
                    for (int n = 0; n < 4; ++n) { const bf16x8 bh = *(LAS bf16x8*)(Bh + (16 * n + fr) * 64 + fq * 16), bl = *(LAS bf16x8*)(Bl + (16 * n + fr) * 64 + fq * 16);
                        acc[n] = mfma16(bh, ah, acc[n]); acc[n] = mfma16(bh, al, acc[n]); acc[n] = mfma16(bl, ah, acc[n]); }
                }
#pragma unroll
                for (int n = 0; n < 4; ++n)
#pragma unroll
                    for (int j = 0; j < 4; ++j) lgl[(16 * wid + fr) * 65 + 16 * n + 4 * fq + j] = acc[n][j];
                if (tid < 64) lcnt[tid] = 0;
                __syncthreads();
                for (int tt = 0; tt < 16; ++tt) {
                    const int tl = 16 * wid + tt, t = t0 + tl;
                    const float sg = sigmoidf_(lgl[tl * 65 + lane]); const float ch = sg + mybias;
                    const int g = lane >> 3; int rk = 0;
#pragma unroll
                    for (int jj = 0; jj < 8; ++jj) { const int oj = (lane & ~7) + jj; const float o = __shfl(ch, oj); rk += ((o > ch) || (o == ch && oj < lane)) ? 1 : 0; }
                    float top = rk < 2 ? ch : 0.f; top += __shfl_xor(top, 1); top += __shfl_xor(top, 2); top += __shfl_xor(top, 4);
                    int grk = 0;
#pragma unroll
                    for (int gg = 0; gg < 8; ++gg) { const float o = __shfl(top, gg * 8); grk += ((o > top) || (o == top && gg < g)) ? 1 : 0; }
                    const bool gsel = grk < 4; const float mv = gsel ? ch : -INFINITY; int erk = 0;
#pragma unroll 8
                    for (int j = 0; j < 64; ++j) { const float o = __shfl(mv, j); erk += ((o > mv) || (o == mv && j < lane)) ? 1 : 0; }
                    const bool sel = gsel && erk < TOPK;
                    const float tot = wave_sum(sel ? sg : 0.f); const float w = sg / tot * 2.5f;
                    if (sel) { const int lp = __hip_atomic_fetch_add(lcnt + lane, 1, __ATOMIC_RELAXED, __HIP_MEMORY_SCOPE_WORKGROUP);
                        sel_e[tl * 6 + erk] = lane; sel_p[tl * 6 + erk] = lp; TOKW[(size_t)t * 8 + erk] = w; }
                }
                __syncthreads();
                if (tid < 64) { const int c = lcnt[tid]; lbase[tid] = c ? (int)atomicAdd(cnt + tid, (unsigned)c) : 0; }
                __syncthreads();
                for (int idx = tid; idx < 768; idx += 512) { const int e = sel_e[idx], pos = lbase[e] + sel_p[idx], tl = idx / 6, j = idx % 6; LIST[(size_t)e * LISTCAP + pos] = ((t0 + tl) << 3) | j; }
                __syncthreads();
            }
        }
        {
            const bf16_t* Bt = (const bf16_t*)(ws + W_SGU); bf16_t* SH = (bf16_t*)(ws + B_SH);
            for (int u = bid; u < 256 * 2; u += G) {
                const int mt = u >> 1, nt = u & 1;
                auto epi = [&](int r, int c, f32x4 lo, f32x4 hi) { f32x4 h;
#pragma unroll
                    for (int i = 0; i < 4; ++i) h[i] = siluf_(lo[i]) * hi[i];
                    *(u32x2*)(SH + ((size_t)mt * 128 + r) * 256 + nt * 128 + c) = pk4(h); };
                sgemm_unit(lds, XB + ((size_t)mt * 128 + (tid >> 2)) * 1024 + (tid & 3) * 8, Bt + ((size_t)nt * 256 + (tid >> 2)) * 1024 + (tid & 3) * 8,
                           Bt + ((size_t)nt * 256 + 128 + (tid >> 2)) * 1024 + (tid & 3) * 8, 1024, epi);
            }
        }
    }
    else if constexpr (PH == 7 || PH == 19) {
        LAS int* tstart = (LAS int*)(lds + SG_LDS); LAS int* rstart = tstart + 65; LAS int* cntl = rstart + 65;
        moe_tables(cnt, tstart, rstart, cntl);
        const int* LIST = (const int*)(ws + B_LIST); const bf16_t* Wgu = (const bf16_t*)(ws + W_GU); bf16_t* H = (bf16_t*)(ws + B_H);
        const int nunits = tstart[NEXP] * 2;
        for (int u = bid; u < nunits; u += G) {
            const int tile = u >> 1, nt = u & 1, e = find_expert(tstart, tile), i0 = (tile - tstart[e]) * 128, ce = cntl[e], r0 = rstart[e] + i0;
            const int myi = i0 + (tid >> 2); const int tok = myi < ce ? (LIST[(size_t)e * LISTCAP + myi] >> 3) : 0;
            const bf16_t* Bt = Wgu + ((size_t)e * 512 + nt * 256) * 1024;
            auto epi = [&](int r, int c, f32x4 lo, f32x4 hi) { f32x4 h;
#pragma unroll
                for (int i = 0; i < 4; ++i) h[i] = siluf_(lo[i]) * hi[i];
                *(u32x2*)(H + (size_t)(r0 + r) * 256 + nt * 128 + c) = pk4(h); };
            sgemm_unit(lds, XB + (size_t)tok * 1024 + (tid & 3) * 8, Bt + (size_t)(tid >> 2) * 1024 + (tid & 3) * 8, Bt + (size_t)(128 + (tid >> 2)) * 1024 + (tid & 3) * 8, 1024, epi);
        }
    }
    else if constexpr (PH == 8 || PH == 10 || PH == 20 || PH == 22) {
        constexpr int P = (PH == 10 || PH == 22) ? 1 : 0;
        LAS int* tstart = (LAS int*)(lds + SG_LDS); LAS int* rstart = tstart + 65; LAS int* cntl = rstart + 65;
        moe_tables(cnt, tstart, rstart, cntl);
        const int* LIST = (const int*)(ws + B_LIST); const float* TOKW = (const float*)(ws + B_TOKW); const bf16_t* Wd = (const bf16_t*)(ws + W_D);
        const bf16_t* H = (const bf16_t*)(ws + B_H); bf16_t* YT = (bf16_t*)(ws + B_YT);
        const int nunits = tstart[NEXP] * 2;
        for (int u = bid; u < nunits; u += G) {
            const int tile = u >> 1, nt = u & 1, e = find_expert(tstart, tile), i0 = (tile - tstart[e]) * 128, ce = cntl[e], r0 = rstart[e] + i0;
            const bf16_t* Bt = Wd + ((size_t)e * 1024 + 512 * P + nt * 256) * 256;
            auto epi = [&](int r, int c, f32x4 lo, f32x4 hi) {
                if (i0 + r < ce) { const int v = LIST[(size_t)e * LISTCAP + i0 + r]; const float w = TOKW[v]; const size_t dst = ((size_t)(v >> 3) * 6 + (v & 7)) * 512 + nt * 256 + c;
                    *(u32x2*)(YT + dst) = pk4(lo * w); *(u32x2*)(YT + dst + 128) = pk4(hi * w); } };
            sgemm_unit(lds, H + (size_t)(r0 + (tid >> 2)) * 256 + (tid & 3) * 8, Bt + (size_t)(tid >> 2) * 256 + (tid & 3) * 8, Bt + (size_t)(128 + (tid >> 2)) * 256 + (tid & 3) * 8, 256, epi);
        }
    }
    else if constexpr (PH == 9 || PH == 11 || PH == 21 || PH == 23) {
        constexpr int P = (PH == 11 || PH == 23) ? 1 : 0;
        const bf16_t* SH = (const bf16_t*)(ws + B_SH); const bf16_t* Wsd = (const bf16_t*)(ws + W_SD); const bf16_t* YT = (const bf16_t*)(ws + B_YT); float* xo = a.out;
        for (int u = bid; u < 256 * 2; u += G) {
            const int mt = u >> 1, nt = u & 1;
            const bf16_t* Bt = Wsd + ((size_t)512 * P + nt * 256) * 256;
            auto epi = [&](int r, int c, f32x4 lo, f32x4 hi) {
                const size_t row = (size_t)mt * 128 + r; const size_t off = row * 1024 + 512 * P + nt * 256 + c;
                f32x4 a0 = *(const f32x4*)(xo + off) * ALPHA + lo, a1 = *(const f32x4*)(xo + off + 128) * ALPHA + hi;
#pragma unroll
                for (int j = 0; j < 6; ++j) { const u32x2 y0 = *(const u32x2*)(YT + (row * 6 + j) * 512 + nt * 256 + c), y1 = *(const u32x2*)(YT + (row * 6 + j) * 512 + nt * 256 + c + 128);
                    a0[0] += __uint_as_float(y0.x << 16); a0[1] += __uint_as_float(y0.x & 0xffff0000u); a0[2] += __uint_as_float(y0.y << 16); a0[3] += __uint_as_float(y0.y & 0xffff0000u);
                    a1[0] += __uint_as_float(y1.x << 16); a1[1] += __uint_as_float(y1.x & 0xffff0000u); a1[2] += __uint_as_float(y1.y << 16); a1[3] += __uint_as_float(y1.y & 0xffff0000u); }
                *(f32x4*)(xo + off) = a0; *(f32x4*)(xo + off + 128) = a1;
            };
            sgemm_unit(lds, SH + ((size_t)mt * 128 + (tid >> 2)) * 256 + (tid & 3) * 8, Bt + (size_t)(tid >> 2) * 256 + (tid & 3) * 8, Bt + (size_t)(128 + (tid >> 2)) * 256 + (tid & 3) * 8, 256, epi);
        }
    }
    else if constexpr (PH == 12) {
        ln_rows(a.out, (const float*)a.in[24], (const float*)a.in[25], a.out, XB, gw, ngw, lane);
        LAS float* scr = (LAS float*)(lds + wid * 8448);
        constexpr int I_IN = (1024 / 64) * (N_IN1 / 32), I_OUT = (1024 / 64) * (1024 / 32);
        for (int it = gw; it < I_IN + I_OUT; it += ngw) {
            int r = it;
            if (r < I_IN) { prep_item((const float*)a.in[26], nullptr, 3088, 1024, nullptr, (bf16_t*)(ws + W_IN), 1024, N_IN1, map_in1, scr, r, lane); continue; } r -= I_IN;
            prep_item((const float*)a.in[28], nullptr, 1024, 1024, nullptr, (bf16_t*)(ws + W_OUT), 1024, 1024, map_ident, scr, r, lane);
        }
        prep_moe(a, 32, scr, gw, ngw, lane, gtid, gthreads);
    }
    else if constexpr (PH == 13) {
        const bf16_t* Bt = (const bf16_t*)(ws + W_IN); const float* bias = (const float*)(ws + WS_TAB + 8192);
        bf16_t* Q1 = (bf16_t*)(ws + B_Q1); bf16_t* K1 = (bf16_t*)(ws + B_K1); bf16_t* V1 = (bf16_t*)(ws + B_V1); float* GL = (float*)(ws + B_GL);
        for (int u = bid; u < 256 * 13; u += G) {
            const int mt = u / 13, nt = u % 13;
            auto epi = [&](int r, int c, f32x4 lo, f32x4 hi) {
                const size_t row = (size_t)mt * 128 + r;
                lo = lo + *(const f32x4*)(bias + nt * 256 + c); hi = hi + *(const f32x4*)(bias + nt * 256 + 128 + c);
                if (nt < 4) { *(u32x2*)(Q1 + row * 1024 + nt * 256 + c) = pk4(lo * C2_FOX); *(u32x2*)(Q1 + row * 1024 + nt * 256 + 128 + c) = pk4(hi * C2_FOX); }
                else if (nt < 8) { *(u32x2*)(K1 + row * 1024 + (nt - 4) * 256 + c) = pk4(lo); *(u32x2*)(K1 + row * 1024 + (nt - 4) * 256 + 128 + c) = pk4(hi); }
                else if (nt < 12) { *(u32x2*)(V1 + row * 1024 + (nt - 8) * 256 + c) = pk4(lo); *(u32x2*)(V1 + row * 1024 + (nt - 8) * 256 + 128 + c) = pk4(hi); }
                else if (c < 16) { f32x4 o;
#pragma unroll
                    for (int i = 0; i < 4; ++i) { const float x = lo[i]; o[i] = fminf(x, 0.f) - log1pf(__expf(-fabsf(x))); }
                    *(f32x4*)(GL + row * 16 + c) = o; }
            };
            sgemm_unit(lds, XB + ((size_t)mt * 128 + (tid >> 2)) * 1024 + (tid & 3) * 8, Bt + ((size_t)nt * 256 + (tid >> 2)) * 1024 + (tid & 3) * 8,
                       Bt + ((size_t)nt * 256 + 128 + (tid >> 2)) * 1024 + (tid & 3) * 8, 1024, epi);
        }
    }
    else if constexpr (PH == 14) {
        const float* GL = (const float*)(ws + B_GL); float* CK = (float*)(ws + B_CK);
        for (int sq = gw; sq < NBATCH * 16; sq += ngw) {
            const int b = sq >> 4, h = sq & 15; float carry = 0.f;
            for (int i = 0; i < SEQ / 64; ++i) { const size_t t = (size_t)b * SEQ + i * 64 + lane; float v = GL[t * 16 + h];
#pragma unroll
                for (int o = 1; o < 64; o <<= 1) { const float n = __shfl_up(v, o); if (lane >= o) v += n; }
                v += carry; CK[t * 16 + h] = v * LOG2E; carry = __shfl(v, 63); }
        }
    }
    else if constexpr (PH == 15) {
        const bf16_t* Q1 = (const bf16_t*)(ws + B_Q1); const bf16_t* K1 = (const bf16_t*)(ws + B_K1); const bf16_t* V1 = (const bf16_t*)(ws + B_V1); bf16_t* O1 = (bf16_t*)(ws + B_O1);
        const float* CK = (const float*)(ws + B_CK);
        for (int u = bid; u < 128 * 16; u += G) {
            const int i = u >> 8, gp = u & 255, s = gp >> 7, bh = gp & 127, base = 2 * (i >> 1) + s, qb = (i & 1) ? 15 - base : base;
            const int b = bh >> 4, h = bh & 15;
            attn_simple_unit<64, 1024, 1024, 1024, 1024, true>(lds, Q1, K1, V1, O1, CK, b, h * 64, h * 64, h, h * 64, qb);
        }
    }
    else if constexpr (PH == 24) {
        ln_rows(a.out, (const float*)a.in[40], (const float*)a.in[41], a.out, nullptr, gw, ngw, lane);
    }
}

constexpr int LDS_BYTES = 147456;
constexpr int CW_BAR = 4096;
constexpr int NPHASE = 25;
template <int PH, int END> struct RunAll {
    static DI void run(const Args& a, LAS unsigned char* lds, const XcdBarrier& bar) {
        run_phase<PH>(a, lds);
        if (PH + 1 < END) xcd_barrier(bar);
        RunAll<PH + 1, END>::run(a, lds, bar);
    }
};
template <int END> struct RunAll<END, END> { static DI void run(const Args&, LAS unsigned char*, const XcdBarrier&) {} };

__global__ void __launch_bounds__(512, 2) k_all(Args a) {
    extern __shared__ __attribute__((aligned(16))) unsigned char lds_raw[];
    LAS unsigned char* lds = (LAS unsigned char*)lds_raw;
    volatile LAS unsigned* st = (volatile LAS unsigned*)(lds + LDS_BYTES - 16);
    if (threadIdx.x == 0) { st[0] = 0u; st[1] = 0u; st[2] = 0u; st[3] = 0u; }
    __syncthreads();
    const XcdBarrier bar = xcd_barrier_post((unsigned*)(a.ws + WS_CTL) + CW_BAR, st);
    RunAll<0, NPHASE>::run(a, lds, bar);
}

extern "C" void kernel_launch(void* const* d_in, const int* in_sizes, int n_in, void* d_out, int out_size, void* d_ws, size_t ws_size, hipStream_t stream) {
    static int grid = 0;
    if (grid == 0) {
        if (n_in != 42 || out_size != NTOK * DM || ws_size < WS_END) { fprintf(stderr, "kernel_launch: unexpected shapes (n_in %d, out %d, ws %zu < %zu)\n", n_in, out_size, ws_size, (size_t)WS_END); grid = -1; return; }
        int dev = 0, cus = 0, per_cu = 0;
        (void)hipGetDevice(&dev); (void)hipDeviceGetAttribute(&cus, hipDeviceAttributeMultiprocessorCount, dev);
        (void)hipFuncSetAttribute((const void*)k_all, hipFuncAttributeMaxDynamicSharedMemorySize, LDS_BYTES);
        if (hipOccupancyMaxActiveBlocksPerMultiprocessor(&per_cu, (const void*)k_all, 512, LDS_BYTES) != hipSuccess || per_cu < 1) { fprintf(stderr, "kernel_launch: occupancy query reports %d blocks per CU\n", per_cu); per_cu = 1; }
        (void)hipGetLastError();
        grid = cus > 0 ? cus : 256;
    }
    if (grid < 0) return;
    (void)hipMemsetAsync((char*)d_ws + WS_CTL, 0, 1 * MiB, stream);
    Args a{};
    for (int i = 0; i < 42; ++i) a.in[i] = d_in[i];
    a.out = (float*)d_out; a.ws = (unsigned char*)d_ws;
    hipLaunchKernelGGL(k_all, dim3(grid), dim3(512), LDS_BYTES, stream, a);
}
```

```cpp
#include <hip/hip_runtime.h>
#include <cstdio>
#include <cstdint>
#include <cmath>

#define LAS __attribute__((address_space(3)))
#define DI __device__ __forceinline__
typedef unsigned short bf16_t;
typedef short bf16x8 __attribute__((ext_vector_type(8)));
typedef short s16x4 __attribute__((ext_vector_type(4)));
typedef float f32x4 __attribute__((ext_vector_type(4)));
typedef float f32x16 __attribute__((ext_vector_type(16)));
typedef unsigned u32x4 __attribute__((ext_vector_type(4)));
typedef unsigned u32x2 __attribute__((ext_vector_type(2)));
typedef float f32x2_t __attribute__((ext_vector_type(2)));
typedef __bf16 bf16x2_t __attribute__((ext_vector_type(2)));

constexpr int NTOK = 32768, DM = 1024, NBATCH = 8, SEQ = 4096;
constexpr int NEXP = 64, TOPK = 6, EHID = 256;
constexpr float ALPHA = 1.4142135623730951f;
constexpr float LN_EPS = 1e-5f, RMS_EPS = 1e-6f;
constexpr float LOG2E = 1.4426950408889634f;
constexpr float C2_MLA = 0.10206207261596577f * LOG2E;
constexpr float C2_FOX = 0.125f * LOG2E;
constexpr int N_IN0 = 1536, N_IN1 = 3328;
constexpr int LISTCAP = 32768;
constexpr int HROWS = 212992;

constexpr size_t MiB = 1u << 20;
constexpr size_t WS_CTL = 0;
constexpr size_t WS_TAB = 1 * MiB;
constexpr size_t WS_COS = 2 * MiB, WS_SIN = 4 * MiB;
constexpr size_t WS_W = 6 * MiB;
constexpr size_t W_GU = WS_W + 0, W_D = WS_W + 64 * MiB, W_RHI = WS_W + 96 * MiB, W_RLO = W_RHI + 128 * 1024,
                 W_SGU = WS_W + 97 * MiB, W_SD = WS_W + 98 * MiB, W_IN = WS_W + 99 * MiB, W_OUT = WS_W + 106 * MiB,
                 W_UQ = WS_W + 108 * MiB, W_UKV = WS_W + 108 * MiB + 512 * 1024;
constexpr size_t WS_XB = 116 * MiB;
constexpr size_t WS_BIG = 180 * MiB;
constexpr size_t B_UPRE = WS_BIG, B_QL = WS_BIG + 32 * MiB, B_KVL = WS_BIG + 48 * MiB, B_Q0 = WS_BIG + 64 * MiB, B_K0 = WS_BIG + 112 * MiB,
                 B_V0 = WS_BIG + 160 * MiB, B_UO = WS_BIG + 192 * MiB;
constexpr size_t B_Q1 = WS_BIG, B_K1 = WS_BIG + 64 * MiB, B_V1 = WS_BIG + 128 * MiB, B_O1 = WS_BIG + 192 * MiB, B_GL = WS_BIG + 256 * MiB, B_CK = WS_BIG + 258 * MiB;
constexpr size_t B_H = WS_BIG, B_SH = WS_BIG + 104 * MiB, B_YT = WS_BIG + 120 * MiB, B_LIST = WS_BIG + 312 * MiB, B_TOKW = WS_BIG + 320 * MiB;
constexpr size_t WS_END = WS_BIG + 321 * MiB;

struct Args { const void* in[42]; float* out; unsigned char* ws; };

DI unsigned pk2(float lo, float hi) { f32x2_t v = {lo, hi}; bf16x2_t b = __builtin_convertvector(v, bf16x2_t); return __builtin_bit_cast(unsigned, b); }
DI float bf2f(unsigned short b) { return __uint_as_float(((unsigned)b) << 16); }
DI unsigned short f2bf(float f) { return (unsigned short)(pk2(f, 0.f) & 0xffffu); }
DI float sigmoidf_(float x) { return 1.0f / (1.0f + __expf(-x)); }
DI float siluf_(float x) { return x * sigmoidf_(x); }
DI float wave_sum(float v) {
#pragma unroll
    for (int o = 1; o < 64; o <<= 1) v += __shfl_xor(v, o);
    return v;
}
DI int crow(int r, int hi) { return (r & 3) + 8 * (r >> 2) + 4 * hi; }
DI f32x16 mfma32(bf16x8 a, bf16x8 b, f32x16 c) { return __builtin_amdgcn_mfma_f32_32x32x16_bf16(a, b, c, 0, 0, 0); }
DI f32x4 mfma16(bf16x8 a, bf16x8 b, f32x4 c) { return __builtin_amdgcn_mfma_f32_16x16x32_bf16(a, b, c, 0, 0, 0); }
DI u32x2 pk4(f32x4 v) { u32x2 r; r.x = pk2(v[0], v[1]); r.y = pk2(v[2], v[3]); return r; }

DI int map_ident(int n) { return n; }
DI int map_gu(int n) { const int tile = n >> 8, w = n & 255, half = w >> 7, idx = tile * 128 + (w & 127); return idx | (half << 20); }
DI int map_in0(int n) {
    const int tile = n >> 8, w = n & 255;
    if (tile < 4) { const int half = w >> 7, idx = tile * 128 + (w & 127); return half * 512 + idx; }
    if (tile == 4) return 1024 + w;
    if (w < 128) return 1280 + w;
    if (w < 160) { const int i = w - 128; return 1408 + (i & 1) * 16 + (i >> 1); }
    return -1;
}
DI int map_q(int n) { const int h = n / 96, d = n % 96; if (d < 64) return h * 96 + d; const int i = d - 64; return h * 96 + 64 + (i & 1) * 16 + (i >> 1); }
DI int map_kv(int n) {
    if (n < 768) { const int h = n / 96, d = n % 96; if (d < 64) return h * 128 + d; return -2 - (128 + d - 64); }
    const int m = n - 768; return (m >> 6) * 128 + 64 + (m & 63);
}
DI int map_in1(int n) { return n < 3088 ? n : -1; }

template <class MapF>
DI void prep_item(const float* W0, const float* W1, int ldw, int Ksrc, const float* gk, bf16_t* WT, int Kout, int Nout, MapF map, LAS float* scr, int item, int lane) {
    const int nblk = Nout / 32, kb = item / nblk, nb = item % nblk, k0 = 64 * kb, n0 = 32 * nb;
    const int sc = map(n0 + (lane & 31));
    const float* W = (sc >= 0 && (sc >> 20)) ? W1 : W0; const int col = sc & 0xFFFFF;
#pragma unroll 8
    for (int i = 0; i < 32; ++i) {
        const int kk = 2 * i + (lane >> 5), k = k0 + kk; float v = 0.f;
        if (sc >= 0) { if (k < Ksrc) { v = W[(size_t)k * ldw + col]; if (gk) v *= gk[k]; } }
        else if (sc <= -2) v = (k == -2 - sc) ? 1.f : 0.f;
        scr[kk * 33 + (lane & 31)] = v;
    }
    asm volatile("s_waitcnt lgkmcnt(0)" ::: "memory");
    const int c = lane & 7;
#pragma unroll
    for (int j = 0; j < 4; ++j) {
        const int n = (lane >> 3) + 8 * j; const LAS float* s = scr + (8 * c) * 33 + n;
        u32x4 o; o.x = pk2(s[0 * 33], s[1 * 33]); o.y = pk2(s[2 * 33], s[3 * 33]); o.z = pk2(s[4 * 33], s[5 * 33]); o.w = pk2(s[6 * 33], s[7 * 33]);
        *(u32x4*)(WT + (size_t)(n0 + n) * Kout + k0 + 8 * c) = o;
    }
    asm volatile("s_waitcnt lgkmcnt(0)" ::: "memory");
}

DI void prep_moe(const Args& a, int ib, LAS float* scr, int gw, int ngw, int lane, int gtid, int gthreads) {
    unsigned char* ws = a.ws;
    constexpr int I_GU = (1024 / 64) * (512 / 32), I_D = (256 / 64) * (1024 / 32);
    const int NIT = NEXP * (I_GU + I_D) + I_GU + I_D;
    for (int it = gw; it < NIT; it += ngw) {
        int r = it;
        if (r < NEXP * I_GU) { const int e = r / I_GU; r %= I_GU;
            prep_item((const float*)a.in[ib + 2] + (size_t)e * 1024 * 256, (const float*)a.in[ib + 3] + (size_t)e * 1024 * 256, 256, 1024, nullptr, (bf16_t*)(ws + W_GU) + (size_t)e * 512 * 1024, 1024, 512, map_gu, scr, r, lane); continue; }
        r -= NEXP * I_GU;
        if (r < NEXP * I_D) { const int e = r / I_D; r %= I_D;
            prep_item((const float*)a.in[ib + 4] + (size_t)e * 256 * 1024, nullptr, 1024, 256, nullptr, (bf16_t*)(ws + W_D) + (size_t)e * 1024 * 256, 256, 1024, map_ident, scr, r, lane); continue; }
        r -= NEXP * I_D;
        if (r < I_GU) { prep_item((const float*)a.in[ib + 5], (const float*)a.in[ib + 6], 256, 1024, nullptr, (bf16_t*)(ws + W_SGU), 1024, 512, map_gu, scr, r, lane); continue; }
        r -= I_GU;
        prep_item((const float*)a.in[ib + 7], nullptr, 1024, 256, nullptr, (bf16_t*)(ws + W_SD), 256, 1024, map_ident, scr, r, lane);
    }
    const float* rw = (const float*)a.in[ib];
    bf16_t* rhi = (bf16_t*)(ws + W_RHI); bf16_t* rlo = (bf16_t*)(ws + W_RLO);
    for (int idx = gtid; idx < 64 * 1024; idx += gthreads) { const int n = idx >> 10, k = idx & 1023; const float v = rw[k * 64 + n]; const unsigned short h = f2bf(v); rhi[idx] = h; rlo[idx] = f2bf(v - bf2f(h)); }
}

constexpr int SG_LDS = 49152;
namespace pg8 {
constexpr int BM = 256, BK = 64, HALF = 128, HTB = HALF * BK * 2, STAGE_BYTES = 8 * HTB, NXCD = 8, WGM = 8;
DI int lds_byte(int r, int c) { const int st = (r >> 4) * 2 + (c >> 5), rr = r & 15, cc = c & 31, ob = rr * 64 + cc * 2; return st * 1024 + (ob ^ (((ob >> 9) & 1) << 5)); }
DI void stage_rc(int b, int& R, int& C) { const int st = b / 1024, sb = b % 1024, swz = sb ^ (((sb >> 9) & 1) << 5); R = (st >> 1) * 16 + swz / 64; C = (st & 1) * 32 + (swz % 64) / 2; }
DI int perm32(int rho) { const int n = rho >> 4, i = rho & 15; return 8 * (i >> 2) + 4 * n + (i & 3); }
struct Unit { int pm, pn, e; };

struct DenseOrder {
    int nM, nN, nwg, G, c; const char* Bt; size_t tstepB;
    DI void init(int M, int N, int K, const bf16_t* Bt_, int G_, int c_) { nM = M / BM; nN = N / BM; nwg = nM * nN; G = G_; c = c_; Bt = (const char*)Bt_; tstepB = (size_t)BM * K * 2; }
    DI bool next(int i, Unit& u) const {
        const long L = (long)i * G + c; if (L >= nwg) return false;
        int wgid = (int)L; { const int q = nwg / NXCD, r = nwg % NXCD, xcd = wgid % NXCD, off = wgid / NXCD; wgid = (xcd < r ? xcd * (q + 1) : r * (q + 1) + (xcd - r) * q) + off; }
        const int nig = WGM * nN, gid = wgid / nig, fm = gid * WGM, gsz = (nM - fm) < WGM ? (nM - fm) : WGM;
        u.pm = fm + ((wgid % nig) % gsz); u.pn = (wgid % nig) / gsz; u.e = 0; return true;
    }
    DI const char* bptr(const Unit& u) const { return Bt + (size_t)u.pn * tstepB; }
    static constexpr bool GATHER_A = false;
    DI const int* lptr(const Unit&) const { return nullptr; }
    DI int lcnt(const Unit&) const { return 0; }
    DI unsigned arow0(const Unit& u) const { return (unsigned)(u.pm * BM); }
    DI unsigned arow(const Unit& u, int rt) const { return (unsigned)(u.pm * BM + rt); }
};
DI int find_expert(const LAS int* tstart, int tile) { int e = 0;
#pragma unroll
    for (int s = 32; s > 0; s >>= 1) if (tstart[e + s] <= tile) e += s;
    return e; }
template <bool GATHER> struct GroupedOrder {
    const LAS int* tstart; const LAS int* cntl; int NT, G, c; const char* Bt; size_t estepB, tstepB; const int* LIST;
    DI bool next(int i, Unit& u) const {
        const int L = i * G + c; if (L >= tstart[NEXP] * NT) return false;
        const int tile = L / NT; u.pn = L - tile * NT; u.e = find_expert(tstart, tile); u.pm = tile - tstart[u.e]; return true;
    }
    DI const char* bptr(const Unit& u) const { return Bt + (size_t)u.e * estepB + (size_t)u.pn * tstepB; }
    static constexpr bool GATHER_A = GATHER;
    DI const int* lptr(const Unit& u) const { return LIST + (size_t)u.e * LISTCAP + u.pm * BM; }
    DI int lcnt(const Unit& u) const { return cntl[u.e] - u.pm * BM; }
    DI unsigned arow0(const Unit& u) const { return (unsigned)((tstart[u.e] + u.pm) * BM); }
    DI unsigned arow(const Unit& u, int rt) const {
        if (GATHER) { int i = u.pm * BM + rt; i = i < cntl[u.e] ? i : u.pm * BM; return (unsigned)(LIST[(size_t)u.e * LISTCAP + i] >> 3); }
        return (unsigned)((tstart[u.e] + u.pm) * BM + rt);
    }
};
template <class F> struct EpiFn {
    F f;
    DI void operator()(const f32x4 (&acc)[2][2][4][2], const Unit& u, int wr, int wc, int fr, int fq) const {
#pragma unroll
        for (int ai = 0; ai < 2; ++ai)
#pragma unroll
            for (int m = 0; m < 4; ++m) { int r_ = ai * HALF + wr * 64 + m * 16 + fr; asm volatile("" : "+v"(r_));
                f(u, r_, wc * 32 + 8 * fq, acc[ai][0][m][0], acc[ai][0][m][1], acc[ai][1][m][0], acc[ai][1][m][1]); asm volatile("" ::: "memory"); }
    }
};
template <class F> DI EpiFn<F> make_epi(const F& f) { return EpiFn<F>{f}; }

template <class Epi, class Sched>
DI void gemm_phase(LAS unsigned char* lds, const bf16_t* Abase, const int K, const Sched& S, const Epi& E) {
    int tid_ = threadIdx.x; asm volatile("" : "+v"(tid_));
    const int tid = tid_, wid = __builtin_amdgcn_readfirstlane(tid >> 6), lane = tid & 63, wr = wid >> 2, wc = wid & 3, fr = lane & 15, fq = lane >> 4;
    const int nt = K / BK;
    unsigned voffB[2];
#pragma unroll
    for (int i = 0; i < 2; ++i) { int R_, C_; stage_rc(tid * 16 + i * 8192, R_, C_); const int Rb = (R_ & ~31) + perm32(R_ & 31); voffB[i] = (unsigned)(Rb * K + C_) * 2u; }
    const size_t kstep = (size_t)(BK * 2);
    const size_t hstep = (size_t)HALF * K * 2;
    const unsigned ldsw = (unsigned)wid * 1024u;
    const int aoff = lds_byte(wr * 64 + fr, fq * 8), boff = lds_byte(wc * 32 + fr, fq * 8);
#define PG8_SA(b, h) (((b) * 2 + (h)) * HTB)
#define PG8_SB(b, h) ((4 + (b) * 2 + (h)) * HTB)
#define PG8_STAGE(bufoff, gbase, voff) do { _Pragma("unroll") for (int _i = 0; _i < 2; ++_i) \
        __builtin_amdgcn_global_load_lds((const unsigned*)((const char*)(gbase) + (voff)[_i]), (LAS unsigned*)(lds + (bufoff) + ldsw + _i * 8192), 16, 0, 0); } while (0)
#define PG8_LDA(dst, b, h) do { _Pragma("unroll") for (int m = 0; m < 4; ++m) _Pragma("unroll") for (int k = 0; k < 2; ++k) dst[m][k] = *(const LAS bf16x8*)(lds + PG8_SA(b, h) + aoff + m * 2048 + k * 1024); } while (0)
#define PG8_LDB(dst, b, h) do { _Pragma("unroll") for (int n = 0; n < 2; ++n) _Pragma("unroll") for (int k = 0; k < 2; ++k) dst[n][k] = *(const LAS bf16x8*)(lds + PG8_SB(b, h) + boff + n * 2048 + k * 1024); } while (0)
#define PG8_MMA(ai, bj, At, Bt) do { __builtin_amdgcn_s_setprio(1); _Pragma("unroll") for (int m = 0; m < 4; ++m) _Pragma("unroll") for (int n = 0; n < 2; ++n) _Pragma("unroll") for (int k = 0; k < 2; ++k) \
        acc[ai][bj][m][n] = __builtin_amdgcn_mfma_f32_16x16x32_bf16(Bt[n][k], At[m][k], acc[ai][bj][m][n], 0, 0, 0); __builtin_amdgcn_s_setprio(0); } while (0)
#define PG8_WAIT_V(n) asm volatile("s_waitcnt vmcnt(" #n ")" ::: "memory")
#define PG8_WAIT_L(n) asm volatile("s_waitcnt lgkmcnt(" #n ")" ::: "memory")
#define PG8_BAR __builtin_amdgcn_s_barrier()
#define PG8_SCHED __builtin_amdgcn_sched_barrier(0)
#define PG8_AOFFS(dst, u) do { _Pragma("unroll") for (int _i = 0; _i < 2; ++_i) { int R_, C_; stage_rc(tid * 16 + _i * 8192, R_, C_); _Pragma("unroll") for (int _h = 0; _h < 2; ++_h) dst[_h][_i] = (S.arow(u, _h * HALF + R_) * (unsigned)K + (unsigned)C_) * 2u; } } while (0)
    Unit cur, nxt; int ui = 0;
    if (!S.next(0, cur)) return;
    f32x4 acc[2][2][4][2];
#pragma unroll
    for (int a = 0; a < 2; ++a)
#pragma unroll
        for (int b = 0; b < 2; ++b)
#pragma unroll
            for (int m = 0; m < 4; ++m)
#pragma unroll
                for (int n = 0; n < 2; ++n) acc[a][b][m][n] = (f32x4){0.f, 0.f, 0.f, 0.f};
    bf16x8 At[4][2], B0[2][2], B1[2][2];
    constexpr bool GA = Sched::GATHER_A;
    unsigned vcur[2][2], vnxt[2][2];
    const char* const Ab = (const char*)Abase;
    const char* cA = Ab;
    if constexpr (GA) { PG8_AOFFS(vcur, cur); }
    else {
#pragma unroll
        for (int i = 0; i < 2; ++i) { int R_, C_; stage_rc(tid * 16 + i * 8192, R_, C_); vcur[0][i] = (unsigned)(R_ * K + C_) * 2u; vcur[1][i] = vcur[0][i]; }
        cA = Ab + (size_t)S.arow0(cur) * K * 2;
    }
    const size_t ah = GA ? (size_t)0 : hstep;
    const char* cB = S.bptr(cur);
    PG8_STAGE(PG8_SB(0, 0), cB, voffB); PG8_STAGE(PG8_SB(0, 1), cB + hstep, voffB); PG8_STAGE(PG8_SA(0, 0), cA, vcur[0]); PG8_STAGE(PG8_SA(0, 1), cA + ah, vcur[1]);
    if (wr == 1) PG8_BAR;
    PG8_WAIT_V(2); PG8_BAR;
    PG8_STAGE(PG8_SB(1, 0), cB + kstep, voffB); PG8_STAGE(PG8_SA(1, 0), cA + kstep, vcur[0]); PG8_STAGE(PG8_SB(1, 1), cB + hstep + kstep, voffB);
    PG8_WAIT_V(6); PG8_BAR;
    for (;;) {
        const bool has_next = S.next(ui + 1, nxt);
        const char* nB = cB; const char* nA = cA;
        if (has_next) { nB = S.bptr(nxt);
            if constexpr (GA) {
                const int* lp_ = S.lptr(nxt); const int cn_ = S.lcnt(nxt);
#pragma unroll
                for (int i = 0; i < 2; ++i) { int R_, C_; stage_rc(tid * 16 + i * 8192, R_, C_);
#pragma unroll
                    for (int h = 0; h < 2; ++h) { int rt_ = h * HALF + R_; rt_ = rt_ < cn_ ? rt_ : 0; const int* p_ = lp_ + rt_; asm volatile("global_load_dword %0, %1, off" : "=v"(vnxt[h][i]) : "v"(p_) : "memory"); } }
            } else nA = Ab + (size_t)S.arow0(nxt) * K * 2; }
        else if constexpr (GA) {
#pragma unroll
            for (int h = 0; h < 2; ++h)
#pragma unroll
                for (int i = 0; i < 2; ++i) vnxt[h][i] = vcur[h][i];
        }
#pragma unroll 1
        for (int t = 0; t < nt; t += 2) {
            const bool last = (t == nt - 2);
            const char* a1 = cA + (size_t)(t + 1) * kstep;
            const char* a2 = last ? nA : cA + (size_t)(t + 2) * kstep; const char* b2 = last ? nB : cB + (size_t)(t + 2) * kstep;
            const char* a3 = a2 + kstep; const char* b3 = b2 + kstep;
            if constexpr (GA) { if (last && has_next) {
                asm volatile("" : "+v"(vnxt[0][0]), "+v"(vnxt[0][1]), "+v"(vnxt[1][0]), "+v"(vnxt[1][1]));
#pragma unroll
                for (int i = 0; i < 2; ++i) { int R_, C_; stage_rc(tid * 16 + i * 8192, R_, C_);
#pragma unroll
                    for (int h = 0; h < 2; ++h) vnxt[h][i] = ((vnxt[h][i] >> 3) * (unsigned)K + (unsigned)C_) * 2u; } } }
            unsigned v2[2][2];
#pragma unroll
            for (int h = 0; h < 2; ++h)
#pragma unroll
                for (int i = 0; i < 2; ++i) v2[h][i] = (GA && last) ? vnxt[h][i] : vcur[h][i];
            PG8_LDB(B0, 0, 0); PG8_LDB(B1, 0, 1); PG8_SCHED; PG8_LDA(At, 0, 0); PG8_STAGE(PG8_SA(1, 1), a1 + ah, vcur[1]);
            PG8_WAIT_V(8); PG8_WAIT_L(0); PG8_BAR; PG8_MMA(0, 0, At, B0); PG8_MMA(0, 1, At, B1); PG8_BAR; PG8_SCHED;
            PG8_LDA(At, 0, 1); PG8_STAGE(PG8_SB(0, 0), b2, voffB); PG8_STAGE(PG8_SB(0, 1), b2 + hstep, voffB); PG8_STAGE(PG8_SA(0, 0), a2, v2[0]);
            PG8_WAIT_V(8); PG8_WAIT_L(0); PG8_BAR; PG8_MMA(1, 0, At, B0); PG8_MMA(1, 1, At, B1); PG8_BAR; PG8_SCHED;
            PG8_LDB(B0, 1, 0); PG8_LDB(B1, 1, 1); PG8_SCHED; PG8_LDA(At, 1, 0); PG8_STAGE(PG8_SA(0, 1), a2 + ah, v2[1]);
            PG8_WAIT_V(8); PG8_WAIT_L(0); PG8_BAR; PG8_MMA(0, 0, At, B0); PG8_MMA(0, 1, At, B1); PG8_BAR; PG8_SCHED;
            PG8_LDA(At, 1, 1); PG8_STAGE(PG8_SB(1, 0), b3, voffB); PG8_STAGE(PG8_SB(1, 1), b3 + hstep, voffB); PG8_STAGE(PG8_SA(1, 0), a3, v2[0]);
            PG8_WAIT_V(8); PG8_WAIT_L(0); PG8_BAR; PG8_MMA(1, 0, At, B0); PG8_MMA(1, 1, At, B1); PG8_BAR; PG8_SCHED;
        }
        if (wr == 0) PG8_BAR;
        { int fr_ = fr, fq_ = fq; asm volatile("" : "+v"(fr_), "+v"(fq_));
          E(acc, cur, wr, wc, fr_, fq_); }
        if (!has_next) break;
#pragma unroll
        for (int a = 0; a < 2; ++a)
#pragma unroll
            for (int b = 0; b < 2; ++b)
#pragma unroll
                for (int m = 0; m < 4; ++m)
#pragma unroll
                    for (int n = 0; n < 2; ++n) acc[a][b][m][n] = (f32x4){0.f, 0.f, 0.f, 0.f};
        cur = nxt; cB = nB; cA = nA; ++ui;
        if constexpr (GA) {
#pragma unroll
            for (int h = 0; h < 2; ++h)
#pragma unroll
                for (int i = 0; i < 2; ++i) vcur[h][i] = vnxt[h][i];
        }
        if (wr == 1) PG8_BAR;
    }
    PG8_WAIT_V(0);
    PG8_BAR;
#undef PG8_SA
#undef PG8_SB
#undef PG8_STAGE
#undef PG8_LDA
#undef PG8_LDB
#undef PG8_MMA
#undef PG8_WAIT_V
#undef PG8_WAIT_L
#undef PG8_BAR
#undef PG8_SCHED
#undef PG8_AOFFS
}
}
DI u32x4 pk8(f32x4 a, f32x4 b) { u32x4 o; o.x = pk2(a[0], a[1]); o.y = pk2(a[2], a[3]); o.z = pk2(b[0], b[1]); o.w = pk2(b[2], b[3]); return o; }
DI float dot4(f32x4 a) { return (a[0] * a[0] + a[1] * a[1]) + (a[2] * a[2] + a[3] * a[3]); }
DI void rope8(f32x4& v0, f32x4& v1, const float* ct, const float* st, size_t row, int p) {
    const f32x4 cs = *(const f32x4*)(ct + row * 16 + p), sn = *(const f32x4*)(st + row * 16 + p);
    float a, b;
    a = v0[0]; b = v0[1]; v0[0] = a * cs[0] - b * sn[0]; v0[1] = b * cs[0] + a * sn[0];
    a = v0[2]; b = v0[3]; v0[2] = a * cs[1] - b * sn[1]; v0[3] = b * cs[1] + a * sn[1];
    a = v1[0]; b = v1[1]; v1[0] = a * cs[2] - b * sn[2]; v1[1] = b * cs[2] + a * sn[2];
    a = v1[2]; b = v1[3]; v1[2] = a * cs[3] - b * sn[3]; v1[3] = b * cs[3] + a * sn[3];
}

template <int DK, int QP, int KP, int VP, int OP, bool BIAS>
DI void attn_simple_unit(LAS unsigned char* lds, const bf16_t* Q, const bf16_t* K, const bf16_t* V, bf16_t* O, const float* CK, int b, int hq, int hv, int hc, int ho, int qb) {
    constexpr int KS = DK + 8, VS = 72;
    LAS bf16_t* Ks = (LAS bf16_t*)lds;
    LAS bf16_t* VT = (LAS bf16_t*)(lds + 64 * KS * 2);
    LAS float* ckl = (LAS float*)(lds + 64 * KS * 2 + 64 * VS * 2);
    int tid_ = threadIdx.x; asm volatile("" : "+v"(tid_));
    const int tid = tid_, lane = tid & 63, wid = tid >> 6, r32 = lane & 31, hi = lane >> 5;
    const size_t rowbase = (size_t)b * SEQ; const int q0 = qb * 256, qw = q0 + 32 * wid;
    bf16x8 qr[DK / 16];
#pragma unroll
    for (int d0 = 0; d0 < DK / 16; ++d0) qr[d0] = *(const bf16x8*)(Q + (rowbase + qw + r32) * QP + hq + 16 * d0 + 8 * hi);
    f32x16 o0, o1;
#pragma unroll
    for (int i = 0; i < 16; ++i) { o0[i] = 0.f; o1[i] = 0.f; }
    float m = -INFINITY, l = 0.f;
    const int ntile = (q0 + 256) / 64;
    for (int jt = 0; jt < ntile; ++jt) {
        const int kv0 = jt * 64;
        __syncthreads();
        for (int c = tid; c < 64 * (DK / 8); c += 512) { const int r = c / (DK / 8), ch = c % (DK / 8);
            const u32x4 v = *(const u32x4*)(K + (rowbase + kv0 + r) * KP + hq + ch * 8); *(LAS u32x4*)(Ks + r * KS + ch * 8) = v; }
        { const int r = tid >> 3, ch = tid & 7; const u32x4 v = *(const u32x4*)(V + (rowbase + kv0 + r) * VP + hv + ch * 8);
#pragma unroll
          for (int i = 0; i < 4; ++i) { VT[(ch * 8 + 2 * i) * VS + r] = (bf16_t)(v[i] & 0xffffu); VT[(ch * 8 + 2 * i + 1) * VS + r] = (bf16_t)(v[i] >> 16); } }
        if (BIAS) { if (tid < 64) ckl[tid] = CK[(rowbase + kv0 + tid) * 16 + hc]; }
        __syncthreads();
        if (kv0 <= qw + 31) {
            f32x16 p0, p1;
#pragma unroll
            for (int i = 0; i < 16; ++i) { p0[i] = 0.f; p1[i] = 0.f; }
#pragma unroll
            for (int d0 = 0; d0 < DK / 16; ++d0) {
                const bf16x8 a0 = *(LAS bf16x8*)(Ks + r32 * KS + 16 * d0 + 8 * hi), a1 = *(LAS bf16x8*)(Ks + (32 + r32) * KS + 16 * d0 + 8 * hi);
                p0 = mfma32(a0, qr[d0], p0); p1 = mfma32(a1, qr[d0], p1);
            }
            if (BIAS) {
#pragma unroll
                for (int i = 0; i < 16; ++i) { p0[i] -= ckl[crow(i, hi)]; p1[i] -= ckl[32 + crow(i, hi)]; }
            }
            if (kv0 + 63 > qw) { const int q = qw + r32;
#pragma unroll
                for (int i = 0; i < 16; ++i) { const int kv = kv0 + crow(i, hi); if (kv > q) p0[i] = -INFINITY; if (kv + 32 > q) p1[i] = -INFINITY; } }
            float rm = p0[0];
#pragma unroll
            for (int i = 0; i < 16; ++i) { rm = fmaxf(rm, p0[i]); rm = fmaxf(rm, p1[i]); }
            rm = fmaxf(rm, __shfl_xor(rm, 32));
            const float mn = fmaxf(m, rm); const float f = __builtin_amdgcn_exp2f(m - mn);
            float rs = 0.f;
#pragma unroll
            for (int i = 0; i < 16; ++i) { p0[i] = __builtin_amdgcn_exp2f(p0[i] - mn); p1[i] = __builtin_amdgcn_exp2f(p1[i] - mn); rs += p0[i] + p1[i]; }
            rs += __shfl_xor(rs, 32);
            l = l * f + rs; m = mn;
#pragma unroll
            for (int i = 0; i < 16; ++i) { const float fi = __shfl(f, crow(i, hi)); o0[i] *= fi; o1[i] *= fi; }
            bf16x8 pf[4];
            { u32x4 t;
              t.x = pk2(p0[0], p0[1]); t.y = pk2(p0[2], p0[3]); t.z = pk2(p0[4], p0[5]); t.w = pk2(p0[6], p0[7]); pf[0] = __builtin_bit_cast(bf16x8, t);
              t.x = pk2(p0[8], p0[9]); t.y = pk2(p0[10], p0[11]); t.z = pk2(p0[12], p0[13]); t.w = pk2(p0[14], p0[15]); pf[1] = __builtin_bit_cast(bf16x8, t);
              t.x = pk2(p1[0], p1[1]); t.y = pk2(p1[2], p1[3]); t.z = pk2(p1[4], p1[5]); t.w = pk2(p1[6], p1[7]); pf[2] = __builtin_bit_cast(bf16x8, t);
              t.x = pk2(p1[8], p1[9]); t.y = pk2(p1[10], p1[11]); t.z = pk2(p1[12], p1[13]); t.w = pk2(p1[14], p1[15]); pf[3] = __builtin_bit_cast(bf16x8, t); }
#pragma unroll
            for (int ks = 0; ks < 4; ++ks) {
                { const s16x4 lo = *(LAS s16x4*)(VT + r32 * VS + 16 * ks + 4 * hi), hh = *(LAS s16x4*)(VT + r32 * VS + 16 * ks + 8 + 4 * hi);
                  const bf16x8 vf = __builtin_shufflevector(lo, hh, 0, 1, 2, 3, 4, 5, 6, 7); o0 = mfma32(pf[ks], vf, o0); }
                { const s16x4 lo = *(LAS s16x4*)(VT + (32 + r32) * VS + 16 * ks + 4 * hi), hh = *(LAS s16x4*)(VT + (32 + r32) * VS + 16 * ks + 8 + 4 * hi);
                  const bf16x8 vf = __builtin_shufflevector(lo, hh, 0, 1, 2, 3, 4, 5, 6, 7); o1 = mfma32(pf[ks], vf, o1); }
            }
        }
    }
    const float inv = 1.0f / l;
#pragma unroll
    for (int i = 0; i < 16; ++i) { const float ii = __shfl(inv, crow(i, hi)); const size_t row = rowbase + qw + crow(i, hi);
        O[row * OP + ho + r32] = f2bf(o0[i] * ii); O[row * OP + ho + 32 + r32] = f2bf(o1[i] * ii); }
}

DI void ln_rows(const float* src, const float* g, const float* b, float* dst, bf16_t* xb, int gw, int ngw, int lane) {
    f32x4 gv[4], bv[4];
#pragma unroll
    for (int j = 0; j < 4; ++j) { gv[j] = *(const f32x4*)(g + lane * 4 + 256 * j); bv[j] = *(const f32x4*)(b + lane * 4 + 256 * j); }
    for (int row = gw; row < NTOK; row += ngw) {
        f32x4 v[4]; float s = 0.f;
#pragma unroll
        for (int j = 0; j < 4; ++j) { v[j] = *(const f32x4*)(src + (size_t)row * DM + lane * 4 + 256 * j); s += (v[j][0] + v[j][1]) + (v[j][2] + v[j][3]); }
        const float mean = wave_sum(s) * (1.f / DM); float s2 = 0.f;
#pragma unroll
        for (int j = 0; j < 4; ++j) { v[j] = v[j] - mean; s2 += (v[j][0] * v[j][0] + v[j][1] * v[j][1]) + (v[j][2] * v[j][2] + v[j][3] * v[j][3]); }
        const float rstd = 1.0f / sqrtf(wave_sum(s2) * (1.f / DM) + LN_EPS);
#pragma unroll
        for (int j = 0; j < 4; ++j) { const f32x4 y = v[j] * rstd * gv[j] + bv[j];
            if (dst) *(f32x4*)(dst + (size_t)row * DM + lane * 4 + 256 * j) = y;
            if (xb) *(u32x2*)(xb + (size_t)row * DM + lane * 4 + 256 * j) = pk4(y); }
    }
}

DI void moe_tables(const unsigned* cnt, LAS int* tstart, LAS int* cntl) {
    __syncthreads();
    if (threadIdx.x == 0) {
        int t = 0;
        for (int e = 0; e < NEXP; ++e) { const int c = (int)cnt[e]; cntl[e] = c; tstart[e] = t; t += (c + 255) >> 8; }
        tstart[NEXP] = t;
    }
    __syncthreads();
}

#define XB_TMO      128
#define XB_XCNT(j)  (256  + 64 * (j))
#define XB_XSUB(j)  (1280 + 64 * (j))
#define XB_XGEN(j)  (2304 + 64 * (j))
#define XB_TOP      3328
#define XB_TOPGEN   3392
#define XCD_BAR_WORDS 3456
#define XB_SPIN_CAP (1u << 18)
__device__ __forceinline__ unsigned xb_ld(unsigned* p)              { return __hip_atomic_load(p, __ATOMIC_RELAXED, __HIP_MEMORY_SCOPE_AGENT); }
__device__ __forceinline__ unsigned xb_add(unsigned* p, unsigned v) { return __hip_atomic_fetch_add(p, v, __ATOMIC_RELAXED, __HIP_MEMORY_SCOPE_AGENT); }
__device__ __forceinline__ unsigned xb_xcc_id() { return (unsigned)__builtin_amdgcn_s_getreg((3 << 11) | 20) & 0xFu; }
#define XB_SPIN(cond, bar) do { unsigned _sp = 0; while (cond) { __builtin_amdgcn_s_sleep(1); \
    if ((++_sp & 255u) == 0u) { if (xb_ld(&(bar)[XB_TMO])) break; if (_sp > XB_SPIN_CAP) { atomicAdd(&(bar)[XB_TMO], 1u); break; } } } } while (0)
struct XcdBarrier { unsigned* bar; unsigned x; volatile LAS unsigned* st; };
__device__ __forceinline__ XcdBarrier xcd_barrier_post(unsigned* bar, volatile LAS unsigned* st) {
    XcdBarrier b; b.bar = bar; b.x = xb_xcc_id(); b.st = st;
    if (threadIdx.x == 0) (void)xb_add(&bar[XB_XCNT(b.x)], 1u);
    return b;
}
__device__ __forceinline__ void xcd_barrier_complete(unsigned* bar, unsigned x, unsigned& nloc, unsigned& nx) {
    const unsigned G = gridDim.x * gridDim.y * gridDim.z;
    unsigned sum, cnt, mine, sp = 0u;
    for (;;) {
        sum = 0u; cnt = 0u; mine = 0u;
#pragma unroll
        for (unsigned j = 0; j < 16; ++j) { const unsigned c = xb_ld(&bar[XB_XCNT(j)]); sum += c; cnt += (c > 0u) ? 1u : 0u; mine = (j == x) ? c : mine; }
        if (sum == G) break;
        __builtin_amdgcn_s_sleep(1);
        if ((++sp & 255u) == 0u) { if (xb_ld(&bar[XB_TMO])) break; if (sp > XB_SPIN_CAP) { atomicAdd(&bar[XB_TMO], 1u); break; } }
    }
    nloc = mine > 0u ? mine : 1u; nx = cnt > 0u ? cnt : 1u;
}
__device__ __forceinline__ void xcd_barrier(const XcdBarrier& b) {
    asm volatile("s_waitcnt vmcnt(0)" ::: "memory");
    __syncthreads();
    if (threadIdx.x == 0) {
        unsigned* bar = b.bar;
        __builtin_amdgcn_s_waitcnt(0);
        unsigned nloc = b.st[0], nx = b.st[1];
        if (nloc == 0u) { xcd_barrier_complete(bar, b.x, nloc, nx); b.st[0] = nloc; b.st[1] = nx; }
        const unsigned old = xb_add(&bar[XB_XSUB(b.x)], 1u);
        const unsigned gen = old / nloc;
        if (old + 1u == (gen + 1u) * nloc) {
            __builtin_amdgcn_fence(__ATOMIC_RELEASE, "agent");
            asm volatile("s_waitcnt vmcnt(0)" ::: "memory");
            const unsigned og = xb_add(&bar[XB_TOP], 1u);
            const unsigned tg = og / nx;
            if (og + 1u == (tg + 1u) * nx) xb_add(&bar[XB_TOPGEN], 1u);
            else XB_SPIN(xb_ld(&bar[XB_TOPGEN]) == tg, bar);
            __builtin_amdgcn_fence(__ATOMIC_ACQUIRE, "agent");
            xb_add(&bar[XB_XGEN(b.x)], 1u);
            asm volatile("s_waitcnt vmcnt(0)" ::: "memory");
        } else {
            XB_SPIN(xb_ld(&bar[XB_XGEN(b.x)]) == gen, bar);
            __builtin_amdgcn_fence(__ATOMIC_ACQUIRE, "agent");
            asm volatile("s_waitcnt vmcnt(0)" ::: "memory");
        }
    }
    __syncthreads();
}

template <int PH> DI void run_phase(const Args& a, LAS unsigned char* lds) {
    int tid_ = threadIdx.x; asm volatile("" : "+v"(tid_));
    const int tid = tid_, lane = tid & 63, wid = tid >> 6;
    const int G = gridDim.x, bid = blockIdx.x;
    const int gw = bid * 8 + wid, ngw = G * 8, gtid = bid * 512 + tid, gthreads = G * 512;
    unsigned char* ws = a.ws;
    constexpr int L = (PH >= 13) ? 1 : 0;
    constexpr int IB_MOE = L ? 32 : 16;
    unsigned* cnt = (unsigned*)(ws + WS_CTL) + 64 * L;
    bf16_t* XB = (bf16_t*)(ws + WS_XB);
    LAS unsigned char* misc = lds + 131072;
    LAS int* tstart = (LAS int*)misc; LAS int* cntl = tstart + 72;
    float* SSQ_Q = (float*)(ws + WS_CTL + 256 * 1024); float* SSQ_KV = (float*)(ws + WS_TAB + 128 * 1024);

    if constexpr (PH == 0) {
        LAS float* scr = (LAS float*)(lds + wid * 8448);
        constexpr int I_IN = (1024 / 64) * (N_IN0 / 32), I_UQ = (256 / 64) * (768 / 32), I_UKV = (256 / 64) * (1280 / 32), I_OUT = (1024 / 64) * (1024 / 32);
        for (int it = gw; it < I_IN + I_UQ + I_UKV + I_OUT; it += ngw) {
            int r = it;
            if (r < I_IN) { prep_item((const float*)a.in[2], nullptr, 1440, 1024, nullptr, (bf16_t*)(ws + W_IN), 1024, N_IN0, map_in0, scr, r, lane); continue; } r -= I_IN;
            if (r < I_UQ) { prep_item((const float*)a.in[9], nullptr, 768, 256, (const float*)a.in[8], (bf16_t*)(ws + W_UQ), 256, 768, map_q, scr, r, lane); continue; } r -= I_UQ;
            if (r < I_UKV) { prep_item((const float*)a.in[11], nullptr, 1024, 128, (const float*)a.in[10], (bf16_t*)(ws + W_UKV), 256, 1280, map_kv, scr, r, lane); continue; } r -= I_UKV;
            prep_item((const float*)a.in[12], nullptr, 1024, 1024, nullptr, (bf16_t*)(ws + W_OUT), 1024, 1024, map_ident, scr, r, lane);
        }
        prep_moe(a, 16, scr, gw, ngw, lane, gtid, gthreads);
        float* b0 = (float*)(ws + WS_TAB); float* b1 = (float*)(ws + WS_TAB + 8192);
        for (int n = gtid; n < N_IN0; n += gthreads) { const int s = map_in0(n); b0[n] = s >= 0 ? ((const float*)a.in[3])[s] : 0.f; }
        for (int n = gtid; n < N_IN1; n += gthreads) b1[n] = n < 3088 ? ((const float*)a.in[27])[n] : 0.f;
        float* ct = (float*)(ws + WS_COS); float* st = (float*)(ws + WS_SIN); const int* pos = (const int*)a.in[1];
        for (int idx = gtid; idx < NTOK * 16; idx += gthreads) {
            const int t = idx >> 4, p = idx & 15;
            const float inv = 1.0f / exp2f((float)p * (13.287712379549449f / 16.0f));
            const float ang = (float)pos[t] * inv;
            double rev = (double)ang * 0.15915494309189535; rev -= rint(rev);
            ct[idx] = __builtin_amdgcn_cosf((float)rev); st[idx] = __builtin_amdgcn_sinf((float)rev);
        }
        const float* x = (const float*)a.in[0];
        for (int idx = gtid; idx < NTOK * DM / 8; idx += gthreads) {
            const f32x4 v0 = *(const f32x4*)(x + (size_t)idx * 8), v1 = *(const f32x4*)(x + (size_t)idx * 8 + 4);
            u32x4 o; o.x = pk2(v0[0], v0[1]); o.y = pk2(v0[2], v0[3]); o.z = pk2(v1[0], v1[1]); o.w = pk2(v1[2], v1[3]);
            *(u32x4*)(XB + (size_t)idx * 8) = o;
        }
    }
    else if constexpr (PH == 1) {
        const bf16_t* Bt = (const bf16_t*)(ws + W_IN); const float* bias = (const float*)(ws + WS_TAB);
        bf16_t* UPRE = (bf16_t*)(ws + B_UPRE); bf16_t* QL = (bf16_t*)(ws + B_QL); bf16_t* KVL = (bf16_t*)(ws + B_KVL);
        pg8::DenseOrder S; S.init(NTOK, N_IN0, 1024, Bt, G, bid);
        auto f = [=](const pg8::Unit& u, int r, int c, f32x4 l0, f32x4 l1, f32x4 h0, f32x4 h1) {
            const int nt = u.pn; const size_t row = (size_t)u.pm * 256 + r;
            l0 = l0 + *(const f32x4*)(bias + nt * 256 + c); l1 = l1 + *(const f32x4*)(bias + nt * 256 + c + 4);
            h0 = h0 + *(const f32x4*)(bias + nt * 256 + 128 + c); h1 = h1 + *(const f32x4*)(bias + nt * 256 + 128 + c + 4);
            if (nt < 4) {
#pragma unroll
                for (int i = 0; i < 4; ++i) { l0[i] = l0[i] * sigmoidf_(h0[i]); l1[i] = l1[i] * sigmoidf_(h1[i]); }
                *(u32x4*)(UPRE + row * 512 + nt * 128 + c) = pk8(l0, l1);
            } else {
                bf16_t* dst = QL + (size_t)(nt - 4) * (B_KVL - B_QL) / 2;
                *(u32x4*)(dst + row * 256 + c) = pk8(l0, l1); *(u32x4*)(dst + row * 256 + 128 + c) = pk8(h0, h1);
                float ss = dot4(l0) + dot4(l1); if (nt == 4) ss += dot4(h0) + dot4(h1);
                ss += __shfl_xor(ss, 16); ss += __shfl_xor(ss, 32);
                if ((lane >> 4) == 0) { if (nt == 4) SSQ_Q[row * 4 + (c >> 5)] = ss; else SSQ_KV[row * 4 + (c >> 5)] = ss; }
            }
        };
        pg8::gemm_phase(lds, XB, 1024, S, pg8::make_epi(f));
    }
    else if constexpr (PH == 2) {
        const bf16_t* UPRE = (const bf16_t*)(ws + B_UPRE); bf16_t* UO = (bf16_t*)(ws + B_UO);
        {
            const float* cw = (const float*)a.in[4]; const float* cb = (const float*)a.in[5]; const float* lg = (const float*)a.in[6]; const float* lb = (const float*)a.in[7];
            LAS bf16_t* U = (LAS bf16_t*)lds;
            LAS float* CO = (LAS float*)(lds + 94 * 512 * 2);
            float w[31];
#pragma unroll
            for (int j = 0; j < 31; ++j) w[j] = cw[j * 512 + tid];
            const float bch = cb[tid];
            f32x4 g0 = *(const f32x4*)(lg + lane * 8), g1 = *(const f32x4*)(lg + lane * 8 + 4), b0 = *(const f32x4*)(lb + lane * 8), b1 = *(const f32x4*)(lb + lane * 8 + 4);
            for (int u = bid; u < NTOK / 64; u += G) {
                const int tok0 = u * 64, s0 = tok0 % SEQ;
                __syncthreads();
                for (int c = tid; c < 94 * 64; c += 512) { const int r = c >> 6, ch = c & 63; const int s = s0 - 30 + r;
                    u32x4 v = (u32x4){0u, 0u, 0u, 0u}; if (s >= 0) v = *(const u32x4*)(UPRE + (size_t)(tok0 - 30 + r) * 512 + ch * 8);
                    *(LAS u32x4*)(U + r * 512 + ch * 8) = v; }
                __syncthreads();
                for (int sub = 0; sub < 4; ++sub) {
                    for (int tt = 0; tt < 16; ++tt) { const int tl = sub * 16 + tt; float acc = bch;
#pragma unroll
                        for (int j = 0; j < 31; ++j) acc += w[j] * bf2f(U[(tl + j) * 512 + tid]);
                        CO[tt * 512 + tid] = acc; }
                    __syncthreads();
#pragma unroll
                    for (int k = 0; k < 2; ++k) { const int tt = 2 * wid + k;
                        f32x4 v0 = *(LAS f32x4*)(CO + tt * 512 + lane * 8), v1 = *(LAS f32x4*)(CO + tt * 512 + lane * 8 + 4);
                        const float mean = wave_sum((v0[0] + v0[1]) + (v0[2] + v0[3]) + (v1[0] + v1[1]) + (v1[2] + v1[3])) * (1.f / 512.f);
                        v0 = v0 - mean; v1 = v1 - mean;
                        const float var = wave_sum((v0[0] * v0[0] + v0[1] * v0[1]) + (v0[2] * v0[2] + v0[3] * v0[3]) + (v1[0] * v1[0] + v1[1] * v1[1]) + (v1[2] * v1[2] + v1[3] * v1[3])) * (1.f / 512.f);
                        const float rstd = 1.0f / sqrtf(var + LN_EPS);
                        f32x4 y0 = v0 * rstd * g0 + b0, y1 = v1 * rstd * g1 + b1;
#pragma unroll
                        for (int i = 0; i < 4; ++i) { y0[i] = siluf_(y0[i]); y1[i] = siluf_(y1[i]); }
                        u32x4 o; o.x = pk2(y0[0], y0[1]); o.y = pk2(y0[2], y0[3]); o.z = pk2(y1[0], y1[1]); o.w = pk2(y1[2], y1[3]);
                        *(u32x4*)(UO + (size_t)(tok0 + sub * 16 + tt) * 1024 + lane * 8) = o; }
                    __syncthreads();
                }
            }
        }
        const float* ct = (const float*)(ws + WS_COS); const float* st = (const float*)(ws + WS_SIN);
        {
            const bf16_t* QL = (const bf16_t*)(ws + B_QL); bf16_t* Q0 = (bf16_t*)(ws + B_Q0);
            pg8::DenseOrder S; S.init(NTOK, 768, 256, (const bf16_t*)(ws + W_UQ), G, bid);
            auto f = [=](const pg8::Unit& u, int r, int c, f32x4 l0, f32x4 l1, f32x4 h0, f32x4 h1) {
                const size_t row = (size_t)u.pm * 256 + r; const f32x4 sq = *(const f32x4*)(SSQ_Q + row * 4); const float s = 1.0f / sqrtf(((sq[0] + sq[1]) + (sq[2] + sq[3])) * (1.f / 256.f) + RMS_EPS);
#pragma unroll
                for (int hh = 0; hh < 2; ++hh) { f32x4 v0 = (hh ? h0 : l0) * s, v1 = (hh ? h1 : l1) * s; const int col = u.pn * 256 + c + 128 * hh; const int d = col % 96;
                    if (d >= 64) rope8(v0, v1, ct, st, row, (d - 64) >> 1);
                    *(u32x4*)(Q0 + row * 768 + col) = pk8(v0 * C2_MLA, v1 * C2_MLA); }
            };
            pg8::gemm_phase(lds, QL, 256, S, pg8::make_epi(f));
        }
        {
            const bf16_t* KVL = (const bf16_t*)(ws + B_KVL); bf16_t* K0 = (bf16_t*)(ws + B_K0); bf16_t* V0 = (bf16_t*)(ws + B_V0);
            pg8::DenseOrder S; S.init(NTOK, 1280, 256, (const bf16_t*)(ws + W_UKV), G, bid);
            auto f = [=](const pg8::Unit& u, int r, int c, f32x4 l0, f32x4 l1, f32x4 h0, f32x4 h1) {
                const size_t row = (size_t)u.pm * 256 + r; const f32x4 sq = *(const f32x4*)(SSQ_KV + row * 4); const float s = 1.0f / sqrtf(((sq[0] + sq[1]) + (sq[2] + sq[3])) * (1.f / 128.f) + RMS_EPS);
#pragma unroll
                for (int hh = 0; hh < 2; ++hh) { f32x4 v0 = (hh ? h0 : l0), v1 = (hh ? h1 : l1); const int col = u.pn * 256 + c + 128 * hh;
                    if (col < 768) { const int d = col % 96;
                        if (d >= 64) rope8(v0, v1, ct, st, row, (d - 64) >> 1); else { v0 = v0 * s; v1 = v1 * s; }
                        *(u32x4*)(K0 + row * 768 + col) = pk8(v0, v1); }
                    else *(u32x4*)(V0 + row * 512 + (col - 768)) = pk8(v0 * s, v1 * s); }
            };
            pg8::gemm_phase(lds, KVL, 256, S, pg8::make_epi(f));
        }
    }
    else if constexpr (PH == 3) {
        const bf16_t* Q0 = (const bf16_t*)(ws + B_Q0); const bf16_t* K0 = (const bf16_t*)(ws + B_K0); const bf16_t* V0 = (const bf16_t*)(ws + B_V0); bf16_t* UO = (bf16_t*)(ws + B_UO);
        for (int u = bid; u < 64 * 16; u += G) {
            const int i = u >> 8, gp = u & 255, s = gp >> 6, bh = gp & 63, base = 4 * (i >> 1) + s, qb = (i & 1) ? 15 - base : base;
            const int b = bh >> 3, h = bh & 7;
            attn_simple_unit<96, 768, 768, 512, 1024, false>(lds, Q0, K0, V0, UO, nullptr, b, h * 96, h * 64, 0, 512 + h * 64, qb);
        }
    }
    else if constexpr (PH == 4 || PH == 16) {
        const bf16_t* A = (const bf16_t*)(ws + (L ? B_O1 : B_UO));
        const float* bias = (const float*)a.in[L ? 29 : 13]; const float* xres = L ? (const float*)a.out : (const float*)a.in[0]; float* pre = a.out;
        pg8::DenseOrder S; S.init(NTOK, 1024, 1024, (const bf16_t*)(ws + W_OUT), G, bid);
        auto f = [=](const pg8::Unit& u, int r, int c, f32x4 l0, f32x4 l1, f32x4 h0, f32x4 h1) {
            const int col = u.pn * 256 + c; const size_t off = ((size_t)u.pm * 256 + r) * 1024 + col;
            const f32x4 x0 = *(const f32x4*)(xres + off), x1 = *(const f32x4*)(xres + off + 4), x2 = *(const f32x4*)(xres + off + 128), x3 = *(const f32x4*)(xres + off + 132);
            *(f32x4*)(pre + off) = x0 * ALPHA + l0 + *(const f32x4*)(bias + col); *(f32x4*)(pre + off + 4) = x1 * ALPHA + l1 + *(const f32x4*)(bias + col + 4);
            *(f32x4*)(pre + off + 128) = x2 * ALPHA + h0 + *(const f32x4*)(bias + col + 128); *(f32x4*)(pre + off + 132) = x3 * ALPHA + h1 + *(const f32x4*)(bias + col + 132);
        };
        pg8::gemm_phase(lds, A, 1024, S, pg8::make_epi(f));
    }
    else if constexpr (PH == 5 || PH == 17) {
        ln_rows(a.out, (const float*)a.in[L ? 30 : 14], (const float*)a.in[L ? 31 : 15], a.out, XB, gw, ngw, lane);
    }
    else if constexpr (PH == 6 || PH == 18) {
        {
            const float* x1 = a.out; const bf16_t* rhi = (const bf16_t*)(ws + W_RHI); const bf16_t* rlo = (const bf16_t*)(ws + W_RLO);
            const float* rbias = (const float*)a.in[IB_MOE + 1];
            int* LIST = (int*)(ws + B_LIST); float* TOKW = (float*)(ws + B_TOKW);
            LAS unsigned char* Ah = lds; LAS unsigned char* Al = lds + 8192; LAS unsigned char* Bh = lds + 16384; LAS unsigned char* Bl = lds + 20480;
            LAS float* lgl = (LAS float*)(lds + 24576);
            LAS int* lcnt = (LAS int*)(lds + 24576 + 33280);
            LAS int* lbase = lcnt + 64;
            LAS int* sel_e = lbase + 64;
            LAS int* sel_p = sel_e + 768;
            const int fr = lane & 15, fq = lane >> 4;
            const float mybias = rbias[lane];
            for (int u = bid; u < NTOK / 128; u += G) {
                const int t0 = u * 128;
                f32x4 acc[4];
#pragma unroll
                for (int n = 0; n < 4; ++n) acc[n] = (f32x4){0.f, 0.f, 0.f, 0.f};
                const int sr = tid >> 2, sc = (tid & 3) * 8;
                for (int kt = 0; kt < 32; ++kt) {
                    const f32x4 v0 = *(const f32x4*)(x1 + (size_t)(t0 + sr) * 1024 + kt * 32 + sc), v1 = *(const f32x4*)(x1 + (size_t)(t0 + sr) * 1024 + kt * 32 + sc + 4);
                    const u32x4 wv = *(const u32x4*)((tid < 256 ? rhi : rlo) + (size_t)((tid & 255) >> 2) * 1024 + kt * 32 + (tid & 3) * 8);
                    u32x4 h, lo_;
                    h.x = pk2(v0[0], v0[1]); h.y = pk2(v0[2], v0[3]); h.z = pk2(v1[0], v1[1]); h.w = pk2(v1[2], v1[3]);
                    lo_.x = pk2(v0[0] - __uint_as_float(h.x << 16), v0[1] - __uint_as_float(h.x & 0xffff0000u));
                    lo_.y = pk2(v0[2] - __uint_as_float(h.y << 16), v0[3] - __uint_as_float(h.y & 0xffff0000u));
                    lo_.z = pk2(v1[0] - __uint_as_float(h.z << 16), v1[1] - __uint_as_float(h.z & 0xffff0000u));
                    lo_.w = pk2(v1[2] - __uint_as_float(h.w << 16), v1[3] - __uint_as_float(h.w & 0xffff0000u));
                    __syncthreads();
                    *(LAS u32x4*)(Ah + sr * 64 + sc * 2) = h; *(LAS u32x4*)(Al + sr * 64 + sc * 2) = lo_;
                    *(LAS u32x4*)((tid < 256 ? Bh : Bl) + ((tid & 255) >> 2) * 64 + (tid & 3) * 16) = wv;
                    __syncthreads();
                    const bf16x8 ah = *(LAS bf16x8*)(Ah + (16 * wid + fr) * 64 + fq * 16), al = *(LAS bf16x8*)(Al + (16 * wid + fr) * 64 + fq * 16);
#pragma unroll
                    for (int n = 0; n < 4; ++n) { const bf16x8 bh = *(LAS bf16x8*)(Bh + (16 * n + fr) * 64 + fq * 16), bl = *(LAS bf16x8*)(Bl + (16 * n + fr) * 64 + fq * 16);
                        acc[n] = mfma16(bh, ah, acc[n]); acc[n] = mfma16(bh, al, acc[n]); acc[n] = mfma16(bl, ah, acc[n]); }
                }
#pragma unroll
                for (int n = 0; n < 4; ++n)
#pragma unroll
                    for (int j = 0; j < 4; ++j) lgl[(16 * wid + fr) * 65 + 16 * n + 4 * fq + j] = acc[n][j];
                if (tid < 64) lcnt[tid] = 0;
                __syncthreads();
                for (int tt = 0; tt < 16; ++tt) {
                    const int tl = 16 * wid + tt, t = t0 + tl;
                    const float sg = sigmoidf_(lgl[tl * 65 + lane]); const float ch = sg + mybias;
                    const int g = lane >> 3; int rk = 0;
#pragma unroll
                    for (int jj = 0; jj < 8; ++jj) { const int oj = (lane & ~7) + jj; const float o = __shfl(ch, oj); rk += ((o > ch) || (o == ch && oj < lane)) ? 1 : 0; }
                    float top = rk < 2 ? ch : 0.f; top += __shfl_xor(top, 1); top += __shfl_xor(top, 2); top += __shfl_xor(top, 4);
                    int grk = 0;
#pragma unroll
                    for (int gg = 0; gg < 8; ++gg) { const float o = __shfl(top, gg * 8); grk += ((o > top) || (o == top && gg < g)) ? 1 : 0; }
                    const bool gsel = grk < 4; const float mv = gsel ? ch : -INFINITY; int erk = 0;
#pragma unroll 8
                    for (int j = 0; j < 64; ++j) { const float o = __shfl(mv, j); erk += ((o > mv) || (o == mv && j < lane)) ? 1 : 0; }
                    const bool sel = gsel && erk < TOPK;
                    const float tot = wave_sum(sel ? sg : 0.f); const float w = sg / tot * 2.5f;
                    if (sel) { const int lp = __hip_atomic_fetch_add(lcnt + lane, 1, __ATOMIC_RELAXED, __HIP_MEMORY_SCOPE_WORKGROUP);
                        sel_e[tl * 6 + erk] = lane; sel_p[tl * 6 + erk] = lp; TOKW[(size_t)t * 8 + erk] = w; }
                }
                __syncthreads();
                if (tid < 64) { const int c = lcnt[tid]; lbase[tid] = c ? (int)atomicAdd(cnt + tid, (unsigned)c) : 0; }
                __syncthreads();
                for (int idx = tid; idx < 768; idx += 512) { const int e = sel_e[idx], pos = lbase[e] + sel_p[idx], tl = idx / 6, j = idx % 6; LIST[(size_t)e * LISTCAP + pos] = ((t0 + tl) << 3) | j; }
                __syncthreads();
            }
        }
        {
            bf16_t* SH = (bf16_t*)(ws + B_SH);
            pg8::DenseOrder S; S.init(NTOK, 512, 1024, (const bf16_t*)(ws + W_SGU), G, bid);
            auto f = [=](const pg8::Unit& u, int r, int c, f32x4 l0, f32x4 l1, f32x4 h0, f32x4 h1) {
#pragma unroll
                for (int i = 0; i < 4; ++i) { l0[i] = siluf_(l0[i]) * h0[i]; l1[i] = siluf_(l1[i]) * h1[i]; }
                *(u32x4*)(SH + ((size_t)u.pm * 256 + r) * 256 + u.pn * 128 + c) = pk8(l0, l1); };
            pg8::gemm_phase(lds, XB, 1024, S, pg8::make_epi(f));
        }
    }
    else if constexpr (PH == 7 || PH == 19) {
        moe_tables(cnt, tstart, cntl);
        bf16_t* H = (bf16_t*)(ws + B_H);
        pg8::GroupedOrder<true> S{tstart, cntl, 2, G, bid, (const char*)(ws + W_GU), (size_t)512 * 1024 * 2, (size_t)256 * 1024 * 2, (const int*)(ws + B_LIST)};
        auto f = [=](const pg8::Unit& u, int r, int c, f32x4 l0, f32x4 l1, f32x4 h0, f32x4 h1) {
#pragma unroll
            for (int i = 0; i < 4; ++i) { l0[i] = siluf_(l0[i]) * h0[i]; l1[i] = siluf_(l1[i]) * h1[i]; }
            *(u32x4*)(H + ((size_t)(tstart[u.e] + u.pm) * 256 + r) * 256 + u.pn * 128 + c) = pk8(l0, l1); };
        pg8::gemm_phase(lds, XB, 1024, S, pg8::make_epi(f));
    }
    else if constexpr (PH == 8 || PH == 10 || PH == 20 || PH == 22) {
        constexpr int P = (PH == 10 || PH == 22) ? 1 : 0;
        moe_tables(cnt, tstart, cntl);
        const int* LIST = (const int*)(ws + B_LIST); const float* TOKW = (const float*)(ws + B_TOKW); bf16_t* YT = (bf16_t*)(ws + B_YT);
        pg8::GroupedOrder<false> S{tstart, cntl, 2, G, bid, (const char*)(ws + W_D) + (size_t)512 * P * 256 * 2, (size_t)1024 * 256 * 2, (size_t)256 * 256 * 2, LIST};
        auto f = [=](const pg8::Unit& u, int r, int c, f32x4 l0, f32x4 l1, f32x4 h0, f32x4 h1) {
            const int i = u.pm * 256 + r;
            if (i < cntl[u.e]) { const int v = LIST[(size_t)u.e * LISTCAP + i]; const float w = TOKW[v]; const size_t dst = ((size_t)(v >> 3) * 6 + (v & 7)) * 512 + u.pn * 256 + c;
                *(u32x4*)(YT + dst) = pk8(l0 * w, l1 * w); *(u32x4*)(YT + dst + 128) = pk8(h0 * w, h1 * w); } };
        pg8::gemm_phase(lds, (const bf16_t*)(ws + B_H), 256, S, pg8::make_epi(f));
    }
    else if constexpr (PH == 9 || PH == 11 || PH == 21 || PH == 23) {
        constexpr int P = (PH == 11 || PH == 23) ? 1 : 0;
        const bf16_t* YT = (const bf16_t*)(ws + B_YT); float* xo = a.out;
        pg8::DenseOrder S; S.init(NTOK, 512, 256, (const bf16_t*)(ws + W_SD) + (size_t)512 * P * 256, G, bid);
        auto f = [=](const pg8::Unit& u, int r, int c, f32x4 l0, f32x4 l1, f32x4 h0, f32x4 h1) {
            const size_t row = (size_t)u.pm * 256 + r; const size_t off = row * 1024 + 512 * P + u.pn * 256 + c;
            l0 = l0 + *(const f32x4*)(xo + off) * ALPHA; l1 = l1 + *(const f32x4*)(xo + off + 4) * ALPHA; h0 = h0 + *(const f32x4*)(xo + off + 128) * ALPHA; h1 = h1 + *(const f32x4*)(xo + off + 132) * ALPHA;
#pragma unroll
            for (int j = 0; j < 6; ++j) { const u32x4 y0 = *(const u32x4*)(YT + (row * 6 + j) * 512 + u.pn * 256 + c), y1 = *(const u32x4*)(YT + (row * 6 + j) * 512 + u.pn * 256 + c + 128);
                l0[0] += __uint_as_float(y0.x << 16); l0[1] += __uint_as_float(y0.x & 0xffff0000u); l0[2] += __uint_as_float(y0.y << 16); l0[3] += __uint_as_float(y0.y & 0xffff0000u);
                l1[0] += __uint_as_float(y0.z << 16); l1[1] += __uint_as_float(y0.z & 0xffff0000u); l1[2] += __uint_as_float(y0.w << 16); l1[3] += __uint_as_float(y0.w & 0xffff0000u);
                h0[0] += __uint_as_float(y1.x << 16); h0[1] += __uint_as_float(y1.x & 0xffff0000u); h0[2] += __uint_as_float(y1.y << 16); h0[3] += __uint_as_float(y1.y & 0xffff0000u);
                h1[0] += __uint_as_float(y1.z << 16); h1[1] += __uint_as_float(y1.z & 0xffff0000u); h1[2] += __uint_as_float(y1.w << 16); h1[3] += __uint_as_float(y1.w & 0xffff0000u);
                if (j & 1) asm volatile("" ::: "memory"); }
            *(f32x4*)(xo + off) = l0; *(f32x4*)(xo + off + 4) = l1; *(f32x4*)(xo + off + 128) = h0; *(f32x4*)(xo + off + 132) = h1;
        };
        pg8::gemm_phase(lds, (const bf16_t*)(ws + B_SH), 256, S, pg8::make_epi(f));
    }
    else if constexpr (PH == 12) {
        ln_rows(a.out, (const float*)a.in[24], (const float*)a.in[25], a.out, XB, gw, ngw, lane);
        LAS float* scr = (LAS float*)(lds + wid * 8448);
        constexpr int I_IN = (1024 / 64) * (N_IN1 / 32), I_OUT = (1024 / 64) * (1024 / 32);
        for (int it = gw; it < I_IN + I_OUT; it += ngw) {
            int r = it;
            if (r < I_IN) { prep_item((const float*)a.in[26], nullptr, 3088, 1024, nullptr, (bf16_t*)(ws + W_IN), 1024, N_IN1, map_in1, scr, r, lane); continue; } r -= I_IN;
            prep_item((const float*)a.in[28], nullptr, 1024, 1024, nullptr, (bf16_t*)(ws + W_OUT), 1024, 1024, map_ident, scr, r, lane);
        }
        prep_moe(a, 32, scr, gw, ngw, lane, gtid, gthreads);
    }
    else if constexpr (PH == 13) {
        const float* bias = (const float*)(ws + WS_TAB + 8192);
        bf16_t* Q1 = (bf16_t*)(ws + B_Q1); bf16_t* K1 = (bf16_t*)(ws + B_K1); bf16_t* V1 = (bf16_t*)(ws + B_V1); float* GL = (float*)(ws + B_GL);
        pg8::DenseOrder S; S.init(NTOK, N_IN1, 1024, (const bf16_t*)(ws + W_IN), G, bid);
        auto f = [=](const pg8::Unit& u, int r, int c, f32x4 l0, f32x4 l1, f32x4 h0, f32x4 h1) {
            const int nt = u.pn; const size_t row = (size_t)u.pm * 256 + r;
            l0 = l0 + *(const f32x4*)(bias + nt * 256 + c); l1 = l1 + *(const f32x4*)(bias + nt * 256 + c + 4);
            h0 = h0 + *(const f32x4*)(bias + nt * 256 + 128 + c); h1 = h1 + *(const f32x4*)(bias + nt * 256 + 128 + c + 4);
            if (nt < 4) { *(u32x4*)(Q1 + row * 1024 + nt * 256 + c) = pk8(l0 * C2_FOX, l1 * C2_FOX); *(u32x4*)(Q1 + row * 1024 + nt * 256 + 128 + c) = pk8(h0 * C2_FOX, h1 * C2_FOX); }
            else if (nt < 8) { *(u32x4*)(K1 + row * 1024 + (nt - 4) * 256 + c) = pk8(l0, l1); *(u32x4*)(K1 + row * 1024 + (nt - 4) * 256 + 128 + c) = pk8(h0, h1); }
            else if (nt < 12) { *(u32x4*)(V1 + row * 1024 + (nt - 8) * 256 + c) = pk8(l0, l1); *(u32x4*)(V1 + row * 1024 + (nt - 8) * 256 + 128 + c) = pk8(h0, h1); }
            else if (c < 16) {
#pragma unroll
                for (int i = 0; i < 4; ++i) { float x = l0[i]; l0[i] = fminf(x, 0.f) - log1pf(__expf(-fabsf(x))); x = l1[i]; l1[i] = fminf(x, 0.f) - log1pf(__expf(-fabsf(x))); }
                *(f32x4*)(GL + row * 16 + c) = l0; *(f32x4*)(GL + row * 16 + c + 4) = l1; }
        };
        pg8::gemm_phase(lds, XB, 1024, S, pg8::make_epi(f));
    }
    else if constexpr (PH == 14) {
        const float* GL = (const float*)(ws + B_GL); float* CK = (float*)(ws + B_CK);
        for (int sq = gw; sq < NBATCH * 16; sq += ngw) {
            const int b = sq >> 4, h = sq & 15; float carry = 0.f;
            for (int i = 0; i < SEQ / 64; ++i) { const size_t t = (size_t)b * SEQ + i * 64 + lane; float v = GL[t * 16 + h];
#pragma unroll
                for (int o = 1; o < 64; o <<= 1) { const float n = __shfl_up(v, o); if (lane >= o) v += n; }
                v += carry; CK[t * 16 + h] = v * LOG2E; carry = __shfl(v, 63); }
        }
    }
    else if constexpr (PH == 15) {
        const bf16_t* Q1 = (const bf16_t*)(ws + B_Q1); const bf16_t* K1 = (const bf16_t*)(ws + B_K1); const bf16_t* V1 = (const bf16_t*)(ws + B_V1); bf16_t* O1 = (bf16_t*)(ws + B_O1);
        const float* CK = (const float*)(ws + B_CK);
        for (int u = bid; u < 128 * 16; u += G) {
            const int i = u >> 8, gp = u & 255, s = gp >> 7, bh = gp & 127, base = 2 * (i >> 1) + s, qb = (i & 1) ? 15 - base : base;
            const int b = bh >> 4, h = bh & 15;
            attn_simple_unit<64, 1024, 1024, 1024, 1024, true>(lds, Q1, K1, V1, O1, CK, b, h * 64, h * 64, h, h * 64, qb);
        }
    }
    else if constexpr (PH == 24) {
        ln_rows(a.out, (const float*)a.in[40], (const float*)a.in[41], a.out, nullptr, gw, ngw, lane);
    }
}

constexpr int LDS_BYTES = 147456;
constexpr int CW_BAR = 4096;
constexpr int NPHASE = 25;
template <int PH, int END> struct RunAll {
    static DI void run(const Args& a, LAS unsigned char* lds, const XcdBarrier& bar) {
        run_phase<PH>(a, lds);
        if (PH + 1 < END) xcd_barrier(bar);
        RunAll<PH + 1, END>::run(a, lds, bar);
    }
};
template <int END> struct RunAll<END, END> { static DI void run(const Args&, LAS unsigned char*, const XcdBarrier&) {} };

__global__ void __launch_bounds__(512, 2) k_all(Args a) {
    extern __shared__ __attribute__((aligned(16))) unsigned char lds_raw[];
    LAS unsigned char* lds = (LAS unsigned char*)lds_raw;
    volatile LAS unsigned* st = (volatile LAS unsigned*)(lds + LDS_BYTES - 16);
    if (threadIdx.x == 0) { st[0] = 0u; st[1] = 0u; st[2] = 0u; st[3] = 0u; }
    __syncthreads();
    const XcdBarrier bar = xcd_barrier_post((unsigned*)(a.ws + WS_CTL) + CW_BAR, st);
    RunAll<0, NPHASE>::run(a, lds, bar);
}

extern "C" void kernel_launch(void* const* d_in, const int* in_sizes, int n_in, void* d_out, int out_size, void* d_ws, size_t ws_size, hipStream_t stream) {
    static int grid = 0;
    if (grid == 0) {
        if (n_in != 42 || out_size != NTOK * DM || ws_size < WS_END) { fprintf(stderr, "kernel_launch: unexpected shapes (n_in %d, out %d, ws %zu < %zu)\n", n_in, out_size, ws_size, (size_t)WS_END); grid = -1; return; }
        int dev = 0, cus = 0, per_cu = 0;
        (void)hipGetDevice(&dev); (void)hipDeviceGetAttribute(&cus, hipDeviceAttributeMultiprocessorCount, dev);
        (void)hipFuncSetAttribute((const void*)k_all, hipFuncAttributeMaxDynamicSharedMemorySize, LDS_BYTES);
        if (hipOccupancyMaxActiveBlocksPerMultiprocessor(&per_cu, (const void*)k_all, 512, LDS_BYTES) != hipSuccess || per_cu < 1) { fprintf(stderr, "kernel_launch: occupancy query reports %d blocks per CU\n", per_cu); per_cu = 1; }
        (void)hipGetLastError();
        grid = cus > 0 ? cus : 256;
    }
    if (grid < 0) return;
    (void)hipMemsetAsync((char*)d_ws + WS_CTL, 0, 1 * MiB, stream);
    Args a{};
    for (int i = 0; i < 42; ++i) a.in[i] = d_in[i];
    a.out = (float*)d_out; a.ws = (unsigned char*)d_ws;
    hipLaunchKernelGGL(k_all, dim3(grid), dim3(512), LDS_BYTES, stream, a);
}
```

```cpp
#include <hip/hip_runtime.h>
#include <cstdio>
#include <cstdint>
#include <cmath>

#define LAS __attribute__((address_space(3)))
#define DI __device__ __forceinline__
typedef unsigned short bf16_t;
typedef short bf16x8 __attribute__((ext_vector_type(8)));
typedef short s16x4 __attribute__((ext_vector_type(4)));
typedef float f32x4 __attribute__((ext_vector_type(4)));
typedef float f32x16 __attribute__((ext_vector_type(16)));
typedef unsigned u32x4 __attribute__((ext_vector_type(4)));
typedef unsigned u32x2 __attribute__((ext_vector_type(2)));
typedef float f32x2_t __attribute__((ext_vector_type(2)));
typedef __bf16 bf16x2_t __attribute__((ext_vector_type(2)));

constexpr int NTOK = 32768, DM = 1024, NBATCH = 8, SEQ = 4096;
constexpr int NEXP = 64, TOPK = 6, EHID = 256;
constexpr float ALPHA = 1.4142135623730951f;
constexpr float LN_EPS = 1e-5f, RMS_EPS = 1e-6f;
constexpr float LOG2E = 1.4426950408889634f;
constexpr float C2_MLA = 0.10206207261596577f * LOG2E;
constexpr float C2_FOX = 0.125f * LOG2E;
constexpr int N_IN0 = 1536, N_IN1 = 3328;
constexpr int LISTCAP = 32768;
constexpr int HROWS = 212992;

constexpr size_t MiB = 1u << 20;
constexpr size_t WS_CTL = 0;
constexpr size_t WS_TAB = 1 * MiB;
constexpr size_t WS_COS = 2 * MiB, WS_SIN = 4 * MiB;
constexpr size_t WS_W = 6 * MiB;
constexpr size_t W_GU = WS_W + 0, W_D = WS_W + 64 * MiB, W_RHI = WS_W + 96 * MiB, W_RLO = W_RHI + 128 * 1024,
                 W_SGU = WS_W + 97 * MiB, W_SD = WS_W + 98 * MiB, W_IN = WS_W + 99 * MiB, W_OUT = WS_W + 106 * MiB,
                 W_UQ = WS_W + 108 * MiB, W_UKV = WS_W + 108 * MiB + 512 * 1024;
constexpr size_t WS_XB = 116 * MiB;
constexpr size_t WS_BIG = 180 * MiB;
constexpr size_t B_UPRE = WS_BIG, B_QL = WS_BIG + 32 * MiB, B_KVL = WS_BIG + 48 * MiB, B_Q0 = WS_BIG + 64 * MiB, B_K0 = WS_BIG + 112 * MiB,
                 B_V0 = WS_BIG + 160 * MiB, B_UO = WS_BIG + 192 * MiB;
constexpr size_t B_Q1 = WS_BIG, B_K1 = WS_BIG + 64 * MiB, B_V1 = WS_BIG + 128 * MiB, B_O1 = WS_BIG + 192 * MiB, B_GL = WS_BIG + 256 * MiB, B_CK = WS_BIG + 258 * MiB;
constexpr size_t B_H = WS_BIG, B_SH = WS_BIG + 104 * MiB, B_YT = WS_BIG + 120 * MiB, B_LIST = WS_BIG + 312 * MiB, B_TOKW = WS_BIG + 320 * MiB;
constexpr size_t WS_END = WS_BIG + 321 * MiB;

struct KArgs { const void* in[42]; float* out; unsigned char* ws; };
struct Args {
    LAS unsigned long long* tab; float* out; unsigned char* ws;
    __device__ __forceinline__ const void* in(int k) const { const unsigned long long v = tab[k]; const unsigned lo = __builtin_amdgcn_readfirstlane((unsigned)v), hi = __builtin_amdgcn_readfirstlane((unsigned)(v >> 32)); return (const void*)(const __attribute__((address_space(1))) char*)(((unsigned long long)hi << 32) | lo); }
};

DI unsigned pk2(float lo, float hi) { f32x2_t v = {lo, hi}; bf16x2_t b = __builtin_convertvector(v, bf16x2_t); return __builtin_bit_cast(unsigned, b); }
DI float bf2f(unsigned short b) { return __uint_as_float(((unsigned)b) << 16); }
DI unsigned short f2bf(float f) { return (unsigned short)(pk2(f, 0.f) & 0xffffu); }
DI float sigmoidf_(float x) { return 1.0f / (1.0f + __expf(-x)); }
DI float siluf_(float x) { return x * sigmoidf_(x); }
DI float wave_sum(float v) {
#pragma unroll
    for (int o = 1; o < 64; o <<= 1) v += __shfl_xor(v, o);
    return v;
}
DI int crow(int r, int hi) { return (r & 3) + 8 * (r >> 2) + 4 * hi; }
DI f32x16 mfma32(bf16x8 a, bf16x8 b, f32x16 c) { return __builtin_amdgcn_mfma_f32_32x32x16_bf16(a, b, c, 0, 0, 0); }
DI f32x4 mfma16(bf16x8 a, bf16x8 b, f32x4 c) { return __builtin_amdgcn_mfma_f32_16x16x32_bf16(a, b, c, 0, 0, 0); }
DI u32x2 pk4(f32x4 v) { u32x2 r; r.x = pk2(v[0], v[1]); r.y = pk2(v[2], v[3]); return r; }

DI int map_ident(int n) { return n; }
DI int map_gu(int n) { const int tile = n >> 8, w = n & 255, half = w >> 7, idx = tile * 128 + (w & 127); return idx | (half << 20); }
DI int map_in0(int n) {
    const int tile = n >> 8, w = n & 255;
    if (tile < 4) { const int half = w >> 7, idx = tile * 128 + (w & 127); return half * 512 + idx; }
    if (tile == 4) return 1024 + w;
    if (w < 128) return 1280 + w;
    if (w < 160) { const int i = w - 128; return 1408 + (i & 1) * 16 + (i >> 1); }
    return -1;
}
DI int map_q(int n) { const int h = n / 96, d = n % 96; if (d < 64) return h * 96 + d; const int i = d - 64; return h * 96 + 64 + (i & 1) * 16 + (i >> 1); }
DI int map_kv(int n) {
    if (n < 768) { const int h = n / 96, d = n % 96; if (d < 64) return h * 128 + d; return -2 - (128 + d - 64); }
    const int m = n - 768; return (m >> 6) * 128 + 64 + (m & 63);
}
DI int map_in1(int n) { return n < 3088 ? n : -1; }

template <class MapF>
DI void prep_item(const float* W0, const float* W1, int ldw, int Ksrc, const float* gk, bf16_t* WT, int Kout, int Nout, MapF map, LAS float* scr, int item, int lane) {
    const int nblk = Nout / 32, kb = item / nblk, nb = item % nblk, k0 = 64 * kb, n0 = 32 * nb;
    const int sc = map(n0 + (lane & 31));
    const float* W = (sc >= 0 && (sc >> 20)) ? W1 : W0; const int col = sc & 0xFFFFF;
#pragma unroll 8
    for (int i = 0; i < 32; ++i) {
        const int kk = 2 * i + (lane >> 5), k = k0 + kk; float v = 0.f;
        if (sc >= 0) { if (k < Ksrc) { v = W[(size_t)k * ldw + col]; if (gk) v *= gk[k]; } }
        else if (sc <= -2) v = (k == -2 - sc) ? 1.f : 0.f;
        scr[kk * 33 + (lane & 31)] = v;
    }
    asm volatile("s_waitcnt lgkmcnt(0)" ::: "memory");
    const int c = lane & 7;
#pragma unroll
    for (int j = 0; j < 4; ++j) {
        const int n = (lane >> 3) + 8 * j; const LAS float* s = scr + (8 * c) * 33 + n;
        u32x4 o; o.x = pk2(s[0 * 33], s[1 * 33]); o.y = pk2(s[2 * 33], s[3 * 33]); o.z = pk2(s[4 * 33], s[5 * 33]); o.w = pk2(s[6 * 33], s[7 * 33]);
        *(u32x4*)(WT + (size_t)(n0 + n) * Kout + k0 + 8 * c) = o;
    }
    asm volatile("s_waitcnt lgkmcnt(0)" ::: "memory");
}

DI void prep_moe(const Args& a, int ib, LAS float* scr, int gw, int ngw, int lane, int gtid, int gthreads) {
    unsigned char* ws = a.ws;
    constexpr int I_GU = (1024 / 64) * (512 / 32), I_D = (256 / 64) * (1024 / 32);
    const int NIT = NEXP * (I_GU + I_D) + I_GU + I_D;
    for (int it = gw; it < NIT; it += ngw) {
        int r = it;
        if (r < NEXP * I_GU) { const int e = r / I_GU; r %= I_GU;
            prep_item((const float*)a.in(ib + 2) + (size_t)e * 1024 * 256, (const float*)a.in(ib + 3) + (size_t)e * 1024 * 256, 256, 1024, nullptr, (bf16_t*)(ws + W_GU) + (size_t)e * 512 * 1024, 1024, 512, map_gu, scr, r, lane); continue; }
        r -= NEXP * I_GU;
        if (r < NEXP * I_D) { const int e = r / I_D; r %= I_D;
            prep_item((const float*)a.in(ib + 4) + (size_t)e * 256 * 1024, nullptr, 1024, 256, nullptr, (bf16_t*)(ws + W_D) + (size_t)e * 1024 * 256, 256, 1024, map_ident, scr, r, lane); continue; }
        r -= NEXP * I_D;
        if (r < I_GU) { prep_item((const float*)a.in(ib + 5), (const float*)a.in(ib + 6), 256, 1024, nullptr, (bf16_t*)(ws + W_SGU), 1024, 512, map_gu, scr, r, lane); continue; }
        r -= I_GU;
        prep_item((const float*)a.in(ib + 7), nullptr, 1024, 256, nullptr, (bf16_t*)(ws + W_SD), 256, 1024, map_ident, scr, r, lane);
    }
    const float* rw = (const float*)a.in(ib);
    bf16_t* rhi = (bf16_t*)(ws + W_RHI); bf16_t* rlo = (bf16_t*)(ws + W_RLO);
    for (int idx = gtid; idx < 64 * 1024; idx += gthreads) { const int n = idx >> 10, k = idx & 1023; const float v = rw[k * 64 + n]; const unsigned short h = f2bf(v); rhi[idx] = h; rlo[idx] = f2bf(v - bf2f(h)); }
}

constexpr int SG_LDS = 49152;
namespace pg8 {
constexpr int BM = 256, BK = 64, HALF = 128, HTB = HALF * BK * 2, STAGE_BYTES = 8 * HTB, NXCD = 8, WGM = 8;
DI int lds_byte(int r, int c) { const int st = (r >> 4) * 2 + (c >> 5), rr = r & 15, cc = c & 31, ob = rr * 64 + cc * 2; return st * 1024 + (ob ^ (((ob >> 9) & 1) << 5)); }
DI void stage_rc(int b, int& R, int& C) { const int st = b / 1024, sb = b % 1024, swz = sb ^ (((sb >> 9) & 1) << 5); R = (st >> 1) * 16 + swz / 64; C = (st & 1) * 32 + (swz % 64) / 2; }
DI int perm32(int rho) { const int n = rho >> 4, i = rho & 15; return 8 * (i >> 2) + 4 * n + (i & 3); }
struct Unit { int pm, pn, e; };

struct DenseOrder {
    int nM, nN, nwg, G, c; const char* Bt; size_t tstepB;
    DI void init(int M, int N, int K, const bf16_t* Bt_, int G_, int c_) { nM = M / BM; nN = N / BM; nwg = nM * nN; G = G_; c = c_; Bt = (const char*)Bt_; tstepB = (size_t)BM * K * 2; }
    DI bool next(int i, Unit& u) const {
        const long L = (long)i * G + c; if (L >= nwg) return false;
        int wgid = (int)L; { const int q = nwg / NXCD, r = nwg % NXCD, xcd = wgid % NXCD, off = wgid / NXCD; wgid = (xcd < r ? xcd * (q + 1) : r * (q + 1) + (xcd - r) * q) + off; }
        const int nig = WGM * nN, gid = wgid / nig, fm = gid * WGM, gsz = (nM - fm) < WGM ? (nM - fm) : WGM;
        u.pm = fm + ((wgid % nig) % gsz); u.pn = (wgid % nig) / gsz; u.e = 0; return true;
    }
    DI const char* bptr(const Unit& u) const { return Bt + (size_t)u.pn * tstepB; }
    static constexpr bool GATHER_A = false;
    DI const int* lptr(const Unit&) const { return nullptr; }
    DI int lcnt(const Unit&) const { return 0; }
    DI unsigned arow0(const Unit& u) const { return (unsigned)(u.pm * BM); }
    DI unsigned arow(const Unit& u, int rt) const { return (unsigned)(u.pm * BM + rt); }
};
DI int find_expert(const LAS int* tstart, int tile) { int e = 0;
#pragma unroll
    for (int s = 32; s > 0; s >>= 1) if (tstart[e + s] <= tile) e += s;
    return e; }
template <bool GATHER> struct GroupedOrder {
    const LAS int* tstart; const LAS int* cntl; int NT, G, c; const char* Bt; size_t estepB, tstepB; const int* LIST;
    DI bool next(int i, Unit& u) const {
        const int L = i * G + c; if (L >= tstart[NEXP] * NT) return false;
        const int tile = L / NT; u.pn = L - tile * NT; u.e = find_expert(tstart, tile); u.pm = tile - tstart[u.e]; return true;
    }
    DI const char* bptr(const Unit& u) const { return Bt + (size_t)u.e * estepB + (size_t)u.pn * tstepB; }
    static constexpr bool GATHER_A = GATHER;
    DI const int* lptr(const Unit& u) const { return LIST + (size_t)u.e * LISTCAP + u.pm * BM; }
    DI int lcnt(const Unit& u) const { return cntl[u.e] - u.pm * BM; }
    DI unsigned arow0(const Unit& u) const { return (unsigned)((tstart[u.e] + u.pm) * BM); }
    DI unsigned arow(const Unit& u, int rt) const {
        if (GATHER) { int i = u.pm * BM + rt; i = i < cntl[u.e] ? i : u.pm * BM; return (unsigned)(LIST[(size_t)u.e * LISTCAP + i] >> 3); }
        return (unsigned)((tstart[u.e] + u.pm) * BM + rt);
    }
};
template <class F> struct EpiFn {
    F f;
    DI void operator()(const f32x4 (&acc)[2][2][4][2], const Unit& u, int wr, int wc, int fr, int fq) const {
#pragma unroll
        for (int ai = 0; ai < 2; ++ai)
#pragma unroll
            for (int m = 0; m < 4; ++m) { int r_ = ai * HALF + wr * 64 + m * 16 + fr; asm volatile("" : "+v"(r_));
                f(u, r_, wc * 32 + 8 * fq, acc[ai][0][m][0], acc[ai][0][m][1], acc[ai][1][m][0], acc[ai][1][m][1]); asm volatile("" ::: "memory"); }
    }
};
template <class F> DI EpiFn<F> make_epi(const F& f) { return EpiFn<F>{f}; }

template <class Epi, class Sched>
DI void gemm_phase(LAS unsigned char* lds, const bf16_t* Abase, const int K, const Sched& S, const Epi& E) {
    int tid_ = threadIdx.x; asm volatile("" : "+v"(tid_));
    const int tid = tid_, wid = __builtin_amdgcn_readfirstlane(tid >> 6), lane = tid & 63, wr = wid >> 2, wc = wid & 3, fr = lane & 15, fq = lane >> 4;
    const int nt = K / BK;
    unsigned voffB[2];
#pragma unroll
    for (int i = 0; i < 2; ++i) { int R_, C_; stage_rc(tid * 16 + i * 8192, R_, C_); const int Rb = (R_ & ~31) + perm32(R_ & 31); voffB[i] = (unsigned)(Rb * K + C_) * 2u; }
    const size_t kstep = (size_t)(BK * 2);
    const size_t hstep = (size_t)HALF * K * 2;
    const unsigned ldsw = (unsigned)wid * 1024u;
    const int aoff = lds_byte(wr * 64 + fr, fq * 8), boff = lds_byte(wc * 32 + fr, fq * 8);
#define PG8_SA(b, h) (((b) * 2 + (h)) * HTB)
#define PG8_SB(b, h) ((4 + (b) * 2 + (h)) * HTB)
#define PG8_STAGE(bufoff, gbase, voff) do { _Pragma("unroll") for (int _i = 0; _i < 2; ++_i) \
        __builtin_amdgcn_global_load_lds((const unsigned*)((const char*)(gbase) + (voff)[_i]), (LAS unsigned*)(lds + (bufoff) + ldsw + _i * 8192), 16, 0, 0); } while (0)
#define PG8_LDA(dst, b, h) do { _Pragma("unroll") for (int m = 0; m < 4; ++m) _Pragma("unroll") for (int k = 0; k < 2; ++k) dst[m][k] = *(const LAS bf16x8*)(lds + PG8_SA(b, h) + aoff + m * 2048 + k * 1024); } while (0)
#define PG8_LDB(dst, b, h) do { _Pragma("unroll") for (int n = 0; n < 2; ++n) _Pragma("unroll") for (int k = 0; k < 2; ++k) dst[n][k] = *(const LAS bf16x8*)(lds + PG8_SB(b, h) + boff + n * 2048 + k * 1024); } while (0)
#define PG8_MMA(ai, bj, At, Bt) do { __builtin_amdgcn_s_setprio(1); _Pragma("unroll") for (int m = 0; m < 4; ++m) _Pragma("unroll") for (int n = 0; n < 2; ++n) _Pragma("unroll") for (int k = 0; k < 2; ++k) \
        acc[ai][bj][m][n] = __builtin_amdgcn_mfma_f32_16x16x32_bf16(Bt[n][k], At[m][k], acc[ai][bj][m][n], 0, 0, 0); __builtin_amdgcn_s_setprio(0); } while (0)
#define PG8_WAIT_V(n) asm volatile("s_waitcnt vmcnt(" #n ")" ::: "memory")
#define PG8_WAIT_L(n) asm volatile("s_waitcnt lgkmcnt(" #n ")" ::: "memory")
#define PG8_BAR __builtin_amdgcn_s_barrier()
#define PG8_SCHED __builtin_amdgcn_sched_barrier(0)
#define PG8_AOFFS(dst, u) do { _Pragma("unroll") for (int _i = 0; _i < 2; ++_i) { int R_, C_; stage_rc(tid * 16 + _i * 8192, R_, C_); _Pragma("unroll") for (int _h = 0; _h < 2; ++_h) dst[_h][_i] = (S.arow(u, _h * HALF + R_) * (unsigned)K + (unsigned)C_) * 2u; } } while (0)
    Unit cur, nxt; int ui = 0;
    if (!S.next(0, cur)) return;
    f32x4 acc[2][2][4][2];
#pragma unroll
    for (int a = 0; a < 2; ++a)
#pragma unroll
        for (int b = 0; b < 2; ++b)
#pragma unroll
            for (int m = 0; m < 4; ++m)
#pragma unroll
                for (int n = 0; n < 2; ++n) acc[a][b][m][n] = (f32x4){0.f, 0.f, 0.f, 0.f};
    bf16x8 At[4][2], B0[2][2], B1[2][2];
    constexpr bool GA = Sched::GATHER_A;
    unsigned vcur[2][2], vnxt[2][2];
    const char* const Ab = (const char*)Abase;
    const char* cA = Ab;
    if constexpr (GA) { PG8_AOFFS(vcur, cur); }
    else {
#pragma unroll
        for (int i = 0; i < 2; ++i) { int R_, C_; stage_rc(tid * 16 + i * 8192, R_, C_); vcur[0][i] = (unsigned)(R_ * K + C_) * 2u; vcur[1][i] = vcur[0][i]; }
        cA = Ab + (size_t)S.arow0(cur) * K * 2;
    }
    const size_t ah = GA ? (size_t)0 : hstep;
    const char* cB = S.bptr(cur);
    PG8_STAGE(PG8_SB(0, 0), cB, voffB); PG8_STAGE(PG8_SB(0, 1), cB + hstep, voffB); PG8_STAGE(PG8_SA(0, 0), cA, vcur[0]); PG8_STAGE(PG8_SA(0, 1), cA + ah, vcur[1]);
    if (wr == 1) PG8_BAR;
    PG8_WAIT_V(2); PG8_BAR;
    PG8_STAGE(PG8_SB(1, 0), cB + kstep, voffB); PG8_STAGE(PG8_SA(1, 0), cA + kstep, vcur[0]); PG8_STAGE(PG8_SB(1, 1), cB + hstep + kstep, voffB);
    PG8_WAIT_V(6); PG8_BAR;
    for (;;) {
        const bool has_next = S.next(ui + 1, nxt);
        const char* nB = cB; const char* nA = cA;
        if (has_next) { nB = S.bptr(nxt);
            if constexpr (GA) {
                const int* lp_ = S.lptr(nxt); const int cn_ = S.lcnt(nxt);
#pragma unroll
                for (int i = 0; i < 2; ++i) { int R_, C_; stage_rc(tid * 16 + i * 8192, R_, C_);
#pragma unroll
                    for (int h = 0; h < 2; ++h) { int rt_ = h * HALF + R_; rt_ = rt_ < cn_ ? rt_ : 0; const int* p_ = lp_ + rt_; asm volatile("global_load_dword %0, %1, off" : "=v"(vnxt[h][i]) : "v"(p_) : "memory"); } }
            } else nA = Ab + (size_t)S.arow0(nxt) * K * 2; }
        else if constexpr (GA) {
#pragma unroll
            for (int h = 0; h < 2; ++h)
#pragma unroll
                for (int i = 0; i < 2; ++i) vnxt[h][i] = vcur[h][i];
        }
#pragma unroll 1
        for (int t = 0; t < nt; t += 2) {
            const bool last = (t == nt - 2);
            const char* a1 = cA + (size_t)(t + 1) * kstep;
            const char* a2 = last ? nA : cA + (size_t)(t + 2) * kstep; const char* b2 = last ? nB : cB + (size_t)(t + 2) * kstep;
            const char* a3 = a2 + kstep; const char* b3 = b2 + kstep;
            if constexpr (GA) { if (last && has_next) {
                asm volatile("" : "+v"(vnxt[0][0]), "+v"(vnxt[0][1]), "+v"(vnxt[1][0]), "+v"(vnxt[1][1]));
#pragma unroll
                for (int i = 0; i < 2; ++i) { int R_, C_; stage_rc(tid * 16 + i * 8192, R_, C_);
#pragma unroll
                    for (int h = 0; h < 2; ++h) vnxt[h][i] = ((vnxt[h][i] >> 3) * (unsigned)K + (unsigned)C_) * 2u; } } }
            unsigned v2[2][2];
#pragma unroll
            for (int h = 0; h < 2; ++h)
#pragma unroll
                for (int i = 0; i < 2; ++i) v2[h][i] = (GA && last) ? vnxt[h][i] : vcur[h][i];
            PG8_LDB(B0, 0, 0); PG8_LDB(B1, 0, 1); PG8_SCHED; PG8_LDA(At, 0, 0); PG8_STAGE(PG8_SA(1, 1), a1 + ah, vcur[1]);
            PG8_WAIT_V(8); PG8_WAIT_L(0); PG8_BAR; PG8_MMA(0, 0, At, B0); PG8_MMA(0, 1, At, B1); PG8_BAR; PG8_SCHED;
            PG8_LDA(At, 0, 1); PG8_STAGE(PG8_SB(0, 0), b2, voffB); PG8_STAGE(PG8_SB(0, 1), b2 + hstep, voffB); PG8_STAGE(PG8_SA(0, 0), a2, v2[0]);
            PG8_WAIT_V(8); PG8_WAIT_L(0); PG8_BAR; PG8_MMA(1, 0, At, B0); PG8_MMA(1, 1, At, B1); PG8_BAR; PG8_SCHED;
            PG8_LDB(B0, 1, 0); PG8_LDB(B1, 1, 1); PG8_SCHED; PG8_LDA(At, 1, 0); PG8_STAGE(PG8_SA(0, 1), a2 + ah, v2[1]);
            PG8_WAIT_V(8); PG8_WAIT_L(0); PG8_BAR; PG8_MMA(0, 0, At, B0); PG8_MMA(0, 1, At, B1); PG8_BAR; PG8_SCHED;
            PG8_LDA(At, 1, 1); PG8_STAGE(PG8_SB(1, 0), b3, voffB); PG8_STAGE(PG8_SB(1, 1), b3 + hstep, voffB); PG8_STAGE(PG8_SA(1, 0), a3, v2[0]);
            PG8_WAIT_V(8); PG8_WAIT_L(0); PG8_BAR; PG8_MMA(1, 0, At, B0); PG8_MMA(1, 1, At, B1); PG8_BAR; PG8_SCHED;
        }
        if (wr == 0) PG8_BAR;
        { int fr_ = fr, fq_ = fq; asm volatile("" : "+v"(fr_), "+v"(fq_));
          E(acc, cur, wr, wc, fr_, fq_); }
        if (!has_next) break;
#pragma unroll
        for (int a = 0; a < 2; ++a)
#pragma unroll
            for (int b = 0; b < 2; ++b)
#pragma unroll
                for (int m = 0; m < 4; ++m)
#pragma unroll
                    for (int n = 0; n < 2; ++n) acc[a][b][m][n] = (f32x4){0.f, 0.f, 0.f, 0.f};
        cur = nxt; cB = nB; cA = nA; ++ui;
        if constexpr (GA) {
#pragma unroll
            for (int h = 0; h < 2; ++h)
#pragma unroll
                for (int i = 0; i < 2; ++i) vcur[h][i] = vnxt[h][i];
        }
        if (wr == 1) PG8_BAR;
    }
    PG8_WAIT_V(0);
    PG8_BAR;
#undef PG8_SA
#undef PG8_SB
#undef PG8_STAGE
#undef PG8_LDA
#undef PG8_LDB
#undef PG8_MMA
#undef PG8_WAIT_V
#undef PG8_WAIT_L
#undef PG8_BAR
#undef PG8_SCHED
#undef PG8_AOFFS
}
}
DI u32x4 pk8(f32x4 a, f32x4 b) { u32x4 o; o.x = pk2(a[0], a[1]); o.y = pk2(a[2], a[3]); o.z = pk2(b[0], b[1]); o.w = pk2(b[2], b[3]); return o; }
DI float dot4(f32x4 a) { return (a[0] * a[0] + a[1] * a[1]) + (a[2] * a[2] + a[3] * a[3]); }
DI void rope8(f32x4& v0, f32x4& v1, const float* ct, const float* st, size_t row, int p) {
    const f32x4 cs = *(const f32x4*)(ct + row * 16 + p), sn = *(const f32x4*)(st + row * 16 + p);
    float a, b;
    a = v0[0]; b = v0[1]; v0[0] = a * cs[0] - b * sn[0]; v0[1] = b * cs[0] + a * sn[0];
    a = v0[2]; b = v0[3]; v0[2] = a * cs[1] - b * sn[1]; v0[3] = b * cs[1] + a * sn[1];
    a = v1[0]; b = v1[1]; v1[0] = a * cs[2] - b * sn[2]; v1[1] = b * cs[2] + a * sn[2];
    a = v1[2]; b = v1[3]; v1[2] = a * cs[3] - b * sn[3]; v1[3] = b * cs[3] + a * sn[3];
}

template <int DK, int QP, int KP, int VP, int OP, bool BIAS>
DI void attn_simple_unit(LAS unsigned char* lds, const bf16_t* Q, const bf16_t* K, const bf16_t* V, bf16_t* O, const float* CK, int b, int hq, int hv, int hc, int ho, int qb) {
    constexpr int KS = DK + 8, VS = 72;
    LAS bf16_t* Ks = (LAS bf16_t*)lds;
    LAS bf16_t* VT = (LAS bf16_t*)(lds + 64 * KS * 2);
    LAS float* ckl = (LAS float*)(lds + 64 * KS * 2 + 64 * VS * 2);
    int tid_ = threadIdx.x; asm volatile("" : "+v"(tid_));
    const int tid = tid_, lane = tid & 63, wid = tid >> 6, r32 = lane & 31, hi = lane >> 5;
    const size_t rowbase = (size_t)b * SEQ; const int q0 = qb * 256, qw = q0 + 32 * wid;
    bf16x8 qr[DK / 16];
#pragma unroll
    for (int d0 = 0; d0 < DK / 16; ++d0) qr[d0] = *(const bf16x8*)(Q + (rowbase + qw + r32) * QP + hq + 16 * d0 + 8 * hi);
    f32x16 o0, o1;
#pragma unroll
    for (int i = 0; i < 16; ++i) { o0[i] = 0.f; o1[i] = 0.f; }
    float m = -INFINITY, l = 0.f;
    const int ntile = (q0 + 256) / 64;
    for (int jt = 0; jt < ntile; ++jt) {
        const int kv0 = jt * 64;
        __syncthreads();
        for (int c = tid; c < 64 * (DK / 8); c += 512) { const int r = c / (DK / 8), ch = c % (DK / 8);
            const u32x4 v = *(const u32x4*)(K + (rowbase + kv0 + r) * KP + hq + ch * 8); *(LAS u32x4*)(Ks + r * KS + ch * 8) = v; }
        { const int r = tid >> 3, ch = tid & 7; const u32x4 v = *(const u32x4*)(V + (rowbase + kv0 + r) * VP + hv + ch * 8);
#pragma unroll
          for (int i = 0; i < 4; ++i) { VT[(ch * 8 + 2 * i) * VS + r] = (bf16_t)(v[i] & 0xffffu); VT[(ch * 8 + 2 * i + 1) * VS + r] = (bf16_t)(v[i] >> 16); } }
        if (BIAS) { if (tid < 64) ckl[tid] = CK[(rowbase + kv0 + tid) * 16 + hc]; }
        __syncthreads();
        if (kv0 <= qw + 31) {
            f32x16 p0, p1;
#pragma unroll
            for (int i = 0; i < 16; ++i) { p0[i] = 0.f; p1[i] = 0.f; }
#pragma unroll
            for (int d0 = 0; d0 < DK / 16; ++d0) {
                const bf16x8 a0 = *(LAS bf16x8*)(Ks + r32 * KS + 16 * d0 + 8 * hi), a1 = *(LAS bf16x8*)(Ks + (32 + r32) * KS + 16 * d0 + 8 * hi);
                p0 = mfma32(a0, qr[d0], p0); p1 = mfma32(a1, qr[d0], p1);
            }
            if (BIAS) {
#pragma unroll
                for (int i = 0; i < 16; ++i) { p0[i] -= ckl[crow(i, hi)]; p1[i] -= ckl[32 + crow(i, hi)]; }
            }
            if (kv0 + 63 > qw) { const int q = qw + r32;
#pragma unroll
                for (int i = 0; i < 16; ++i) { const int kv = kv0 + crow(i, hi); if (kv > q) p0[i] = -INFINITY; if (kv + 32 > q) p1[i] = -INFINITY; } }
            float rm = p0[0];
#pragma unroll
            for (int i = 0; i < 16; ++i) { rm = fmaxf(rm, p0[i]); rm = fmaxf(rm, p1[i]); }
            rm = fmaxf(rm, __shfl_xor(rm, 32));
            const float mn = fmaxf(m, rm); const float f = __builtin_amdgcn_exp2f(m - mn);
            float rs = 0.f;
#pragma unroll
            for (int i = 0; i < 16; ++i) { p0[i] = __builtin_amdgcn_exp2f(p0[i] - mn); p1[i] = __builtin_amdgcn_exp2f(p1[i] - mn); rs += p0[i] + p1[i]; }
            rs += __shfl_xor(rs, 32);
            l = l * f + rs; m = mn;
#pragma unroll
            for (int i = 0; i < 16; ++i) { const float fi = __shfl(f, crow(i, hi)); o0[i] *= fi; o1[i] *= fi; }
            bf16x8 pf[4];
            { u32x4 t;
              t.x = pk2(p0[0], p0[1]); t.y = pk2(p0[2], p0[3]); t.z = pk2(p0[4], p0[5]); t.w = pk2(p0[6], p0[7]); pf[0] = __builtin_bit_cast(bf16x8, t);
              t.x = pk2(p0[8], p0[9]); t.y = pk2(p0[10], p0[11]); t.z = pk2(p0[12], p0[13]); t.w = pk2(p0[14], p0[15]); pf[1] = __builtin_bit_cast(bf16x8, t);
              t.x = pk2(p1[0], p1[1]); t.y = pk2(p1[2], p1[3]); t.z = pk2(p1[4], p1[5]); t.w = pk2(p1[6], p1[7]); pf[2] = __builtin_bit_cast(bf16x8, t);
              t.x = pk2(p1[8], p1[9]); t.y = pk2(p1[10], p1[11]); t.z = pk2(p1[12], p1[13]); t.w = pk2(p1[14], p1[15]); pf[3] = __builtin_bit_cast(bf16x8, t); }
#pragma unroll
            for (int ks = 0; ks < 4; ++ks) {
                { const s16x4 lo = *(LAS s16x4*)(VT + r32 * VS + 16 * ks + 4 * hi), hh = *(LAS s16x4*)(VT + r32 * VS + 16 * ks + 8 + 4 * hi);
                  const bf16x8 vf = __builtin_shufflevector(lo, hh, 0, 1, 2, 3, 4, 5, 6, 7); o0 = mfma32(pf[ks], vf, o0); }
                { const s16x4 lo = *(LAS s16x4*)(VT + (32 + r32) * VS + 16 * ks + 4 * hi), hh = *(LAS s16x4*)(VT + (32 + r32) * VS + 16 * ks + 8 + 4 * hi);
                  const bf16x8 vf = __builtin_shufflevector(lo, hh, 0, 1, 2, 3, 4, 5, 6, 7); o1 = mfma32(pf[ks], vf, o1); }
            }
        }
    }
    const float inv = 1.0f / l;
#pragma unroll
    for (int i = 0; i < 16; ++i) { const float ii = __shfl(inv, crow(i, hi)); const size_t row = rowbase + qw + crow(i, hi);
        O[row * OP + ho + r32] = f2bf(o0[i] * ii); O[row * OP + ho + 32 + r32] = f2bf(o1[i] * ii); }
}

namespace attn_fox {
using bf16=unsigned short;
constexpr int BATCH=8,NHEAD=16,SEQ=4096,D=64,DM=NHEAD*D;
constexpr int NW=8,QBLK=32,QB=QBLK*NW,KVBLK=64,NQB=SEQ/QB;
constexpr int ATTN_PITCH=DM, ATTN_UNIT_ROWS=QB;
__device__ __forceinline__ int crow(int r,int hi){return (r&3)+8*(r>>2)+4*hi;}
#define SBAR() __builtin_amdgcn_sched_barrier(0)
__device__ __forceinline__ void cmask(f32x16&p0,f32x16&p1,int jb,int qrel,int hi){
  const float NEG=-INFINITY; int kb=64*jb+4*hi;
  #pragma unroll
  for(int r=0;r<16;++r){int kv=kb+(r&3)+8*(r>>2); if(kv>qrel)p0[r]=NEG; if(kv+32>qrel)p1[r]=NEG;}
}

constexpr int NSLOT=3, SLOTB=8192;
constexpr int LDS_K=0, LDS_V=NSLOT*SLOTB, LDS_WS=2*NSLOT*SLOTB, LDS_OST=LDS_WS+NW*64*4, LDS_CK=LDS_OST+NW*4096, LDS_BYTES=LDS_CK+SEQ*4;
constexpr float C2=0.125f*1.4426950408889634f;
__device__ __forceinline__ void glds16(const void*gsrc,unsigned lds_dst){unsigned keep;
  asm volatile("s_mov_b32 %0, m0\n\ts_mov_b32 m0, %2\n\ts_nop 0\n\tglobal_load_lds_dwordx4 %1, off\n\ts_mov_b32 m0, %0":"=&s"(keep):"v"(gsrc),"s"(lds_dst):"memory");}
__device__ __forceinline__ float max3f(float a,float b,float c){float r;asm("v_max3_f32 %0, %1, %2, %3":"=v"(r):"v"(a),"v"(b),"v"(c));return r;}
__device__ __forceinline__ float max2f(float a,float b){float r;asm("v_max_f32_e32 %0, %1, %2":"=v"(r):"v"(a),"v"(b));return r;}
__device__ __forceinline__ float fadd_s(float a,float b){float r;asm("v_add_f32_e32 %0, %1, %2":"=v"(r):"v"(a),"v"(b));return r;}
__device__ __forceinline__ float fsub_s(float a,float b){float r;asm("v_sub_f32_e32 %0, %1, %2":"=v"(r):"v"(a),"v"(b));return r;}
typedef float f32x2_t __attribute__((ext_vector_type(2))); typedef __bf16 bf16x2_t __attribute__((ext_vector_type(2)));
__device__ __forceinline__ unsigned cvtpk_s(float lo,float hi){f32x2_t v={lo,hi};bf16x2_t b=__builtin_convertvector(v,bf16x2_t);return __builtin_bit_cast(unsigned,b);}
#define WAIT_BAR(N) asm volatile("s_waitcnt vmcnt(" #N ") lgkmcnt(0)\n\ts_barrier":::"memory")

__device__ __forceinline__ void qkt(f32x16&p0,f32x16&p1,const char*Kslot,const bf16x8*qr,int r32,int hi){
  const char*kb=Kslot+hi*1024+r32*16;
  #pragma unroll
  for(int d0=0;d0<4;++d0){
    const bf16x8 b0=*reinterpret_cast<const bf16x8*>(kb+d0*2048);
    const bf16x8 b1=*reinterpret_cast<const bf16x8*>(kb+d0*2048+512);
    p0=__builtin_amdgcn_mfma_f32_32x32x16_bf16(b0,qr[d0],p0,0,0,0);p1=__builtin_amdgcn_mfma_f32_32x32x16_bf16(b1,qr[d0],p1,0,0,0);}
}
typedef __attribute__((address_space(3))) const char* lds_cptr;
typedef __attribute__((address_space(3))) const float* lds_fptr;
typedef short v4i16_t __attribute__((ext_vector_type(4)));
__device__ __forceinline__ void kload8(bf16x8*kf,lds_cptr kp){
  kf[0]=*(const __attribute__((address_space(3))) bf16x8*)(kp);      kf[1]=*(const __attribute__((address_space(3))) bf16x8*)(kp+512);
  kf[2]=*(const __attribute__((address_space(3))) bf16x8*)(kp+2048); kf[3]=*(const __attribute__((address_space(3))) bf16x8*)(kp+2560);
  kf[4]=*(const __attribute__((address_space(3))) bf16x8*)(kp+4096); kf[5]=*(const __attribute__((address_space(3))) bf16x8*)(kp+4608);
  kf[6]=*(const __attribute__((address_space(3))) bf16x8*)(kp+6144); kf[7]=*(const __attribute__((address_space(3))) bf16x8*)(kp+6656);
}
__device__ __forceinline__ void kload2(bf16x8*kf,lds_cptr kp,int j){ kf[2*j]=*(const __attribute__((address_space(3))) bf16x8*)(kp+j*2048); kf[2*j+1]=*(const __attribute__((address_space(3))) bf16x8*)(kp+j*2048+512); }
__device__ __forceinline__ s16x4 vtr(lds_cptr p){ return __builtin_bit_cast(s16x4,__builtin_amdgcn_ds_read_tr16_b64_v4i16((__attribute__((address_space(3))) v4i16_t*)p)); }
__device__ __forceinline__ float rowmax(const f32x16&p0,const f32x16&p1){
  float a=max3f(p0[0],p0[1],p1[0]),b=max3f(p0[2],p0[3],p1[1]);a=max3f(a,p1[2],p1[3]);
  #pragma unroll
  for(int r=4;r<16;r+=4){a=max3f(a,p0[r],p0[r+1]);b=max3f(b,p0[r+2],p0[r+3]);a=max3f(a,p1[r],p1[r+1]);b=max3f(b,p1[r+2],p1[r+3]);}
  const float m=max2f(a,b);
  auto rr=__builtin_amdgcn_permlane32_swap(__float_as_uint(m),__float_as_uint(m),false,false);
  return max2f(__uint_as_float(rr[0]),__uint_as_float(rr[1]));
}
__device__ __forceinline__ void pv(f32x16*o,int vb,bf16x8 pa0,bf16x8 pa1,bf16x8 pa2,bf16x8 pa3){
  #pragma unroll
  for(int d0=0;d0<2;++d0){s16x4 lo[4],hi[4];
    #pragma unroll
    for(int ks=0;ks<4;++ks){
      asm volatile("ds_read_b64_tr_b16 %0,%1 offset:%c2":"=&v"(lo[ks]):"v"(vb),"i"(d0*4096+ks*1024):"memory");
      asm volatile("ds_read_b64_tr_b16 %0,%1 offset:%c2":"=&v"(hi[ks]):"v"(vb),"i"(d0*4096+ks*1024+512):"memory");}
    asm volatile("s_waitcnt lgkmcnt(0)":::"memory");SBAR();
    #define PK(k) (bf16x8){lo[k][0],lo[k][1],lo[k][2],lo[k][3],hi[k][0],hi[k][1],hi[k][2],hi[k][3]}
    o[d0]=__builtin_amdgcn_mfma_f32_32x32x16_bf16(pa0,PK(0),o[d0],0,0,0);
    o[d0]=__builtin_amdgcn_mfma_f32_32x32x16_bf16(pa1,PK(1),o[d0],0,0,0);
    o[d0]=__builtin_amdgcn_mfma_f32_32x32x16_bf16(pa2,PK(2),o[d0],0,0,0);
    o[d0]=__builtin_amdgcn_mfma_f32_32x32x16_bf16(pa3,PK(3),o[d0],0,0,0);
    #undef PK
  }
}

#ifndef ATTN_STORE16
#define ATTN_STORE16(p,v) (*(u32x4*)(p)=(v))
#endif
template<int THRL> __device__ __forceinline__ void attn_unit(int b,int h,int qb,const bf16*Q,const bf16*__restrict__ K,const bf16*__restrict__ V,bf16*O,const float*__restrict__ CKH,char*shm){
  const int tid=threadIdx.x,lane=tid&63,r32=lane&31,hi=lane>>5; const int wid=__builtin_amdgcn_readfirstlane(tid>>6);
  const long rowbase=(long)b*SEQ; const int q0=qb*QB;
  const bf16*Qw=Q+(rowbase+q0+wid*QBLK)*DM+h*D;
  const bf16*Kh=K+rowbase*DM+h*D,*Vh=V+rowbase*DM+h*D;
  const unsigned lds0=(unsigned)(uintptr_t)shm;
  float*wsf=(float*)(shm+LDS_WS)+wid*64;
  const bf16*ksrc=Kh+(long)lane*DM+wid*8;
  const bf16*vsrc=Vh+(long)(16*(wid&3)+(lane>>2))*DM+(wid>>2)*32+(lane&3)*8;
  const unsigned kdst=lds0+LDS_K+wid*1024, vdst=lds0+LDS_V+wid*1024;
  #define DMA_K(t,slot) glds16(ksrc+(long)(t)*KVBLK*DM,(unsigned)__builtin_amdgcn_readfirstlane(kdst+(slot)))
  #define DMA_V(t,slot) glds16(vsrc+(long)(t)*KVBLK*DM,(unsigned)__builtin_amdgcn_readfirstlane(vdst+(slot)))
  const int vb0=(int)(lds0+LDS_V)+((lane>>4)&1)*32+(lane&3)*8+(4*hi+((lane&15)>>2))*64;
  const char*Kbase=shm+LDS_K; bf16x8 kf[8];
  const lds_cptr shm3=(lds_cptr)shm; const lds_cptr kp0=shm3+LDS_K+hi*1024+r32*16; const lds_cptr vp0=shm3+LDS_V+((lane>>4)&1)*32+(lane&3)*8+(4*hi+((lane&15)>>2))*64;
  const int NT=(q0+QB)/KVBLK;
  const float*ckg=CKH+((long)b*NHEAD+h)*SEQ; float*ckl=(float*)(shm+LDS_CK); const lds_fptr ckl3=(lds_fptr)(shm3+LDS_CK);
  f32x4 ckv0=f32x4{0.f,0.f,0.f,0.f},ckv1=f32x4{0.f,0.f,0.f,0.f}; if(tid*4<q0+QB)ckv0=*reinterpret_cast<const f32x4*>(ckg+tid*4); if(2048+tid*4<q0+QB)ckv1=*reinterpret_cast<const f32x4*>(ckg+2048+tid*4);
  const float cq=ckg[q0+wid*QBLK+r32];
  DMA_K(0,0);DMA_V(0,0);DMA_K(1,SLOTB);
  bf16x8 qr[4];
  #pragma unroll
  for(int d0=0;d0<4;++d0)qr[d0]=*reinterpret_cast<const bf16x8*>(&Qw[(long)r32*DM+d0*16+hi*8]);
  float mhat=-cq,l_reg=0.f;f32x16 o[2];o[0]=f32x16{};o[1]=f32x16{};
  const int qrel=wid*QBLK+r32;
  #define CMASK(P0,P1,t) do{int jb_=(t)-(NT-4); if(jb_>=0)cmask(P0,P1,jb_,qrel,hi);}while(0)
  bool resc=false;
  #define START(P0,P1) do{ const float rm=rowmax(P0,P1); resc=false; \
    { const float dl=__builtin_fmaxf(rm,0.f); mhat=fadd_s(mhat,dl); \
      _Pragma("unroll") for(int r=0;r<16;++r){P0[r]=fsub_s(P0[r],dl);P1[r]=fsub_s(P1[r],dl);} } \
    _Pragma("unroll") for(int r=0;r<16;++r)P0[r]=__builtin_amdgcn_exp2f(P0[r]); }while(0)
  #define RESC() do{ if(resc){ asm volatile("s_waitcnt lgkmcnt(0)":::"memory"); \
      _Pragma("unroll") for(int d_=0;d_<2;++d_) _Pragma("unroll") for(int r=0;r<16;++r)o[d_][r]*=wsf[crow(r,hi)]; } }while(0)
  #define BGRP(X,g,base) do{ const f32x4 cv_=*(const __attribute__((address_space(3))) f32x4*)(ckl3+(base)+8*(g)+4*hi); const float nm_=-mhat; \
      X[4*(g)]=nm_-cv_[0]; X[4*(g)+1]=nm_-cv_[1]; X[4*(g)+2]=nm_-cv_[2]; X[4*(g)+3]=nm_-cv_[3]; }while(0)
  #define BINIT(X0,X1,tt) do{ _Pragma("unroll") for(int g_=0;g_<4;++g_){ BGRP(X0,g_,64*(tt)); BGRP(X1,g_,64*(tt)+32); } }while(0)
  f32x16 pA0,pA1,pB0,pB1;
  int sl_prev=0,sl_cur=0,sl_next=SLOTB;
  #define ROT() do{sl_prev=sl_cur;sl_cur=sl_next;sl_next=(sl_next==(NSLOT-1)*SLOTB)?0:sl_next+SLOTB;}while(0)
  DMA_K(2,2*SLOTB);
  *reinterpret_cast<f32x4*>(ckl+tid*4)=ckv0; *reinterpret_cast<f32x4*>(ckl+2048+tid*4)=ckv1;
  WAIT_BAR(3);
  BINIT(pA0,pA1,0);
  qkt(pA0,pA1,Kbase,qr,r32,hi);asm volatile("s_nop 15\n\ts_nop 7":"+v"(pA0),"+v"(pA1));CMASK(pA0,pA1,0);
  START(pA0,pA1);
  _Pragma("unroll") for(int r=0;r<16;++r)pA1[r]=__builtin_amdgcn_exp2f(pA1[r]);
  BINIT(pB0,pB1,1);
  WAIT_BAR(0);
  DMA_K(3,0);DMA_V(1,SLOTB);
  ROT();
  kload8(kf,kp0+sl_cur);
  WAIT_BAR(2);
  s16x4 vlo[8],vhi[8]; u32x4 pw0,pw1,pw2,pw3;
  #define PKW(P,B) cvtpk_s(P[B],P[B+1])
  #define PAF(k) __builtin_bit_cast(bf16x8,pw##k)
  #define VFR(i) (bf16x8){vlo[i][0],vlo[i][1],vlo[i][2],vlo[i][3],vhi[i][0],vhi[i][1],vhi[i][2],vhi[i][3]}
  #define PIN(x) asm volatile("":"+v"(x))
  #define MX3(a,b,c) __builtin_fmaxf(__builtin_fmaxf((a),(b)),(c))
  #define GAPA(MF,A0,A1,A2,A3,W0,W1,PW) do{ MF; sacc+=A0; sacc+=A1; sacc+=A2; sacc+=A3; PIN(sacc); W0; W1; PIN(PW); SBAR(); }while(0)
  #define EX(v) __builtin_amdgcn_exp2f(v)
  #define GAPB(MF,X,B) do{ MF; X[B]=EX(X[B]); X[B+1]=EX(X[B+1]); X[B+2]=EX(X[B+2]); X[B+3]=EX(X[B+3]); PIN(X); SBAR(); }while(0)
  #define VRD(i) do{ vlo[i]=vtr(vp_+(((i)>>2)*4096+((i)&3)*1024)); vhi[i]=vtr(vp_+(((i)>>2)*4096+((i)&3)*1024+512)); }while(0)
  #define KRD(G,j) do{ if(G){ kload2(kf,kp0+sl_next,j); SBAR(); } }while(0)
  #define NXB(G,X,g,tt,off) do{ if(G){ BGRP(X,g,64*(tt)+(off)); PIN(X); SBAR(); } }while(0)
  #define STEP(C0,C1,P0,P1,t,GK,GV,GL) do{ SBAR(); \
    const lds_cptr vp_=vp0+sl_prev; \
    VRD(0); SBAR(); float sacc=(P0[0]+P0[1]); \
    GAPA(C0=__builtin_amdgcn_mfma_f32_32x32x16_bf16(kf[0],qr[0],C0,0,0,0), P0[2],P0[3],P0[4],P0[5],     pw0[0]=PKW(P0,0), pw0[1]=PKW(P0,2), pw0); \
    VRD(4); SBAR(); GAPA(C1=__builtin_amdgcn_mfma_f32_32x32x16_bf16(kf[1],qr[0],C1,0,0,0), P0[6],P0[7],P0[8],P0[9],     pw0[2]=PKW(P0,4), pw0[3]=PKW(P0,6), pw0); \
    VRD(1); SBAR(); GAPA(C0=__builtin_amdgcn_mfma_f32_32x32x16_bf16(kf[2],qr[1],C0,0,0,0),   P0[10],P0[11],P0[12],P0[13], pw1[0]=PKW(P0,8), pw1[1]=PKW(P0,10), pw1); \
    VRD(5); SBAR(); GAPA(C1=__builtin_amdgcn_mfma_f32_32x32x16_bf16(kf[3],qr[1],C1,0,0,0),   P0[14],P0[15],P1[0],P1[1],   pw1[2]=PKW(P0,12),pw1[3]=PKW(P0,14), pw1); \
    VRD(2); SBAR(); GAPA(C0=__builtin_amdgcn_mfma_f32_32x32x16_bf16(kf[4],qr[2],C0,0,0,0),   P1[2],P1[3],P1[4],P1[5],     pw2[0]=PKW(P1,0), pw2[1]=PKW(P1,2), pw2); \
    VRD(6); SBAR(); GAPA(C1=__builtin_amdgcn_mfma_f32_32x32x16_bf16(kf[5],qr[2],C1,0,0,0),   P1[6],P1[7],P1[8],P1[9],     pw2[2]=PKW(P1,4), pw2[3]=PKW(P1,6), pw2); \
    VRD(3); SBAR(); GAPA(C0=__builtin_amdgcn_mfma_f32_32x32x16_bf16(kf[6],qr[3],C0,0,0,0),   P1[10],P1[11],P1[12],P1[13], pw3[0]=PKW(P1,8), pw3[1]=PKW(P1,10), pw3); \
    VRD(7); SBAR(); GAPA(C1=__builtin_amdgcn_mfma_f32_32x32x16_bf16(kf[7],qr[3],C1,0,0,0),   P1[14],P1[15],0.f,0.f,       pw3[2]=PKW(P1,12),pw3[3]=PKW(P1,14), pw3); \
    l_reg+=sacc; \
    if(GK){DMA_K((t)+3,sl_cur);} if(GV){DMA_V((t)+1,sl_next);} \
    CMASK(C0,C1,t); \
    { float a=MX3(C0[0],C0[1],C1[0]),b=MX3(C0[2],C0[3],C1[1]); a=MX3(a,C1[2],C1[3]); \
      _Pragma("unroll") for(int r=4;r<16;r+=4){a=MX3(a,C0[r],C0[r+1]);b=MX3(b,C0[r+2],C0[r+3]);a=MX3(a,C1[r],C1[r+1]);b=MX3(b,C1[r+2],C1[r+3]);} \
      float rm=__builtin_fmaxf(a,b); { auto rr=__builtin_amdgcn_permlane32_swap(__float_as_uint(rm),__float_as_uint(rm),false,false); rm=__builtin_fmaxf(__uint_as_float(rr[0]),__uint_as_float(rr[1])); } \
      resc=false; \
      if(__builtin_expect(__any(rm>(float)THRL),0)){ const float dl=__builtin_fmaxf(rm,0.f); mhat+=dl; \
        _Pragma("unroll") for(int r=0;r<16;++r){C0[r]-=dl;C1[r]-=dl;} \
        const float f=__builtin_amdgcn_exp2f(-dl); l_reg*=f; if(hi==0)wsf[r32]=f; resc=true; } } \
    SBAR(); \
    GAPB(o[0]=__builtin_amdgcn_mfma_f32_32x32x16_bf16(PAF(0),VFR(0),o[0],0,0,0), C0,0);  NXB(GL,P0,0,(t)+1,0); \
    GAPB(o[1]=__builtin_amdgcn_mfma_f32_32x32x16_bf16(PAF(0),VFR(4),o[1],0,0,0), C0,4);  NXB(GL,P0,1,(t)+1,0); \
    KRD(GL,0); GAPB(o[0]=__builtin_amdgcn_mfma_f32_32x32x16_bf16(PAF(1),VFR(1),o[0],0,0,0), C0,8);  NXB(GL,P0,2,(t)+1,0); \
    KRD(GL,1); GAPB(o[1]=__builtin_amdgcn_mfma_f32_32x32x16_bf16(PAF(1),VFR(5),o[1],0,0,0), C0,12); NXB(GL,P0,3,(t)+1,0); \
    KRD(GL,2); GAPB(o[0]=__builtin_amdgcn_mfma_f32_32x32x16_bf16(PAF(2),VFR(2),o[0],0,0,0), C1,0);  NXB(GL,P1,0,(t)+1,32); \
    KRD(GL,3); GAPB(o[1]=__builtin_amdgcn_mfma_f32_32x32x16_bf16(PAF(2),VFR(6),o[1],0,0,0), C1,4);  NXB(GL,P1,1,(t)+1,32); \
    GAPB(o[0]=__builtin_amdgcn_mfma_f32_32x32x16_bf16(PAF(3),VFR(3),o[0],0,0,0), C1,8);  NXB(GL,P1,2,(t)+1,32); \
    GAPB(o[1]=__builtin_amdgcn_mfma_f32_32x32x16_bf16(PAF(3),VFR(7),o[1],0,0,0), C1,12); NXB(GL,P1,3,(t)+1,32); \
    }while(0)
  int t=1;
  #undef CMASK
  #define CMASK(P0,P1,t) do{}while(0)
  for(;t+5<NT;t+=2){
    STEP(pB0,pB1,pA0,pA1,t,true,true,true);     WAIT_BAR(2); RESC(); ROT();
    STEP(pA0,pA1,pB0,pB1,t+1,true,true,true);   WAIT_BAR(2); RESC(); ROT();
  }
  #undef CMASK
  #define CMASK(P0,P1,t) do{int jb_=(t)-(NT-4); if(jb_>=0)cmask(P0,P1,jb_,qrel,hi);}while(0)
  #define ENDW(tt) do{ if((tt)+3<NT){WAIT_BAR(2);} else if((tt)+2<NT){WAIT_BAR(1);} else {WAIT_BAR(0);} }while(0)
  for(;t+1<NT;t+=2){
    STEP(pB0,pB1,pA0,pA1,t,(t+3<NT),(t+1<NT),(t+1<NT));       ENDW(t);   RESC(); ROT();
    STEP(pA0,pA1,pB0,pB1,t+1,(t+4<NT),(t+2<NT),(t+2<NT));     ENDW(t+1); RESC(); ROT();
  }
  STEP(pB0,pB1,pA0,pA1,NT-1,false,false,false); RESC();
  { float sacc=pB0[0]+pB0[1]; _Pragma("unroll") for(int r=2;r<16;++r)sacc+=pB0[r]; _Pragma("unroll") for(int r=0;r<16;++r)sacc+=pB1[r]; l_reg+=sacc;
    pw0=(u32x4){PKW(pB0,0),PKW(pB0,2),PKW(pB0,4),PKW(pB0,6)};pw1=(u32x4){PKW(pB0,8),PKW(pB0,10),PKW(pB0,12),PKW(pB0,14)};pw2=(u32x4){PKW(pB1,0),PKW(pB1,2),PKW(pB1,4),PKW(pB1,6)};pw3=(u32x4){PKW(pB1,8),PKW(pB1,10),PKW(pB1,12),PKW(pB1,14)};
    SBAR(); pv(o,vb0+sl_cur,PAF(0),PAF(1),PAF(2),PAF(3)); }
  #undef PKW
  #undef PAF
  #undef VFR
  #undef PIN
  #undef MX3
  #undef GAPA
  #undef GAPB
  #undef EX
  #undef VRD
  #undef KRD
  #undef NXB
  #undef STEP
  #undef ENDW
  {auto rr=__builtin_amdgcn_permlane32_swap(__float_as_uint(l_reg),__float_as_uint(l_reg),false,false);l_reg=__uint_as_float(rr[0])+__uint_as_float(rr[1]);}
  if(hi==0)wsf[32+r32]=l_reg;asm volatile("s_waitcnt lgkmcnt(0)":::"memory");
  float rli[16];
  #pragma unroll
  for(int r=0;r<16;++r)rli[r]=__builtin_amdgcn_rcpf(wsf[32+crow(r,hi)]);
  bf16*Ow=O+(rowbase+q0+wid*QBLK)*DM+h*D;
  { bf16*stg=(bf16*)(shm+LDS_OST)+wid*2048;
    #pragma unroll
    for(int r=0;r<16;++r){const int orow=crow(r,hi);
      #pragma unroll
      for(int d0=0;d0<2;++d0)stg[orow*64+d0*32+r32]=(bf16)(cvtpk_s(o[d0][r]*rli[r],0.f)&0xffffu);}
    asm volatile("s_waitcnt lgkmcnt(0)":::"memory");
    #pragma unroll
    for(int i=0;i<4;++i){const int row=i*8+(lane>>3),ch=lane&7; const u32x4 v=*(const u32x4*)(stg+row*64+ch*8); ATTN_STORE16(Ow+(long)row*DM+ch*8,v);} }
  asm volatile("s_waitcnt lgkmcnt(0)\n\ts_barrier":::"memory");
  #undef DMA_K
  #undef DMA_V
  #undef BINIT
  #undef BGRP
  #undef CMASK
  #undef START
  #undef RESC
  #undef ROT
}
constexpr int ATTN_LDS_BYTES=LDS_BYTES;
struct AttnTensors { const bf16* Q; const bf16* K; const bf16* V; bf16* O; const float* CKH; };
struct AttnUnit { int bh; int qb; };
struct StaticOrder {
  int G,c;
  __device__ __forceinline__ StaticOrder(int grid,int block):G(grid),c(block){}
  __device__ __forceinline__ bool next(int i,AttnUnit&u)const{ const int L=i*G+c; if(L>=BATCH*NHEAD*NQB)return false; const int ii=L>>8,g=L&255,s=g>>7,base=2*(ii>>1)+s; u.bh=g&127; u.qb=(ii&1)?(NQB-1-base):base; return true; }
  __device__ __forceinline__ void a_ready(const AttnUnit&)const{}
  __device__ __forceinline__ void done(const AttnUnit&)const{}
};
template<class Sched,int THRL=8> __device__ __forceinline__ void attn_phase(char*lds,const AttnTensors&T,const Sched&S){
  AttnUnit u;
  for(int i=0;S.next(i,u);++i){ S.a_ready(u); attn_unit<THRL>(u.bh/NHEAD,u.bh%NHEAD,u.qb,T.Q,T.K,T.V,T.O,T.CKH,lds); S.done(u); }
}
#undef SBAR
#undef WAIT_BAR
}

DI void ln_rows(const float* src, const float* g, const float* b, float* dst, bf16_t* xb, int gw, int ngw, int lane) {
    f32x4 gv[4], bv[4];
#pragma unroll
    for (int j = 0; j < 4; ++j) { gv[j] = *(const f32x4*)(g + lane * 4 + 256 * j); bv[j] = *(const f32x4*)(b + lane * 4 + 256 * j); }
    for (int row = gw; row < NTOK; row += ngw) {
        f32x4 v[4]; float s = 0.f;
#pragma unroll
        for (int j = 0; j < 4; ++j) { v[j] = *(const f32x4*)(src + (size_t)row * DM + lane * 4 + 256 * j); s += (v[j][0] + v[j][1]) + (v[j][2] + v[j][3]); }
        const float mean = wave_sum(s) * (1.f / DM); float s2 = 0.f;
#pragma unroll
        for (int j = 0; j < 4; ++j) { v[j] = v[j] - mean; s2 += (v[j][0] * v[j][0] + v[j][1] * v[j][1]) + (v[j][2] * v[j][2] + v[j][3] * v[j][3]); }
        const float rstd = 1.0f / sqrtf(wave_sum(s2) * (1.f / DM) + LN_EPS);
#pragma unroll
        for (int j = 0; j < 4; ++j) { const f32x4 y = v[j] * rstd * gv[j] + bv[j];
            if (dst) *(f32x4*)(dst + (size_t)row * DM + lane * 4 + 256 * j) = y;
            if (xb) *(u32x2*)(xb + (size_t)row * DM + lane * 4 + 256 * j) = pk4(y); }
    }
}

DI void moe_tables(const unsigned* cnt, LAS int* tstart, LAS int* cntl) {
    __syncthreads();
    if (threadIdx.x == 0) {
        int t = 0;
        for (int e = 0; e < NEXP; ++e) { const int c = (int)cnt[e]; cntl[e] = c; tstart[e] = t; t += (c + 255) >> 8; }
        tstart[NEXP] = t;
    }
    __syncthreads();
}

#define XB_TMO      128
#define XB_XCNT(j)  (256  + 64 * (j))
#define XB_XSUB(j)  (1280 + 64 * (j))
#define XB_XGEN(j)  (2304 + 64 * (j))
#define XB_TOP      3328
#define XB_TOPGEN   3392
#define XCD_BAR_WORDS 3456
#define XB_SPIN_CAP (1u << 18)
__device__ __forceinline__ unsigned xb_ld(unsigned* p)              { return __hip_atomic_load(p, __ATOMIC_RELAXED, __HIP_MEMORY_SCOPE_AGENT); }
__device__ __forceinline__ unsigned xb_add(unsigned* p, unsigned v) { return __hip_atomic_fetch_add(p, v, __ATOMIC_RELAXED, __HIP_MEMORY_SCOPE_AGENT); }
__device__ __forceinline__ unsigned xb_xcc_id() { return (unsigned)__builtin_amdgcn_s_getreg((3 << 11) | 20) & 0xFu; }
#define XB_SPIN(cond, bar) do { unsigned _sp = 0; while (cond) { __builtin_amdgcn_s_sleep(1); \
    if ((++_sp & 255u) == 0u) { if (xb_ld(&(bar)[XB_TMO])) break; if (_sp > XB_SPIN_CAP) { atomicAdd(&(bar)[XB_TMO], 1u); break; } } } } while (0)
struct XcdBarrier { unsigned* bar; unsigned x; volatile LAS unsigned* st; };
__device__ __forceinline__ XcdBarrier xcd_barrier_post(unsigned* bar, volatile LAS unsigned* st) {
    XcdBarrier b; b.bar = bar; b.x = xb_xcc_id(); b.st = st;
    if (threadIdx.x == 0) (void)xb_add(&bar[XB_XCNT(b.x)], 1u);
    return b;
}
__device__ __forceinline__ void xcd_barrier_complete(unsigned* bar, unsigned x, unsigned& nloc, unsigned& nx) {
    const unsigned G = gridDim.x * gridDim.y * gridDim.z;
    unsigned sum, cnt, mine, sp = 0u;
    for (;;) {
        sum = 0u; cnt = 0u; mine = 0u;
#pragma unroll
        for (unsigned j = 0; j < 16; ++j) { const unsigned c = xb_ld(&bar[XB_XCNT(j)]); sum += c; cnt += (c > 0u) ? 1u : 0u; mine = (j == x) ? c : mine; }
        if (sum == G) break;
        __builtin_amdgcn_s_sleep(1);
        if ((++sp & 255u) == 0u) { if (xb_ld(&bar[XB_TMO])) break; if (sp > XB_SPIN_CAP) { atomicAdd(&bar[XB_TMO], 1u); break; } }
    }
    nloc = mine > 0u ? mine : 1u; nx = cnt > 0u ? cnt : 1u;
}
__device__ __forceinline__ void xcd_barrier(const XcdBarrier& b) {
    asm volatile("s_waitcnt vmcnt(0)" ::: "memory");
    __syncthreads();
    if (threadIdx.x == 0) {
        unsigned* bar = b.bar;
        __builtin_amdgcn_s_waitcnt(0);
        unsigned nloc = b.st[0], nx = b.st[1];
        if (nloc == 0u) { xcd_barrier_complete(bar, b.x, nloc, nx); b.st[0] = nloc; b.st[1] = nx; }
        const unsigned old = xb_add(&bar[XB_XSUB(b.x)], 1u);
        const unsigned gen = old / nloc;
        if (old + 1u == (gen + 1u) * nloc) {
            __builtin_amdgcn_fence(__ATOMIC_RELEASE, "agent");
            asm volatile("s_waitcnt vmcnt(0)" ::: "memory");
            const unsigned og = xb_add(&bar[XB_TOP], 1u);
            const unsigned tg = og / nx;
            if (og + 1u == (tg + 1u) * nx) xb_add(&bar[XB_TOPGEN], 1u);
            else XB_SPIN(xb_ld(&bar[XB_TOPGEN]) == tg, bar);
            __builtin_amdgcn_fence(__ATOMIC_ACQUIRE, "agent");
            xb_add(&bar[XB_XGEN(b.x)], 1u);
            asm volatile("s_waitcnt vmcnt(0)" ::: "memory");
        } else {
            XB_SPIN(xb_ld(&bar[XB_XGEN(b.x)]) == gen, bar);
            __builtin_amdgcn_fence(__ATOMIC_ACQUIRE, "agent");
            asm volatile("s_waitcnt vmcnt(0)" ::: "memory");
        }
    }
    __syncthreads();
}

template <int PH> DI void run_phase(const Args& a, LAS unsigned char* lds) {
    int tid_ = threadIdx.x; asm volatile("" : "+v"(tid_));
    const int tid = tid_, lane = tid & 63, wid = tid >> 6;
    const int G = gridDim.x, bid = blockIdx.x;
    const int gw = bid * 8 + wid, ngw = G * 8, gtid = bid * 512 + tid, gthreads = G * 512;
    unsigned char* ws = a.ws;
    constexpr int L = (PH >= 13) ? 1 : 0;
    constexpr int IB_MOE = L ? 32 : 16;
    unsigned* cnt = (unsigned*)(ws + WS_CTL) + 64 * L;
    bf16_t* XB = (bf16_t*)(ws + WS_XB);
    LAS unsigned char* misc = lds + 131072;
    LAS int* tstart = (LAS int*)misc; LAS int* cntl = tstart + 72;
    float* SSQ_Q = (float*)(ws + WS_CTL + 256 * 1024); float* SSQ_KV = (float*)(ws + WS_TAB + 128 * 1024);

    if constexpr (PH == 0) {
        LAS float* scr = (LAS float*)(lds + wid * 8448);
        constexpr int I_IN = (1024 / 64) * (N_IN0 / 32), I_UQ = (256 / 64) * (768 / 32), I_UKV = (256 / 64) * (1280 / 32), I_OUT = (1024 / 64) * (1024 / 32);
        for (int it = gw; it < I_IN + I_UQ + I_UKV + I_OUT; it += ngw) {
            int r = it;
            if (r < I_IN) { prep_item((const float*)a.in(2), nullptr, 1440, 1024, nullptr, (bf16_t*)(ws + W_IN), 1024, N_IN0, map_in0, scr, r, lane); continue; } r -= I_IN;
            if (r < I_UQ) { prep_item((const float*)a.in(9), nullptr, 768, 256, (const float*)a.in(8), (bf16_t*)(ws + W_UQ), 256, 768, map_q, scr, r, lane); continue; } r -= I_UQ;
            if (r < I_UKV) { prep_item((const float*)a.in(11), nullptr, 1024, 128, (const float*)a.in(10), (bf16_t*)(ws + W_UKV), 256, 1280, map_kv, scr, r, lane); continue; } r -= I_UKV;
            prep_item((const float*)a.in(12), nullptr, 1024, 1024, nullptr, (bf16_t*)(ws + W_OUT), 1024, 1024, map_ident, scr, r, lane);
        }
        prep_moe(a, 16, scr, gw, ngw, lane, gtid, gthreads);
        float* b0 = (float*)(ws + WS_TAB); float* b1 = (float*)(ws + WS_TAB + 8192);
        for (int n = gtid; n < N_IN0; n += gthreads) { const int s = map_in0(n); b0[n] = s >= 0 ? ((const float*)a.in(3))[s] : 0.f; }
        for (int n = gtid; n < N_IN1; n += gthreads) b1[n] = n < 3088 ? ((const float*)a.in(27))[n] : 0.f;
        float* ct = (float*)(ws + WS_COS); float* st = (float*)(ws + WS_SIN); const int* pos = (const int*)a.in(1);
        for (int idx = gtid; idx < NTOK * 16; idx += gthreads) {
            const int t = idx >> 4, p = idx & 15;
            const float inv = 1.0f / exp2f((float)p * (13.287712379549449f / 16.0f));
            const float ang = (float)pos[t] * inv;
            double rev = (double)ang * 0.15915494309189535; rev -= rint(rev);
            ct[idx] = __builtin_amdgcn_cosf((float)rev); st[idx] = __builtin_amdgcn_sinf((float)rev);
        }
        const float* x = (const float*)a.in(0);
        for (int idx = gtid; idx < NTOK * DM / 8; idx += gthreads) {
            const f32x4 v0 = *(const f32x4*)(x + (size_t)idx * 8), v1 = *(const f32x4*)(x + (size_t)idx * 8 + 4);
            u32x4 o; o.x = pk2(v0[0], v0[1]); o.y = pk2(v0[2], v0[3]); o.z = pk2(v1[0], v1[1]); o.w = pk2(v1[2], v1[3]);
            *(u32x4*)(XB + (size_t)idx * 8) = o;
        }
    }
    else if constexpr (PH == 1) {
        const bf16_t* Bt = (const bf16_t*)(ws + W_IN); const float* bias = (const float*)(ws + WS_TAB);
        bf16_t* UPRE = (bf16_t*)(ws + B_UPRE); bf16_t* QL = (bf16_t*)(ws + B_QL); bf16_t* KVL = (bf16_t*)(ws + B_KVL);
        pg8::DenseOrder S; S.init(NTOK, N_IN0, 1024, Bt, G, bid);
        auto f = [=](const pg8::Unit& u, int r, int c, f32x4 l0, f32x4 l1, f32x4 h0, f32x4 h1) {
            const int nt = u.pn; const size_t row = (size_t)u.pm * 256 + r;
            l0 = l0 + *(const f32x4*)(bias + nt * 256 + c); l1 = l1 + *(const f32x4*)(bias + nt * 256 + c + 4);
            h0 = h0 + *(const f32x4*)(bias + nt * 256 + 128 + c); h1 = h1 + *(const f32x4*)(bias + nt * 256 + 128 + c + 4);
            if (nt < 4) {
#pragma unroll
                for (int i = 0; i < 4; ++i) { l0[i] = l0[i] * sigmoidf_(h0[i]); l1[i] = l1[i] * sigmoidf_(h1[i]); }
                *(u32x4*)(UPRE + row * 512 + nt * 128 + c) = pk8(l0, l1);
            } else {
                bf16_t* dst = QL + (size_t)(nt - 4) * (B_KVL - B_QL) / 2;
                *(u32x4*)(dst + row * 256 + c) = pk8(l0, l1); *(u32x4*)(dst + row * 256 + 128 + c) = pk8(h0, h1);
                float ss = dot4(l0) + dot4(l1); if (nt == 4) ss += dot4(h0) + dot4(h1);
                ss += __shfl_xor(ss, 16); ss += __shfl_xor(ss, 32);
                if ((lane >> 4) == 0) { if (nt == 4) SSQ_Q[row * 4 + (c >> 5)] = ss; else SSQ_KV[row * 4 + (c >> 5)] = ss; }
            }
        };
        pg8::gemm_phase(lds, XB, 1024, S, pg8::make_epi(f));
    }
    else if constexpr (PH == 2) {
        const bf16_t* UPRE = (const bf16_t*)(ws + B_UPRE); bf16_t* UO = (bf16_t*)(ws + B_UO);
        {
            const float* cw = (const float*)a.in(4); const float* cb = (const float*)a.in(5); const float* lg = (const float*)a.in(6); const float* lb = (const float*)a.in(7);
            LAS bf16_t* U = (LAS bf16_t*)lds;
            LAS float* CO = (LAS float*)(lds + 94 * 512 * 2);
            float w[31];
#pragma unroll
            for (int j = 0; j < 31; ++j) w[j] = cw[j * 512 + tid];
            const float bch = cb[tid];
            f32x4 g0 = *(const f32x4*)(lg + lane * 8), g1 = *(const f32x4*)(lg + lane * 8 + 4), b0 = *(const f32x4*)(lb + lane * 8), b1 = *(const f32x4*)(lb + lane * 8 + 4);
            for (int u = bid; u < NTOK / 64; u += G) {
                const int tok0 = u * 64, s0 = tok0 % SEQ;
                __syncthreads();
                for (int c = tid; c < 94 * 64; c += 512) { const int r = c >> 6, ch = c & 63; const int s = s0 - 30 + r;
                    u32x4 v = (u32x4){0u, 0u, 0u, 0u}; if (s >= 0) v = *(const u32x4*)(UPRE + (size_t)(tok0 - 30 + r) * 512 + ch * 8);
                    *(LAS u32x4*)(U + r * 512 + ch * 8) = v; }
                __syncthreads();
                for (int sub = 0; sub < 4; ++sub) {
                    for (int tt = 0; tt < 16; ++tt) { const int tl = sub * 16 + tt; float acc = bch;
#pragma unroll
                        for (int j = 0; j < 31; ++j) acc += w[j] * bf2f(U[(tl + j) * 512 + tid]);
                        CO[tt * 512 + tid] = acc; }
                    __syncthreads();
#pragma unroll
                    for (int k = 0; k < 2; ++k) { const int tt = 2 * wid + k;
                        f32x4 v0 = *(LAS f32x4*)(CO + tt * 512 + lane * 8), v1 = *(LAS f32x4*)(CO + tt * 512 + lane * 8 + 4);
                        const float mean = wave_sum((v0[0] + v0[1]) + (v0[2] + v0[3]) + (v1[0] + v1[1]) + (v1[2] + v1[3])) * (1.f / 512.f);
                        v0 = v0 - mean; v1 = v1 - mean;
                        const float var = wave_sum((v0[0] * v0[0] + v0[1] * v0[1]) + (v0[2] * v0[2] + v0[3] * v0[3]) + (v1[0] * v1[0] + v1[1] * v1[1]) + (v1[2] * v1[2] + v1[3] * v1[3])) * (1.f / 512.f);
                        const float rstd = 1.0f / sqrtf(var + LN_EPS);
                        f32x4 y0 = v0 * rstd * g0 + b0, y1 = v1 * rstd * g1 + b1;
#pragma unroll
                        for (int i = 0; i < 4; ++i) { y0[i] = siluf_(y0[i]); y1[i] = siluf_(y1[i]); }
                        u32x4 o; o.x = pk2(y0[0], y0[1]); o.y = pk2(y0[2], y0[3]); o.z = pk2(y1[0], y1[1]); o.w = pk2(y1[2], y1[3]);
                        *(u32x4*)(UO + (size_t)(tok0 + sub * 16 + tt) * 1024 + lane * 8) = o; }
                    __syncthreads();
                }
            }
        }
        const float* ct = (const float*)(ws + WS_COS); const float* st = (const float*)(ws + WS_SIN);
        {
            const bf16_t* QL = (const bf16_t*)(ws + B_QL); bf16_t* Q0 = (bf16_t*)(ws + B_Q0);
            pg8::DenseOrder S; S.init(NTOK, 768, 256, (const bf16_t*)(ws + W_UQ), G, bid);
            auto f = [=](const pg8::Unit& u, int r, int c, f32x4 l0, f32x4 l1, f32x4 h0, f32x4 h1) {
                const size_t row = (size_t)u.pm * 256 + r; const f32x4 sq = *(const f32x4*)(SSQ_Q + row * 4); const float s = 1.0f / sqrtf(((sq[0] + sq[1]) + (sq[2] + sq[3])) * (1.f / 256.f) + RMS_EPS);
#pragma unroll
                for (int hh = 0; hh < 2; ++hh) { f32x4 v0 = (hh ? h0 : l0) * s, v1 = (hh ? h1 : l1) * s; const int col = u.pn * 256 + c + 128 * hh; const int d = col % 96;
                    if (d >= 64) rope8(v0, v1, ct, st, row, (d - 64) >> 1);
                    *(u32x4*)(Q0 + row * 768 + col) = pk8(v0 * C2_MLA, v1 * C2_MLA); }
            };
            pg8::gemm_phase(lds, QL, 256, S, pg8::make_epi(f));
        }
        {
            const bf16_t* KVL = (const bf16_t*)(ws + B_KVL); bf16_t* K0 = (bf16_t*)(ws + B_K0); bf16_t* V0 = (bf16_t*)(ws + B_V0);
            pg8::DenseOrder S; S.init(NTOK, 1280, 256, (const bf16_t*)(ws + W_UKV), G, bid);
            auto f = [=](const pg8::Unit& u, int r, int c, f32x4 l0, f32x4 l1, f32x4 h0, f32x4 h1) {
                const size_t row = (size_t)u.pm * 256 + r; const f32x4 sq = *(const f32x4*)(SSQ_KV + row * 4); const float s = 1.0f / sqrtf(((sq[0] + sq[1]) + (sq[2] + sq[3])) * (1.f / 128.f) + RMS_EPS);
#pragma unroll
                for (int hh = 0; hh < 2; ++hh) { f32x4 v0 = (hh ? h0 : l0), v1 = (hh ? h1 : l1); const int col = u.pn * 256 + c + 128 * hh;
                    if (col < 768) { const int d = col % 96;
                        if (d >= 64) rope8(v0, v1, ct, st, row, (d - 64) >> 1); else { v0 = v0 * s; v1 = v1 * s; }
                        *(u32x4*)(K0 + row * 768 + col) = pk8(v0, v1); }
                    else *(u32x4*)(V0 + row * 512 + (col - 768)) = pk8(v0 * s, v1 * s); }
            };
            pg8::gemm_phase(lds, KVL, 256, S, pg8::make_epi(f));
        }
    }
    else if constexpr (PH == 3) {
        const bf16_t* Q0 = (const bf16_t*)(ws + B_Q0); const bf16_t* K0 = (const bf16_t*)(ws + B_K0); const bf16_t* V0 = (const bf16_t*)(ws + B_V0); bf16_t* UO = (bf16_t*)(ws + B_UO);
        for (int u = bid; u < 64 * 16; u += G) {
            const int i = u >> 8, gp = u & 255, s = gp >> 6, bh = gp & 63, base = 4 * (i >> 1) + s, qb = (i & 1) ? 15 - base : base;
            const int b = bh >> 3, h = bh & 7;
            attn_simple_unit<96, 768, 768, 512, 1024, false>(lds, Q0, K0, V0, UO, nullptr, b, h * 96, h * 64, 0, 512 + h * 64, qb);
        }
    }
    else if constexpr (PH == 4 || PH == 16) {
        const bf16_t* A = (const bf16_t*)(ws + (L ? B_O1 : B_UO));
        const float* bias = (const float*)a.in(L ? 29 : 13); const float* xres = L ? (const float*)a.out : (const float*)a.in(0); float* pre = a.out;
        pg8::DenseOrder S; S.init(NTOK, 1024, 1024, (const bf16_t*)(ws + W_OUT), G, bid);
        auto f = [=](const pg8::Unit& u, int r, int c, f32x4 l0, f32x4 l1, f32x4 h0, f32x4 h1) {
            const int col = u.pn * 256 + c; const size_t off = ((size_t)u.pm * 256 + r) * 1024 + col;
            const f32x4 x0 = *(const f32x4*)(xres + off), x1 = *(const f32x4*)(xres + off + 4), x2 = *(const f32x4*)(xres + off + 128), x3 = *(const f32x4*)(xres + off + 132);
            *(f32x4*)(pre + off) = x0 * ALPHA + l0 + *(const f32x4*)(bias + col); *(f32x4*)(pre + off + 4) = x1 * ALPHA + l1 + *(const f32x4*)(bias + col + 4);
            *(f32x4*)(pre + off + 128) = x2 * ALPHA + h0 + *(const f32x4*)(bias + col + 128); *(f32x4*)(pre + off + 132) = x3 * ALPHA + h1 + *(const f32x4*)(bias + col + 132);
        };
        pg8::gemm_phase(lds, A, 1024, S, pg8::make_epi(f));
    }
    else if constexpr (PH == 5 || PH == 17) {
        ln_rows(a.out, (const float*)a.in(L ? 30 : 14), (const float*)a.in(L ? 31 : 15), a.out, XB, gw, ngw, lane);
    }
    else if constexpr (PH == 6 || PH == 18) {
        {
            const float* x1 = a.out; const bf16_t* rhi = (const bf16_t*)(ws + W_RHI); const bf16_t* rlo = (const bf16_t*)(ws + W_RLO);
            const float* rbias = (const float*)a.in(IB_MOE + 1);
            int* LIST = (int*)(ws + B_LIST); float* TOKW = (float*)(ws + B_TOKW);
            LAS unsigned char* Ah = lds; LAS unsigned char* Al = lds + 8192; LAS unsigned char* Bh = lds + 16384; LAS unsigned char* Bl = lds + 20480;
            LAS float* lgl = (LAS float*)(lds + 24576);
            LAS int* lcnt = (LAS int*)(lds + 24576 + 33280);
            LAS int* lbase = lcnt + 64;
            LAS int* sel_e = lbase + 64;
            LAS int* sel_p = sel_e + 768;
            const int fr = lane & 15, fq = lane >> 4;
            const float mybias = rbias[lane];
            for (int u = bid; u < NTOK / 128; u += G) {
                const int t0 = u * 128;
                f32x4 acc[4];
#pragma unroll
                for (int n = 0; n < 4; ++n) acc[n] = (f32x4){0.f, 0.f, 0.f, 0.f};
                const int sr = tid >> 2, sc = (tid & 3) * 8;
                for (int kt = 0; kt < 32; ++kt) {
                    const f32x4 v0 = *(const f32x4*)(x1 + (size_t)(t0 + sr) * 1024 + kt * 32 + sc), v1 = *(const f32x4*)(x1 + (size_t)(t0 + sr) * 1024 + kt * 32 + sc + 4);
                    const u32x4 wv = *(const u32x4*)((tid < 256 ? rhi : rlo) + (size_t)((tid & 255) >> 2) * 1024 + kt * 32 + (tid & 3) * 8);
                    u32x4 h, lo_;
                    h.x = pk2(v0[0], v0[1]); h.y = pk2(v0[2], v0[3]); h.z = pk2(v1[0], v1[1]); h.w = pk2(v1[2], v1[3]);
                    lo_.x = pk2(v0[0] - __uint_as_float(h.x << 16), v0[1] - __uint_as_float(h.x & 0xffff0000u));
                    lo_.y = pk2(v0[2] - __uint_as_float(h.y << 16), v0[3] - __uint_as_float(h.y & 0xffff0000u));
                    lo_.z = pk2(v1[0] - __uint_as_float(h.z << 16), v1[1] - __uint_as_float(h.z & 0xffff0000u));
                    lo_.w = pk2(v1[2] - __uint_as_float(h.w << 16), v1[3] - __uint_as_float(h.w & 0xffff0000u));
                    __syncthreads();
                    *(LAS u32x4*)(Ah + sr * 64 + sc * 2) = h; *(LAS u32x4*)(Al + sr * 64 + sc * 2) = lo_;
                    *(LAS u32x4*)((tid < 256 ? Bh : Bl) + ((tid & 255) >> 2) * 64 + (tid & 3) * 16) = wv;
                    __syncthreads();
                    const bf16x8 ah = *(LAS bf16x8*)(Ah + (16 * wid + fr) * 64 + fq * 16), al = *(LAS bf16x8*)(Al + (16 * wid + fr) * 64 + fq * 16);
#pragma unroll
                    for (int n = 0; n < 4; ++n) { const bf16x8 bh = *(LAS bf16x8*)(Bh + (16 * n + fr) * 64 + fq * 16), bl = *(LAS bf16x8*)(Bl + (16 * n + fr) * 64 + fq * 16);
                        acc[n] = mfma16(bh, ah, acc[n]); acc[n] = mfma16(bh, al, acc[n]); acc[n] = mfma16(bl, ah, acc[n]); }
                }
#pragma unroll
                for (int n = 0; n < 4; ++n)
#pragma unroll
                    for (int j = 0; j < 4; ++j) lgl[(16 * wid + fr) * 65 + 16 * n + 4 * fq + j] = acc[n][j];
                if (tid < 64) lcnt[tid] = 0;
                __syncthreads();
                for (int tt = 0; tt < 16; ++tt) {
                    const int tl = 16 * wid + tt, t = t0 + tl;
                    const float sg = sigmoidf_(lgl[tl * 65 + lane]); const float ch = sg + mybias;
                    const int g = lane >> 3; int rk = 0;
#pragma unroll
                    for (int jj = 0; jj < 8; ++jj) { const int oj = (lane & ~7) + jj; const float o = __shfl(ch, oj); rk += ((o > ch) || (o == ch && oj < lane)) ? 1 : 0; }
                    float top = rk < 2 ? ch : 0.f; top += __shfl_xor(top, 1); top += __shfl_xor(top, 2); top += __shfl_xor(top, 4);
                    int grk = 0;
#pragma unroll
                    for (int gg = 0; gg < 8; ++gg) { const float o = __shfl(top, gg * 8); grk += ((o > top) || (o == top && gg < g)) ? 1 : 0; }
                    const bool gsel = grk < 4; const float mv = gsel ? ch : -INFINITY; int erk = 0;
#pragma unroll 8
                    for (int j = 0; j < 64; ++j) { const float o = __shfl(mv, j); erk += ((o > mv) || (o == mv && j < lane)) ? 1 : 0; }
                    const bool sel = gsel && erk < TOPK;
                    const float tot = wave_sum(sel ? sg : 0.f); const float w = sg / tot * 2.5f;
                    if (sel) { const int lp = __hip_atomic_fetch_add(lcnt + lane, 1, __ATOMIC_RELAXED, __HIP_MEMORY_SCOPE_WORKGROUP);
                        sel_e[tl * 6 + erk] = lane; sel_p[tl * 6 + erk] = lp; TOKW[(size_t)t * 8 + erk] = w; }
                }
                __syncthreads();
                if (tid < 64) { const int c = lcnt[tid]; lbase[tid] = c ? (int)atomicAdd(cnt + tid, (unsigned)c) : 0; }
                __syncthreads();
                for (int idx = tid; idx < 768; idx += 512) { const int e = sel_e[idx], pos = lbase[e] + sel_p[idx], tl = idx / 6, j = idx % 6; LIST[(size_t)e * LISTCAP + pos] = ((t0 + tl) << 3) | j; }
                __syncthreads();
            }
        }
        {
            bf16_t* SH = (bf16_t*)(ws + B_SH);
            pg8::DenseOrder S; S.init(NTOK, 512, 1024, (const bf16_t*)(ws + W_SGU), G, bid);
            auto f = [=](const pg8::Unit& u, int r, int c, f32x4 l0, f32x4 l1, f32x4 h0, f32x4 h1) {
#pragma unroll
                for (int i = 0; i < 4; ++i) { l0[i] = siluf_(l0[i]) * h0[i]; l1[i] = siluf_(l1[i]) * h1[i]; }
                *(u32x4*)(SH + ((size_t)u.pm * 256 + r) * 256 + u.pn * 128 + c) = pk8(l0, l1); };
            pg8::gemm_phase(lds, XB, 1024, S, pg8::make_epi(f));
        }
    }
    else if constexpr (PH == 7 || PH == 19) {
        moe_tables(cnt, tstart, cntl);
        bf16_t* H = (bf16_t*)(ws + B_H);
        pg8::GroupedOrder<true> S{tstart, cntl, 2, G, bid, (const char*)(ws + W_GU), (size_t)512 * 1024 * 2, (size_t)256 * 1024 * 2, (const int*)(ws + B_LIST)};
        auto f = [=](const pg8::Unit& u, int r, int c, f32x4 l0, f32x4 l1, f32x4 h0, f32x4 h1) {
#pragma unroll
            for (int i = 0; i < 4; ++i) { l0[i] = siluf_(l0[i]) * h0[i]; l1[i] = siluf_(l1[i]) * h1[i]; }
            *(u32x4*)(H + ((size_t)(tstart[u.e] + u.pm) * 256 + r) * 256 + u.pn * 128 + c) = pk8(l0, l1); };
        pg8::gemm_phase(lds, XB, 1024, S, pg8::make_epi(f));
    }
    else if constexpr (PH == 8 || PH == 10 || PH == 20 || PH == 22) {
        constexpr int P = (PH == 10 || PH == 22) ? 1 : 0;
        moe_tables(cnt, tstart, cntl);
        const int* LIST = (const int*)(ws + B_LIST); const float* TOKW = (const float*)(ws + B_TOKW); bf16_t* YT = (bf16_t*)(ws + B_YT);
        pg8::GroupedOrder<false> S{tstart, cntl, 2, G, bid, (const char*)(ws + W_D) + (size_t)512 * P * 256 * 2, (size_t)1024 * 256 * 2, (size_t)256 * 256 * 2, LIST};
        auto f = [=](const pg8::Unit& u, int r, int c, f32x4 l0, f32x4 l1, f32x4 h0, f32x4 h1) {
            const int i = u.pm * 256 + r;
            if (i < cntl[u.e]) { const int v = LIST[(size_t)u.e * LISTCAP + i]; const float w = TOKW[v]; const size_t dst = ((size_t)(v >> 3) * 6 + (v & 7)) * 512 + u.pn * 256 + c;
                *(u32x4*)(YT + dst) = pk8(l0 * w, l1 * w); *(u32x4*)(YT + dst + 128) = pk8(h0 * w, h1 * w); } };
        pg8::gemm_phase(lds, (const bf16_t*)(ws + B_H), 256, S, pg8::make_epi(f));
    }
    else if constexpr (PH == 9 || PH == 11 || PH == 21 || PH == 23) {
        constexpr int P = (PH == 11 || PH == 23) ? 1 : 0;
        const bf16_t* YT = (const bf16_t*)(ws + B_YT); float* xo = a.out;
        pg8::DenseOrder S; S.init(NTOK, 512, 256, (const bf16_t*)(ws + W_SD) + (size_t)512 * P * 256, G, bid);
        auto f = [=](const pg8::Unit& u, int r, int c, f32x4 l0, f32x4 l1, f32x4 h0, f32x4 h1) {
            const size_t row = (size_t)u.pm * 256 + r; const size_t off = row * 1024 + 512 * P + u.pn * 256 + c;
            l0 = l0 + *(const f32x4*)(xo + off) * ALPHA; l1 = l1 + *(const f32x4*)(xo + off + 4) * ALPHA; h0 = h0 + *(const f32x4*)(xo + off + 128) * ALPHA; h1 = h1 + *(const f32x4*)(xo + off + 132) * ALPHA;
#pragma unroll
            for (int j = 0; j < 6; ++j) { const u32x4 y0 = *(const u32x4*)(YT + (row * 6 + j) * 512 + u.pn * 256 + c), y1 = *(const u32x4*)(YT + (row * 6 + j) * 512 + u.pn * 256 + c + 128);
                l0[0] += __uint_as_float(y0.x << 16); l0[1] += __uint_as_float(y0.x & 0xffff0000u); l0[2] += __uint_as_float(y0.y << 16); l0[3] += __uint_as_float(y0.y & 0xffff0000u);
                l1[0] += __uint_as_float(y0.z << 16); l1[1] += __uint_as_float(y0.z & 0xffff0000u); l1[2] += __uint_as_float(y0.w << 16); l1[3] += __uint_as_float(y0.w & 0xffff0000u);
                h0[0] += __uint_as_float(y1.x << 16); h0[1] += __uint_as_float(y1.x & 0xffff0000u); h0[2] += __uint_as_float(y1.y << 16); h0[3] += __uint_as_float(y1.y & 0xffff0000u);
                h1[0] += __uint_as_float(y1.z << 16); h1[1] += __uint_as_float(y1.z & 0xffff0000u); h1[2] += __uint_as_float(y1.w << 16); h1[3] += __uint_as_float(y1.w & 0xffff0000u);
                if (j & 1) asm volatile("" ::: "memory"); }
            *(f32x4*)(xo + off) = l0; *(f32x4*)(xo + off + 4) = l1; *(f32x4*)(xo + off + 128) = h0; *(f32x4*)(xo + off + 132) = h1;
        };
        pg8::gemm_phase(lds, (const bf16_t*)(ws + B_SH), 256, S, pg8::make_epi(f));
    }
    else if constexpr (PH == 12) {
        ln_rows(a.out, (const float*)a.in(24), (const float*)a.in(25), a.out, XB, gw, ngw, lane);
        LAS float* scr = (LAS float*)(lds + wid * 8448);
        constexpr int I_IN = (1024 / 64) * (N_IN1 / 32), I_OUT = (1024 / 64) * (1024 / 32);
        for (int it = gw; it < I_IN + I_OUT; it += ngw) {
            int r = it;
            if (r < I_IN) { prep_item((const float*)a.in(26), nullptr, 3088, 1024, nullptr, (bf16_t*)(ws + W_IN), 1024, N_IN1, map_in1, scr, r, lane); continue; } r -= I_IN;
            prep_item((const float*)a.in(28), nullptr, 1024, 1024, nullptr, (bf16_t*)(ws + W_OUT), 1024, 1024, map_ident, scr, r, lane);
        }
        prep_moe(a, 32, scr, gw, ngw, lane, gtid, gthreads);
    }
    else if constexpr (PH == 13) {
        const float* bias = (const float*)(ws + WS_TAB + 8192);
        bf16_t* Q1 = (bf16_t*)(ws + B_Q1); bf16_t* K1 = (bf16_t*)(ws + B_K1); bf16_t* V1 = (bf16_t*)(ws + B_V1); float* GL = (float*)(ws + B_GL);
        pg8::DenseOrder S; S.init(NTOK, N_IN1, 1024, (const bf16_t*)(ws + W_IN), G, bid);
        auto f = [=](const pg8::Unit& u, int r, int c, f32x4 l0, f32x4 l1, f32x4 h0, f32x4 h1) {
            const int nt = u.pn; const size_t row = (size_t)u.pm * 256 + r;
            l0 = l0 + *(const f32x4*)(bias + nt * 256 + c); l1 = l1 + *(const f32x4*)(bias + nt * 256 + c + 4);
            h0 = h0 + *(const f32x4*)(bias + nt * 256 + 128 + c); h1 = h1 + *(const f32x4*)(bias + nt * 256 + 128 + c + 4);
            if (nt < 4) { *(u32x4*)(Q1 + row * 1024 + nt * 256 + c) = pk8(l0 * C2_FOX, l1 * C2_FOX); *(u32x4*)(Q1 + row * 1024 + nt * 256 + 128 + c) = pk8(h0 * C2_FOX, h1 * C2_FOX); }
            else if (nt < 8) { *(u32x4*)(K1 + row * 1024 + (nt - 4) * 256 + c) = pk8(l0, l1); *(u32x4*)(K1 + row * 1024 + (nt - 4) * 256 + 128 + c) = pk8(h0, h1); }
            else if (nt < 12) { *(u32x4*)(V1 + row * 1024 + (nt - 8) * 256 + c) = pk8(l0, l1); *(u32x4*)(V1 + row * 1024 + (nt - 8) * 256 + 128 + c) = pk8(h0, h1); }
            else if (c < 16) {
#pragma unroll
                for (int i = 0; i < 4; ++i) { float x = l0[i]; l0[i] = fminf(x, 0.f) - log1pf(__expf(-fabsf(x))); x = l1[i]; l1[i] = fminf(x, 0.f) - log1pf(__expf(-fabsf(x))); }
                *(f32x4*)(GL + row * 16 + c) = l0; *(f32x4*)(GL + row * 16 + c + 4) = l1; }
        };
        pg8::gemm_phase(lds, XB, 1024, S, pg8::make_epi(f));
    }
    else if constexpr (PH == 14) {
        const float* GL = (const float*)(ws + B_GL); float* CK = (float*)(ws + B_CK);
        for (int sq = gw; sq < NBATCH * 16; sq += ngw) {
            const int b = sq >> 4, h = sq & 15; float carry = 0.f;
            for (int i = 0; i < SEQ / 64; ++i) { const size_t t = (size_t)b * SEQ + i * 64 + lane; float v = GL[t * 16 + h];
#pragma unroll
                for (int o = 1; o < 64; o <<= 1) { const float n = __shfl_up(v, o); if (lane >= o) v += n; }
                v += carry; CK[((size_t)b * 16 + h) * SEQ + i * 64 + lane] = v * LOG2E; carry = __shfl(v, 63); }
        }
    }
    else if constexpr (PH == 15) {
        static_assert(attn_fox::ATTN_LDS_BYTES <= 131072, "attention LDS");
        const attn_fox::AttnTensors AT{(const bf16_t*)(ws + B_Q1), (const bf16_t*)(ws + B_K1), (const bf16_t*)(ws + B_V1), (bf16_t*)(ws + B_O1), (const float*)(ws + B_CK)};
        const attn_fox::StaticOrder S(G, bid);
        attn_fox::attn_phase<attn_fox::StaticOrder>((char*)lds, AT, S);
    }
    else if constexpr (PH == 24) {
        ln_rows(a.out, (const float*)a.in(40), (const float*)a.in(41), a.out, nullptr, gw, ngw, lane);
    }
}

constexpr int LDS_BYTES = 147456;
constexpr int CW_BAR = 4096;
constexpr int NPHASE = 25;
template <int PH, int END> struct RunAll {
    static DI void run(const Args& a, LAS unsigned char* lds, const XcdBarrier& bar) {
        run_phase<PH>(a, lds);
        if (PH + 1 < END) xcd_barrier(bar);
        RunAll<PH + 1, END>::run(a, lds, bar);
    }
};
template <int END> struct RunAll<END, END> { static DI void run(const Args&, LAS unsigned char*, const XcdBarrier&) {} };

__global__ void __launch_bounds__(512, 2) k_all(KArgs ka) {
    extern __shared__ __attribute__((aligned(16))) unsigned char lds_raw[];
    LAS unsigned char* lds = (LAS unsigned char*)lds_raw;
    Args a; a.tab = (LAS unsigned long long*)(lds + 131072 + 1024); a.out = ka.out; a.ws = ka.ws;
    { const int t_ = threadIdx.x;
#pragma unroll
      for (int k = 0; k < 42; ++k) if (t_ == k) a.tab[k] = (unsigned long long)ka.in[k]; }
    volatile LAS unsigned* st = (volatile LAS unsigned*)(lds + LDS_BYTES - 16);
    if (threadIdx.x == 0) { st[0] = 0u; st[1] = 0u; st[2] = 0u; st[3] = 0u; }
    __syncthreads();
    const XcdBarrier bar = xcd_barrier_post((unsigned*)(a.ws + WS_CTL) + CW_BAR, st);
    RunAll<0, NPHASE>::run(a, lds, bar);
}

extern "C" void kernel_launch(void* const* d_in, const int* in_sizes, int n_in, void* d_out, int out_size, void* d_ws, size_t ws_size, hipStream_t stream) {
    static int grid = 0;
    if (grid == 0) {
        if (n_in != 42 || out_size != NTOK * DM || ws_size < WS_END) { fprintf(stderr, "kernel_launch: unexpected shapes (n_in %d, out %d, ws %zu < %zu)\n", n_in, out_size, ws_size, (size_t)WS_END); grid = -1; return; }
        int dev = 0, cus = 0, per_cu = 0;
        (void)hipGetDevice(&dev); (void)hipDeviceGetAttribute(&cus, hipDeviceAttributeMultiprocessorCount, dev);
        (void)hipFuncSetAttribute((const void*)k_all, hipFuncAttributeMaxDynamicSharedMemorySize, LDS_BYTES);
        if (hipOccupancyMaxActiveBlocksPerMultiprocessor(&per_cu, (const void*)k_all, 512, LDS_BYTES) != hipSuccess || per_cu < 1) { fprintf(stderr, "kernel_launch: occupancy query reports %d blocks per CU\n", per_cu); per_cu = 1; }
        (void)hipGetLastError();
        grid = cus > 0 ? cus : 256;
    }
    if (grid < 0) return;
    (void)hipMemsetAsync((char*)d_ws + WS_CTL, 0, 1 * MiB, stream);
    KArgs a{};
    for (int i = 0; i < 42; ++i) a.in[i] = d_in[i];
    a.out = (float*)d_out; a.ws = (unsigned char*)d_ws;
    hipLaunchKernelGGL(k_all, dim3(grid), dim3(512), LDS_BYTES, stream, a);
}
```

```cpp
#include <hip/hip_runtime.h>
#include <cstdio>
#include <cstdint>
#include <cmath>

#define LAS __attribute__((address_space(3)))
#define DI __device__ __forceinline__
typedef unsigned short bf16_t;
typedef short bf16x8 __attribute__((ext_vector_type(8)));
typedef short s16x4 __attribute__((ext_vector_type(4)));
typedef float f32x4 __attribute__((ext_vector_type(4)));
typedef float f32x16 __attribute__((ext_vector_type(16)));
typedef unsigned u32x4 __attribute__((ext_vector_type(4)));
typedef unsigned u32x2 __attribute__((ext_vector_type(2)));
typedef float f32x2_t __attribute__((ext_vector_type(2)));
typedef __bf16 bf16x2_t __attribute__((ext_vector_type(2)));

constexpr int NTOK = 32768, DM = 1024, NBATCH = 8, SEQ = 4096;
constexpr int NEXP = 64, TOPK = 6, EHID = 256;
constexpr float ALPHA = 1.4142135623730951f;
constexpr float LN_EPS = 1e-5f, RMS_EPS = 1e-6f;
constexpr float LOG2E = 1.4426950408889634f;
constexpr float C2_MLA = 0.10206207261596577f * LOG2E;
constexpr float C2_FOX = 0.125f * LOG2E;
constexpr int N_IN0 = 1536, N_IN1 = 3328;
constexpr int LISTCAP = 32768;
constexpr int HROWS = 212992;

constexpr size_t MiB = 1u << 20;
constexpr size_t WS_CTL = 0;
constexpr size_t WS_TAB = 1 * MiB;
constexpr size_t WS_COS = 2 * MiB, WS_SIN = 4 * MiB;
constexpr size_t WS_W = 6 * MiB;
constexpr size_t W_GU = WS_W + 0, W_D = WS_W + 64 * MiB, W_SD = WS_W + 96 * MiB  , W_RHI = WS_W + 96 * MiB + 512 * 1024, W_RLO = W_RHI + 128 * 1024,
                 W_SGU = WS_W + 97 * MiB, W_IN = WS_W + 99 * MiB, W_OUT = WS_W + 106 * MiB,
                 W_UQ = WS_W + 108 * MiB, W_UKV = WS_W + 108 * MiB + 512 * 1024;
constexpr size_t WS_XB = 116 * MiB;
constexpr size_t WS_BIG = 180 * MiB;
constexpr size_t B_UPRE = WS_BIG, B_QL = WS_BIG + 32 * MiB, B_KVL = WS_BIG + 48 * MiB, B_Q0 = WS_BIG + 64 * MiB, B_K0 = WS_BIG + 112 * MiB,
                 B_V0 = WS_BIG + 160 * MiB, B_UO = WS_BIG + 192 * MiB;
constexpr size_t B_Q1 = WS_BIG, B_K1 = WS_BIG + 64 * MiB, B_V1 = WS_BIG + 128 * MiB, B_O1 = WS_BIG + 192 * MiB, B_GL = WS_BIG + 256 * MiB, B_CK = WS_BIG + 258 * MiB;
constexpr size_t B_H = WS_BIG, B_SH = WS_BIG + 104 * MiB, B_YT = WS_BIG + 120 * MiB, B_LIST = WS_BIG + 344 * MiB, B_LISTW = WS_BIG + 352 * MiB;
constexpr size_t WS_END = WS_BIG + 360 * MiB;
constexpr float YSCALE = 32.0f;

struct KArgs { const void* in[42]; float* out; unsigned char* ws; };
struct Args {
    LAS unsigned long long* tab; float* out; unsigned char* ws;
    __device__ __forceinline__ const void* in(int k) const { const unsigned long long v = tab[k]; const unsigned lo = __builtin_amdgcn_readfirstlane((unsigned)v), hi = __builtin_amdgcn_readfirstlane((unsigned)(v >> 32)); return (const void*)(const __attribute__((address_space(1))) char*)(((unsigned long long)hi << 32) | lo); }
};

DI unsigned pk2(float lo, float hi) { f32x2_t v = {lo, hi}; bf16x2_t b = __builtin_convertvector(v, bf16x2_t); return __builtin_bit_cast(unsigned, b); }
DI float bf2f(unsigned short b) { return __uint_as_float(((unsigned)b) << 16); }
DI unsigned short f2bf(float f) { return (unsigned short)(pk2(f, 0.f) & 0xffffu); }
DI float sigmoidf_(float x) { return 1.0f / (1.0f + __expf(-x)); }
DI float siluf_(float x) { return x * sigmoidf_(x); }
DI float wave_sum(float v) {
#pragma unroll
    for (int o = 1; o < 64; o <<= 1) v += __shfl_xor(v, o);
    return v;
}
DI int crow(int r, int hi) { return (r & 3) + 8 * (r >> 2) + 4 * hi; }
DI f32x16 mfma32(bf16x8 a, bf16x8 b, f32x16 c) { return __builtin_amdgcn_mfma_f32_32x32x16_bf16(a, b, c, 0, 0, 0); }
DI f32x4 mfma16(bf16x8 a, bf16x8 b, f32x4 c) { return __builtin_amdgcn_mfma_f32_16x16x32_bf16(a, b, c, 0, 0, 0); }
DI u32x2 pk4(f32x4 v) { u32x2 r; r.x = pk2(v[0], v[1]); r.y = pk2(v[2], v[3]); return r; }

DI int map_ident(int n) { return n; }
DI int map_gu(int n) { const int tile = n >> 8, w = n & 255, half = w >> 7, idx = tile * 128 + (w & 127); return idx | (half << 20); }
DI int map_in0(int n) {
    const int tile = n >> 8, w = n & 255;
    if (tile < 4) { const int half = w >> 7, idx = tile * 128 + (w & 127); return half * 512 + idx; }
    if (tile == 4) return 1024 + w;
    if (w < 128) return 1280 + w;
    if (w < 160) { const int i = w - 128; return 1408 + (i & 1) * 16 + (i >> 1); }
    return -1;
}
DI int map_q(int n) { const int h = n / 96, d = n % 96; if (d < 64) return h * 96 + d; const int i = d - 64; return h * 96 + 64 + (i & 1) * 16 + (i >> 1); }
DI int map_kv(int n) {
    if (n < 768) { const int h = n / 96, d = n % 96; if (d < 64) return h * 128 + d; return -2 - (128 + d - 64); }
    const int m = n - 768; return (m >> 6) * 128 + 64 + (m & 63);
}
DI int map_in1(int n) { return n < 3088 ? n : -1; }

template <class MapF>
DI void prep_item(const float* W0, const float* W1, int ldw, int Ksrc, const float* gk, bf16_t* WT, int Kout, int Nout, MapF map, LAS float*, int item, int lane) {
    const int nblk = Nout / 64, kb = item / nblk, nb = item % nblk, k0 = 64 * kb, n = nb * 64 + lane;
    const int sc = map(n);
    const float* W = (sc >= 0 && (sc >> 20)) ? W1 : W0; const int col = sc & 0xFFFFF;
#pragma unroll
    for (int hs = 0; hs < 2; ++hs) {
        float v[32];
#pragma unroll
        for (int i = 0; i < 32; ++i) { const int k = k0 + 32 * hs + i; float x = 0.f;
            if (sc >= 0) { if (k < Ksrc) { x = W[(size_t)k * ldw + col]; if (gk) x *= gk[k]; } }
            else if (sc <= -2) x = (k == -2 - sc) ? 1.f : 0.f;
            v[i] = x; }
#pragma unroll
        for (int j = 0; j < 4; ++j) { u32x4 o; o.x = pk2(v[8 * j], v[8 * j + 1]); o.y = pk2(v[8 * j + 2], v[8 * j + 3]); o.z = pk2(v[8 * j + 4], v[8 * j + 5]); o.w = pk2(v[8 * j + 6], v[8 * j + 7]);
            *(u32x4*)(WT + (size_t)n * Kout + k0 + 32 * hs + 8 * j) = o; }
    }
}

DI void prep_moe(const Args& a, int ib, LAS float* scr, int gw, int ngw, int lane, int gtid, int gthreads) {
    unsigned char* ws = a.ws;
    constexpr int I_GU = (1024 / 64) * (512 / 64), I_D = (256 / 64) * (1024 / 64);
    const int NIT = NEXP * (I_GU + I_D) + I_GU + I_D;
    for (int it = gw; it < NIT; it += ngw) {
        int r = it;
        if (r < NEXP * I_GU) { const int e = r / I_GU; r %= I_GU;
            prep_item((const float*)a.in(ib + 2) + (size_t)e * 1024 * 256, (const float*)a.in(ib + 3) + (size_t)e * 1024 * 256, 256, 1024, nullptr, (bf16_t*)(ws + W_GU) + (size_t)e * 512 * 1024, 1024, 512, map_gu, scr, r, lane); continue; }
        r -= NEXP * I_GU;
        if (r < NEXP * I_D) { const int e = r / I_D; r %= I_D;
            prep_item((const float*)a.in(ib + 4) + (size_t)e * 256 * 1024, nullptr, 1024, 256, nullptr, (bf16_t*)(ws + W_D) + (size_t)e * 1024 * 256, 256, 1024, map_ident, scr, r, lane); continue; }
        r -= NEXP * I_D;
        if (r < I_GU) { prep_item((const float*)a.in(ib + 5), (const float*)a.in(ib + 6), 256, 1024, nullptr, (bf16_t*)(ws + W_SGU), 1024, 512, map_gu, scr, r, lane); continue; }
        r -= I_GU;
        prep_item((const float*)a.in(ib + 7), nullptr, 1024, 256, nullptr, (bf16_t*)(ws + W_SD), 256, 1024, map_ident, scr, r, lane);
    }
    const float* rw = (const float*)a.in(ib);
    bf16_t* rhi = (bf16_t*)(ws + W_RHI); bf16_t* rlo = (bf16_t*)(ws + W_RLO);
    for (int idx = gtid; idx < 64 * 1024; idx += gthreads) { const int n = idx >> 10, k = idx & 1023; const float v = rw[k * 64 + n]; const unsigned short h = f2bf(v); rhi[idx] = h; rlo[idx] = f2bf(v - bf2f(h)); }
}

constexpr int SG_LDS = 49152;
namespace pg8 {
constexpr int BM = 256, BK = 64, HALF = 128, HTB = HALF * BK * 2, STAGE_BYTES = 8 * HTB, NXCD = 8, WGM = 8;
DI int lds_byte(int r, int c) { const int st = (r >> 4) * 2 + (c >> 5), rr = r & 15, cc = c & 31, ob = rr * 64 + cc * 2; return st * 1024 + (ob ^ (((ob >> 9) & 1) << 5)); }
DI void stage_rc(int b, int& R, int& C) { const int st = b / 1024, sb = b % 1024, swz = sb ^ (((sb >> 9) & 1) << 5); R = (st >> 1) * 16 + swz / 64; C = (st & 1) * 32 + (swz % 64) / 2; }
DI int perm32(int rho) { const int n = rho >> 4, i = rho & 15; return 8 * (i >> 2) + 4 * n + (i & 3); }
struct Unit { int pm, pn, e; };

struct DenseOrder {
    int nM, nN, nwg, G, c; const char* Bt; size_t tstepB;
    DI void init(int M, int N, int K, const bf16_t* Bt_, int G_, int c_) { nM = M / BM; nN = N / BM; nwg = nM * nN; G = G_; c = c_; Bt = (const char*)Bt_; tstepB = (size_t)BM * K * 2; }
    DI bool next(int i, Unit& u) const {
        const long L = (long)i * G + c; if (L >= nwg) return false;
        int wgid = (int)L; { const int q = nwg / NXCD, r = nwg % NXCD, xcd = wgid % NXCD, off = wgid / NXCD; wgid = (xcd < r ? xcd * (q + 1) : r * (q + 1) + (xcd - r) * q) + off; }
        const int nig = WGM * nN, gid = wgid / nig, fm = gid * WGM, gsz = (nM - fm) < WGM ? (nM - fm) : WGM;
        u.pm = fm + ((wgid % nig) % gsz); u.pn = (wgid % nig) / gsz; u.e = 0; return true;
    }
    DI const char* bptr(const Unit& u) const { return Bt + (size_t)u.pn * tstepB; }
    static constexpr bool GATHER_A = false;
    DI const int* lptr(const Unit&) const { return nullptr; }
    DI int lcnt(const Unit&) const { return 0; }
    DI unsigned arow0(const Unit& u) const { return (unsigned)(u.pm * BM); }
    DI unsigned arow(const Unit& u, int rt) const { return (unsigned)(u.pm * BM + rt); }
};
DI int find_expert(const LAS int* tstart, int tile) { int e = 0;
#pragma unroll
    for (int s = 32; s > 0; s >>= 1) if (tstart[e + s] <= tile) e += s;
    return e; }
template <bool GATHER> struct GroupedOrder {
    const LAS int* tstart; const LAS int* cntl; int NT, G, c; const char* Bt; size_t estepB, tstepB; const int* LIST; int nshared  ;
    DI bool next(int i, Unit& u) const {
        const int L = i * G + c; if (L >= (tstart[NEXP] + nshared) * NT) return false;
        const int tile = L / NT; u.pn = L - tile * NT;
        if (tile >= tstart[NEXP]) { u.e = NEXP; u.pm = tile - tstart[NEXP]; } else { u.e = find_expert(tstart, tile); u.pm = tile - tstart[u.e]; }
        return true;
    }
    DI const char* bptr(const Unit& u) const { return Bt + (size_t)u.e * estepB + (size_t)u.pn * tstepB; }
    static constexpr bool GATHER_A = GATHER;
    DI const int* lptr(const Unit& u) const { return LIST + (size_t)u.e * LISTCAP + u.pm * BM; }
    DI int lcnt(const Unit& u) const { return cntl[u.e] - u.pm * BM; }
    DI unsigned arow0(const Unit& u) const { return u.e == NEXP ? (unsigned)(HROWS + u.pm * BM) : (unsigned)((tstart[u.e] + u.pm) * BM); }
    DI unsigned arow(const Unit& u, int rt) const {
        if (GATHER) { int i = u.pm * BM + rt; i = i < cntl[u.e] ? i : u.pm * BM; return (unsigned)(LIST[(size_t)u.e * LISTCAP + i] >> 3); }
        return arow0(u) + (unsigned)rt;
    }
};
struct NoMeta {};
template <class F> struct EpiFn {
    F f;
    typedef NoMeta Meta;
    DI Meta prefetch(const Unit&, int, int) const { return Meta{}; }
    DI void operator()(const f32x4 (&acc)[2][2][4][2], const Unit& u, int wr, int wc, int fr, int fq, const Meta&) const {
#pragma unroll
        for (int ai = 0; ai < 2; ++ai)
#pragma unroll
            for (int m = 0; m < 4; ++m) { int r_ = ai * HALF + wr * 64 + m * 16 + fr; asm volatile("" : "+v"(r_));
                f(u, r_, wc * 32 + 8 * fq, acc[ai][0][m][0], acc[ai][0][m][1], acc[ai][1][m][0], acc[ai][1][m][1]); asm volatile("" ::: "memory"); }
    }
};
template <class F> DI EpiFn<F> make_epi(const F& f) { return EpiFn<F>{f}; }

template <class Epi, class Sched>
DI void gemm_phase(LAS unsigned char* lds, const bf16_t* Abase, const int K, const Sched& S, const Epi& E) {
    int tid_ = threadIdx.x; asm volatile("" : "+v"(tid_));
    const int tid = tid_, wid = __builtin_amdgcn_readfirstlane(tid >> 6), lane = tid & 63, wr = wid >> 2, wc = wid & 3, fr = lane & 15, fq = lane >> 4;
    const int nt = K / BK;
    unsigned voffB[2];
#pragma unroll
    for (int i = 0; i < 2; ++i) { int R_, C_; stage_rc(tid * 16 + i * 8192, R_, C_); const int Rb = (R_ & ~31) + perm32(R_ & 31); voffB[i] = (unsigned)(Rb * K + C_) * 2u; }
    const size_t kstep = (size_t)(BK * 2);
    const size_t hstep = (size_t)HALF * K * 2;
    const unsigned ldsw = (unsigned)wid * 1024u;
    const int aoff = lds_byte(wr * 64 + fr, fq * 8), boff = lds_byte(wc * 32 + fr, fq * 8);
#define PG8_SA(b, h) (((b) * 2 + (h)) * HTB)
#define PG8_SB(b, h) ((4 + (b) * 2 + (h)) * HTB)
#define PG8_STAGE(bufoff, gbase, voff) do { _Pragma("unroll") for (int _i = 0; _i < 2; ++_i) \
        __builtin_amdgcn_global_load_lds((const unsigned*)((const char*)(gbase) + (voff)[_i]), (LAS unsigned*)(lds + (bufoff) + ldsw + _i * 8192), 16, 0, 0); } while (0)
#define PG8_LDA(dst, b, h) do { _Pragma("unroll") for (int m = 0; m < 4; ++m) _Pragma("unroll") for (int k = 0; k < 2; ++k) dst[m][k] = *(const LAS bf16x8*)(lds + PG8_SA(b, h) + aoff + m * 2048 + k * 1024); } while (0)
#define PG8_LDB(dst, b, h) do { _Pragma("unroll") for (int n = 0; n < 2; ++n) _Pragma("unroll") for (int k = 0; k < 2; ++k) dst[n][k] = *(const LAS bf16x8*)(lds + PG8_SB(b, h) + boff + n * 2048 + k * 1024); } while (0)
#define PG8_MMA(ai, bj, At, Bt) do { __builtin_amdgcn_s_setprio(1); _Pragma("unroll") for (int m = 0; m < 4; ++m) _Pragma("unroll") for (int n = 0; n < 2; ++n) _Pragma("unroll") for (int k = 0; k < 2; ++k) \
        acc[ai][bj][m][n] = __builtin_amdgcn_mfma_f32_16x16x32_bf16(Bt[n][k], At[m][k], acc[ai][bj][m][n], 0, 0, 0); __builtin_amdgcn_s_setprio(0); } while (0)
#define PG8_WAIT_V(n) asm volatile("s_waitcnt vmcnt(" #n ")" ::: "memory")
#define PG8_WAIT_L(n) asm volatile("s_waitcnt lgkmcnt(" #n ")" ::: "memory")
#define PG8_BAR __builtin_amdgcn_s_barrier()
#define PG8_SCHED __builtin_amdgcn_sched_barrier(0)
#define PG8_AOFFS(dst, u) do { _Pragma("unroll") for (int _i = 0; _i < 2; ++_i) { int R_, C_; stage_rc(tid * 16 + _i * 8192, R_, C_); _Pragma("unroll") for (int _h = 0; _h < 2; ++_h) dst[_h][_i] = (S.arow(u, _h * HALF + R_) * (unsigned)K + (unsigned)C_) * 2u; } } while (0)
    Unit cur, nxt; int ui = 0;
    if (!S.next(0, cur)) return;
    f32x4 acc[2][2][4][2];
#pragma unroll
    for (int a = 0; a < 2; ++a)
#pragma unroll
        for (int b = 0; b < 2; ++b)
#pragma unroll
            for (int m = 0; m < 4; ++m)
#pragma unroll
                for (int n = 0; n < 2; ++n) acc[a][b][m][n] = (f32x4){0.f, 0.f, 0.f, 0.f};
    bf16x8 At[4][2], B0[2][2], B1[2][2];
    constexpr bool GA = Sched::GATHER_A;
    unsigned vcur[2][2], vnxt[2][2];
    const char* const Ab = (const char*)Abase;
    const char* cA = Ab;
    if constexpr (GA) { PG8_AOFFS(vcur, cur); }
    else {
#pragma unroll
        for (int i = 0; i < 2; ++i) { int R_, C_; stage_rc(tid * 16 + i * 8192, R_, C_); vcur[0][i] = (unsigned)(R_ * K + C_) * 2u; vcur[1][i] = vcur[0][i]; }
        cA = Ab + (size_t)S.arow0(cur) * K * 2;
    }
    const size_t ah = GA ? (size_t)0 : hstep;
    const char* cB = S.bptr(cur);
    typename Epi::Meta meta = E.prefetch(cur, wr, fr);
    PG8_STAGE(PG8_SB(0, 0), cB, voffB); PG8_STAGE(PG8_SB(0, 1), cB + hstep, voffB); PG8_STAGE(PG8_SA(0, 0), cA, vcur[0]); PG8_STAGE(PG8_SA(0, 1), cA + ah, vcur[1]);
    if (wr == 1) PG8_BAR;
    PG8_WAIT_V(2); PG8_BAR;
    PG8_STAGE(PG8_SB(1, 0), cB + kstep, voffB); PG8_STAGE(PG8_SA(1, 0), cA + kstep, vcur[0]); PG8_STAGE(PG8_SB(1, 1), cB + hstep + kstep, voffB);
    PG8_WAIT_V(6); PG8_BAR;
    for (;;) {
        const bool has_next = S.next(ui + 1, nxt);
        const char* nB = cB; const char* nA = cA;
        if (has_next) { nB = S.bptr(nxt);
            if constexpr (GA) {
                const int* lp_ = S.lptr(nxt); const int cn_ = S.lcnt(nxt);
#pragma unroll
                for (int i = 0; i < 2; ++i) { int R_, C_; stage_rc(tid * 16 + i * 8192, R_, C_);
#pragma unroll
                    for (int h = 0; h < 2; ++h) { int rt_ = h * HALF + R_; rt_ = rt_ < cn_ ? rt_ : 0; const int* p_ = lp_ + rt_; asm volatile("global_load_dword %0, %1, off" : "=v"(vnxt[h][i]) : "v"(p_) : "memory"); } }
            } else nA = Ab + (size_t)S.arow0(nxt) * K * 2; }
        else if constexpr (GA) {
#pragma unroll
            for (int h = 0; h < 2; ++h)
#pragma unroll
                for (int i = 0; i < 2; ++i) vnxt[h][i] = vcur[h][i];
        }
#pragma unroll 1
        for (int t = 0; t < nt; t += 2) {
            const bool last = (t == nt - 2);
            const char* a1 = cA + (size_t)(t + 1) * kstep;
            const char* a2 = last ? nA : cA + (size_t)(t + 2) * kstep; const char* b2 = last ? nB : cB + (size_t)(t + 2) * kstep;
            const char* a3 = a2 + kstep; const char* b3 = b2 + kstep;
            if constexpr (GA) { if (last && has_next) {
                asm volatile("" : "+v"(vnxt[0][0]), "+v"(vnxt[0][1]), "+v"(vnxt[1][0]), "+v"(vnxt[1][1]));
#pragma unroll
                for (int i = 0; i < 2; ++i) { int R_, C_; stage_rc(tid * 16 + i * 8192, R_, C_);
#pragma unroll
                    for (int h = 0; h < 2; ++h) vnxt[h][i] = ((vnxt[h][i] >> 3) * (unsigned)K + (unsigned)C_) * 2u; } } }
            unsigned v2[2][2];
#pragma unroll
            for (int h = 0; h < 2; ++h)
#pragma unroll
                for (int i = 0; i < 2; ++i) v2[h][i] = (GA && last) ? vnxt[h][i] : vcur[h][i];
            PG8_LDB(B0, 0, 0); PG8_LDB(B1, 0, 1); PG8_SCHED; PG8_LDA(At, 0, 0); PG8_STAGE(PG8_SA(1, 1), a1 + ah, vcur[1]);
            PG8_WAIT_V(8); PG8_WAIT_L(0); PG8_BAR; PG8_MMA(0, 0, At, B0); PG8_MMA(0, 1, At, B1); PG8_BAR; PG8_SCHED;
            PG8_LDA(At, 0, 1); PG8_STAGE(PG8_SB(0, 0), b2, voffB); PG8_STAGE(PG8_SB(0, 1), b2 + hstep, voffB); PG8_STAGE(PG8_SA(0, 0), a2, v2[0]);
            PG8_WAIT_V(8); PG8_WAIT_L(0); PG8_BAR; PG8_MMA(1, 0, At, B0); PG8_MMA(1, 1, At, B1); PG8_BAR; PG8_SCHED;
            PG8_LDB(B0, 1, 0); PG8_LDB(B1, 1, 1); PG8_SCHED; PG8_LDA(At, 1, 0); PG8_STAGE(PG8_SA(0, 1), a2 + ah, v2[1]);
            PG8_WAIT_V(8); PG8_WAIT_L(0); PG8_BAR; PG8_MMA(0, 0, At, B0); PG8_MMA(0, 1, At, B1); PG8_BAR; PG8_SCHED;
            PG8_LDA(At, 1, 1); PG8_STAGE(PG8_SB(1, 0), b3, voffB); PG8_STAGE(PG8_SB(1, 1), b3 + hstep, voffB); PG8_STAGE(PG8_SA(1, 0), a3, v2[0]);
            PG8_WAIT_V(8); PG8_WAIT_L(0); PG8_BAR; PG8_MMA(1, 0, At, B0); PG8_MMA(1, 1, At, B1); PG8_BAR; PG8_SCHED;
        }
        if (wr == 0) PG8_BAR;
        { int fr_ = fr, fq_ = fq; asm volatile("" : "+v"(fr_), "+v"(fq_));
          E(acc, cur, wr, wc, fr_, fq_, meta); }
        if (!has_next) break;
#pragma unroll
        for (int a = 0; a < 2; ++a)
#pragma unroll
            for (int b = 0; b < 2; ++b)
#pragma unroll
                for (int m = 0; m < 4; ++m)
#pragma unroll
                    for (int n = 0; n < 2; ++n) acc[a][b][m][n] = (f32x4){0.f, 0.f, 0.f, 0.f};
        cur = nxt; cB = nB; cA = nA; ++ui;
        meta = E.prefetch(cur, wr, fr);
        if constexpr (GA) {
#pragma unroll
            for (int h = 0; h < 2; ++h)
#pragma unroll
                for (int i = 0; i < 2; ++i) vcur[h][i] = vnxt[h][i];
        }
        if (wr == 1) PG8_BAR;
    }
    PG8_WAIT_V(0);
    PG8_BAR;
#undef PG8_SA
#undef PG8_SB
#undef PG8_STAGE
#undef PG8_LDA
#undef PG8_LDB
#undef PG8_MMA
#undef PG8_WAIT_V
#undef PG8_WAIT_L
#undef PG8_BAR
#undef PG8_SCHED
#undef PG8_AOFFS
}
}
DI u32x4 pk8(f32x4 a, f32x4 b) { u32x4 o; o.x = pk2(a[0], a[1]); o.y = pk2(a[2], a[3]); o.z = pk2(b[0], b[1]); o.w = pk2(b[2], b[3]); return o; }
struct EpiDown {
    const LAS int* cntl; const int* LIST; const float* LISTW; unsigned char* YT;
    struct Meta { int dst[2][4]; float w[2][4]; };
    DI Meta prefetch(const pg8::Unit& u, int wr, int fr) const {
        Meta m;
#pragma unroll
        for (int ai = 0; ai < 2; ++ai)
#pragma unroll
            for (int mm = 0; mm < 4; ++mm) { const int i = u.pm * 256 + ai * 128 + wr * 64 + mm * 16 + fr;
                if (u.e == NEXP) { m.dst[ai][mm] = i * 7 + 6; m.w[ai][mm] = YSCALE; }
                else { const bool ok = i < cntl[u.e]; const size_t idx = (size_t)u.e * LISTCAP + (ok ? i : u.pm * 256); const int v = LIST[idx]; m.w[ai][mm] = LISTW[idx] * YSCALE; m.dst[ai][mm] = ok ? (v >> 3) * 7 + (v & 7) : -1; } }
        return m;
    }
    DI void operator()(const f32x4 (&acc)[2][2][4][2], const pg8::Unit& u, int wr, int wc, int fr, int fq, const Meta& m) const {
#pragma unroll
        for (int ai = 0; ai < 2; ++ai)
#pragma unroll
            for (int mm = 0; mm < 4; ++mm) { const int d = m.dst[ai][mm]; const float w = m.w[ai][mm];
                if (d >= 0) { unsigned char* p = YT + (size_t)d * 1024 + u.pn * 256 + wc * 32 + 8 * fq;
#pragma unroll
                    for (int bj = 0; bj < 2; ++bj) { const f32x4 a0 = acc[ai][bj][mm][0] * w, a1 = acc[ai][bj][mm][1] * w; u32x2 o;
                        int t = __builtin_amdgcn_cvt_pk_fp8_f32(a0[0], a0[1], 0, false); t = __builtin_amdgcn_cvt_pk_fp8_f32(a0[2], a0[3], t, true); o.x = (unsigned)t;
                        t = __builtin_amdgcn_cvt_pk_fp8_f32(a1[0], a1[1], 0, false); t = __builtin_amdgcn_cvt_pk_fp8_f32(a1[2], a1[3], t, true); o.y = (unsigned)t;
                        *(u32x2*)(p + 128 * bj) = o; } } }
    }
};
DI float dot4(f32x4 a) { return (a[0] * a[0] + a[1] * a[1]) + (a[2] * a[2] + a[3] * a[3]); }
DI void rope8(f32x4& v0, f32x4& v1, const float* ct, const float* st, size_t row, int p) {
    const f32x4 cs = *(const f32x4*)(ct + row * 16 + p), sn = *(const f32x4*)(st + row * 16 + p);
    float a, b;
    a = v0[0]; b = v0[1]; v0[0] = a * cs[0] - b * sn[0]; v0[1] = b * cs[0] + a * sn[0];
    a = v0[2]; b = v0[3]; v0[2] = a * cs[1] - b * sn[1]; v0[3] = b * cs[1] + a * sn[1];
    a = v1[0]; b = v1[1]; v1[0] = a * cs[2] - b * sn[2]; v1[1] = b * cs[2] + a * sn[2];
    a = v1[2]; b = v1[3]; v1[2] = a * cs[3] - b * sn[3]; v1[3] = b * cs[3] + a * sn[3];
}

template <int DK, int QP, int KP, int VP, int OP, bool BIAS>
DI void attn_simple_unit(LAS unsigned char* lds, const bf16_t* Q, const bf16_t* K, const bf16_t* V, bf16_t* O, const float* CK, int b, int hq, int hv, int hc, int ho, int qb) {
    constexpr int KS = DK + 8, VS = 72;
    LAS bf16_t* Ks = (LAS bf16_t*)lds;
    LAS bf16_t* VT = (LAS bf16_t*)(lds + 64 * KS * 2);
    LAS float* ckl = (LAS float*)(lds + 64 * KS * 2 + 64 * VS * 2);
    int tid_ = threadIdx.x; asm volatile("" : "+v"(tid_));
    const int tid = tid_, lane = tid & 63, wid = tid >> 6, r32 = lane & 31, hi = lane >> 5;
    const size_t rowbase = (size_t)b * SEQ; const int q0 = qb * 256, qw = q0 + 32 * wid;
    bf16x8 qr[DK / 16];
#pragma unroll
    for (int d0 = 0; d0 < DK / 16; ++d0) qr[d0] = *(const bf16x8*)(Q + (rowbase + qw + r32) * QP + hq + 16 * d0 + 8 * hi);
    f32x16 o0, o1;
#pragma unroll
    for (int i = 0; i < 16; ++i) { o0[i] = 0.f; o1[i] = 0.f; }
    float m = -INFINITY, l = 0.f;
    const int ntile = (q0 + 256) / 64;
    for (int jt = 0; jt < ntile; ++jt) {
        const int kv0 = jt * 64;
        __syncthreads();
        for (int c = tid; c < 64 * (DK / 8); c += 512) { const int r = c / (DK / 8), ch = c % (DK / 8);
            const u32x4 v = *(const u32x4*)(K + (rowbase + kv0 + r) * KP + hq + ch * 8); *(LAS u32x4*)(Ks + r * KS + ch * 8) = v; }
        { const int r = tid >> 3, ch = tid & 7; const u32x4 v = *(const u32x4*)(V + (rowbase + kv0 + r) * VP + hv + ch * 8);
#pragma unroll
          for (int i = 0; i < 4; ++i) { VT[(ch * 8 + 2 * i) * VS + r] = (bf16_t)(v[i] & 0xffffu); VT[(ch * 8 + 2 * i + 1) * VS + r] = (bf16_t)(v[i] >> 16); } }
        if (BIAS) { if (tid < 64) ckl[tid] = CK[(rowbase + kv0 + tid) * 16 + hc]; }
        __syncthreads();
        if (kv0 <= qw + 31) {
            f32x16 p0, p1;
#pragma unroll
            for (int i = 0; i < 16; ++i) { p0[i] = 0.f; p1[i] = 0.f; }
#pragma unroll
            for (int d0 = 0; d0 < DK / 16; ++d0) {
                const bf16x8 a0 = *(LAS bf16x8*)(Ks + r32 * KS + 16 * d0 + 8 * hi), a1 = *(LAS bf16x8*)(Ks + (32 + r32) * KS + 16 * d0 + 8 * hi);
                p0 = mfma32(a0, qr[d0], p0); p1 = mfma32(a1, qr[d0], p1);
            }
            if (BIAS) {
#pragma unroll
                for (int i = 0; i < 16; ++i) { p0[i] -= ckl[crow(i, hi)]; p1[i] -= ckl[32 + crow(i, hi)]; }
            }
            if (kv0 + 63 > qw) { const int q = qw + r32;
#pragma unroll
                for (int i = 0; i < 16; ++i) { const int kv = kv0 + crow(i, hi); if (kv > q) p0[i] = -INFINITY; if (kv + 32 > q) p1[i] = -INFINITY; } }
            float rm = p0[0];
#pragma unroll
            for (int i = 0; i < 16; ++i) { rm = fmaxf(rm, p0[i]); rm = fmaxf(rm, p1[i]); }
            rm = fmaxf(rm, __shfl_xor(rm, 32));
            const float mn = fmaxf(m, rm); const float f = __builtin_amdgcn_exp2f(m - mn);
            float rs = 0.f;
#pragma unroll
            for (int i = 0; i < 16; ++i) { p0[i] = __builtin_amdgcn_exp2f(p0[i] - mn); p1[i] = __builtin_amdgcn_exp2f(p1[i] - mn); rs += p0[i] + p1[i]; }
            rs += __shfl_xor(rs, 32);
            l = l * f + rs; m = mn;
#pragma unroll
            for (int i = 0; i < 16; ++i) { const float fi = __shfl(f, crow(i, hi)); o0[i] *= fi; o1[i] *= fi; }
            bf16x8 pf[4];
            { u32x4 t;
              t.x = pk2(p0[0], p0[1]); t.y = pk2(p0[2], p0[3]); t.z = pk2(p0[4], p0[5]); t.w = pk2(p0[6], p0[7]); pf[0] = __builtin_bit_cast(bf16x8, t);
              t.x = pk2(p0[8], p0[9]); t.y = pk2(p0[10], p0[11]); t.z = pk2(p0[12], p0[13]); t.w = pk2(p0[14], p0[15]); pf[1] = __builtin_bit_cast(bf16x8, t);
              t.x = pk2(p1[0], p1[1]); t.y = pk2(p1[2], p1[3]); t.z = pk2(p1[4], p1[5]); t.w = pk2(p1[6], p1[7]); pf[2] = __builtin_bit_cast(bf16x8, t);
              t.x = pk2(p1[8], p1[9]); t.y = pk2(p1[10], p1[11]); t.z = pk2(p1[12], p1[13]); t.w = pk2(p1[14], p1[15]); pf[3] = __builtin_bit_cast(bf16x8, t); }
#pragma unroll
            for (int ks = 0; ks < 4; ++ks) {
                { const s16x4 lo = *(LAS s16x4*)(VT + r32 * VS + 16 * ks + 4 * hi), hh = *(LAS s16x4*)(VT + r32 * VS + 16 * ks + 8 + 4 * hi);
                  const bf16x8 vf = __builtin_shufflevector(lo, hh, 0, 1, 2, 3, 4, 5, 6, 7); o0 = mfma32(pf[ks], vf, o0); }
                { const s16x4 lo = *(LAS s16x4*)(VT + (32 + r32) * VS + 16 * ks + 4 * hi), hh = *(LAS s16x4*)(VT + (32 + r32) * VS + 16 * ks + 8 + 4 * hi);
                  const bf16x8 vf = __builtin_shufflevector(lo, hh, 0, 1, 2, 3, 4, 5, 6, 7); o1 = mfma32(pf[ks], vf, o1); }
            }
        }
    }
    const float inv = 1.0f / l;
#pragma unroll
    for (int i = 0; i < 16; ++i) { const float ii = __shfl(inv, crow(i, hi)); const size_t row = rowbase + qw + crow(i, hi);
        O[row * OP + ho + r32] = f2bf(o0[i] * ii); O[row * OP + ho + 32 + r32] = f2bf(o1[i] * ii); }
}

namespace attn_fox {
using bf16=unsigned short;
constexpr int BATCH=8,NHEAD=16,SEQ=4096,D=64,DM=NHEAD*D;
constexpr int NW=8,QBLK=32,QB=QBLK*NW,KVBLK=64,NQB=SEQ/QB;
constexpr int ATTN_PITCH=DM, ATTN_UNIT_ROWS=QB;
__device__ __forceinline__ int crow(int r,int hi){return (r&3)+8*(r>>2)+4*hi;}
#define SBAR() __builtin_amdgcn_sched_barrier(0)
__device__ __forceinline__ void cmask(f32x16&p0,f32x16&p1,int jb,int qrel,int hi){
  const float NEG=-INFINITY; int kb=64*jb+4*hi;
  #pragma unroll
  for(int r=0;r<16;++r){int kv=kb+(r&3)+8*(r>>2); if(kv>qrel)p0[r]=NEG; if(kv+32>qrel)p1[r]=NEG;}
}

constexpr int NSLOT=3, SLOTB=8192;
constexpr int LDS_K=0, LDS_V=NSLOT*SLOTB, LDS_WS=2*NSLOT*SLOTB, LDS_OST=LDS_WS+NW*64*4, LDS_CK=LDS_OST+NW*4096, LDS_BYTES=LDS_CK+SEQ*4;
constexpr float C2=0.125f*1.4426950408889634f;
__device__ __forceinline__ void glds16(const void*gsrc,unsigned lds_dst){unsigned keep;
  asm volatile("s_mov_b32 %0, m0\n\ts_mov_b32 m0, %2\n\ts_nop 0\n\tglobal_load_lds_dwordx4 %1, off\n\ts_mov_b32 m0, %0":"=&s"(keep):"v"(gsrc),"s"(lds_dst):"memory");}
__device__ __forceinline__ float max3f(float a,float b,float c){float r;asm("v_max3_f32 %0, %1, %2, %3":"=v"(r):"v"(a),"v"(b),"v"(c));return r;}
__device__ __forceinline__ float max2f(float a,float b){float r;asm("v_max_f32_e32 %0, %1, %2":"=v"(r):"v"(a),"v"(b));return r;}
__device__ __forceinline__ float fadd_s(float a,float b){float r;asm("v_add_f32_e32 %0, %1, %2":"=v"(r):"v"(a),"v"(b));return r;}
__device__ __forceinline__ float fsub_s(float a,float b){float r;asm("v_sub_f32_e32 %0, %1, %2":"=v"(r):"v"(a),"v"(b));return r;}
typedef float f32x2_t __attribute__((ext_vector_type(2))); typedef __bf16 bf16x2_t __attribute__((ext_vector_type(2)));
__device__ __forceinline__ unsigned cvtpk_s(float lo,float hi){f32x2_t v={lo,hi};bf16x2_t b=__builtin_convertvector(v,bf16x2_t);return __builtin_bit_cast(unsigned,b);}
#define WAIT_BAR(N) asm volatile("s_waitcnt vmcnt(" #N ") lgkmcnt(0)\n\ts_barrier":::"memory")

__device__ __forceinline__ void qkt(f32x16&p0,f32x16&p1,const char*Kslot,const bf16x8*qr,int r32,int hi){
  const char*kb=Kslot+hi*1024+r32*16;
  #pragma unroll
  for(int d0=0;d0<4;++d0){
    const bf16x8 b0=*reinterpret_cast<const bf16x8*>(kb+d0*2048);
    const bf16x8 b1=*reinterpret_cast<const bf16x8*>(kb+d0*2048+512);
    p0=__builtin_amdgcn_mfma_f32_32x32x16_bf16(b0,qr[d0],p0,0,0,0);p1=__builtin_amdgcn_mfma_f32_32x32x16_bf16(b1,qr[d0],p1,0,0,0);}
}
typedef __attribute__((address_space(3))) const char* lds_cptr;
typedef __attribute__((address_space(3))) const float* lds_fptr;
typedef short v4i16_t __attribute__((ext_vector_type(4)));
__device__ __forceinline__ void kload8(bf16x8*kf,lds_cptr kp){
  kf[0]=*(const __attribute__((address_space(3))) bf16x8*)(kp);      kf[1]=*(const __attribute__((address_space(3))) bf16x8*)(kp+512);
  kf[2]=*(const __attribute__((address_space(3))) bf16x8*)(kp+2048); kf[3]=*(const __attribute__((address_space(3))) bf16x8*)(kp+2560);
  kf[4]=*(const __attribute__((address_space(3))) bf16x8*)(kp+4096); kf[5]=*(const __attribute__((address_space(3))) bf16x8*)(kp+4608);
  kf[6]=*(const __attribute__((address_space(3))) bf16x8*)(kp+6144); kf[7]=*(const __attribute__((address_space(3))) bf16x8*)(kp+6656);
}
__device__ __forceinline__ void kload2(bf16x8*kf,lds_cptr kp,int j){ kf[2*j]=*(const __attribute__((address_space(3))) bf16x8*)(kp+j*2048); kf[2*j+1]=*(const __attribute__((address_space(3))) bf16x8*)(kp+j*2048+512); }
__device__ __forceinline__ s16x4 vtr(lds_cptr p){ return __builtin_bit_cast(s16x4,__builtin_amdgcn_ds_read_tr16_b64_v4i16((__attribute__((address_space(3))) v4i16_t*)p)); }
__device__ __forceinline__ float rowmax(const f32x16&p0,const f32x16&p1){
  float a=max3f(p0[0],p0[1],p1[0]),b=max3f(p0[2],p0[3],p1[1]);a=max3f(a,p1[2],p1[3]);
  #pragma unroll
  for(int r=4;r<16;r+=4){a=max3f(a,p0[r],p0[r+1]);b=max3f(b,p0[r+2],p0[r+3]);a=max3f(a,p1[r],p1[r+1]);b=max3f(b,p1[r+2],p1[r+3]);}
  const float m=max2f(a,b);
  auto rr=__builtin_amdgcn_permlane32_swap(__float_as_uint(m),__float_as_uint(m),false,false);
  return max2f(__uint_as_float(rr[0]),__uint_as_float(rr[1]));
}
__device__ __forceinline__ void pv(f32x16*o,int vb,bf16x8 pa0,bf16x8 pa1,bf16x8 pa2,bf16x8 pa3){
  #pragma unroll
  for(int d0=0;d0<2;++d0){s16x4 lo[4],hi[4];
    #pragma unroll
    for(int ks=0;ks<4;++ks){
      asm volatile("ds_read_b64_tr_b16 %0,%1 offset:%c2":"=&v"(lo[ks]):"v"(vb),"i"(d0*4096+ks*1024):"memory");
      asm volatile("ds_read_b64_tr_b16 %0,%1 offset:%c2":"=&v"(hi[ks]):"v"(vb),"i"(d0*4096+ks*1024+512):"memory");}
    asm volatile("s_waitcnt lgkmcnt(0)":::"memory");SBAR();
    #define PK(k) (bf16x8){lo[k][0],lo[k][1],lo[k][2],lo[k][3],hi[k][0],hi[k][1],hi[k][2],hi[k][3]}
    o[d0]=__builtin_amdgcn_mfma_f32_32x32x16_bf16(pa0,PK(0),o[d0],0,0,0);
    o[d0]=__builtin_amdgcn_mfma_f32_32x32x16_bf16(pa1,PK(1),o[d0],0,0,0);
    o[d0]=__builtin_amdgcn_mfma_f32_32x32x16_bf16(pa2,PK(2),o[d0],0,0,0);
    o[d0]=__builtin_amdgcn_mfma_f32_32x32x16_bf16(pa3,PK(3),o[d0],0,0,0);
    #undef PK
  }
}

#ifndef ATTN_STORE16
#define ATTN_STORE16(p,v) (*(u32x4*)(p)=(v))
#endif
template<int THRL> __device__ __forceinline__ void attn_unit(int b,int h,int qb,const bf16*Q,const bf16*__restrict__ K,const bf16*__restrict__ V,bf16*O,const float*__restrict__ CKH,char*shm){
  const int tid=threadIdx.x,lane=tid&63,r32=lane&31,hi=lane>>5; const int wid=__builtin_amdgcn_readfirstlane(tid>>6);
  const long rowbase=(long)b*SEQ; const int q0=qb*QB;
  const bf16*Qw=Q+(rowbase+q0+wid*QBLK)*DM+h*D;
  const bf16*Kh=K+rowbase*DM+h*D,*Vh=V+rowbase*DM+h*D;
  const unsigned lds0=(unsigned)(uintptr_t)shm;
  float*wsf=(float*)(shm+LDS_WS)+wid*64;
  const bf16*ksrc=Kh+(long)lane*DM+wid*8;
  const bf16*vsrc=Vh+(long)(16*(wid&3)+(lane>>2))*DM+(wid>>2)*32+(lane&3)*8;
  const unsigned kdst=lds0+LDS_K+wid*1024, vdst=lds0+LDS_V+wid*1024;
  #define DMA_K(t,slot) glds16(ksrc+(long)(t)*KVBLK*DM,(unsigned)__builtin_amdgcn_readfirstlane(kdst+(slot)))
  #define DMA_V(t,slot) glds16(vsrc+(long)(t)*KVBLK*DM,(unsigned)__builtin_amdgcn_readfirstlane(vdst+(slot)))
  const int vb0=(int)(lds0+LDS_V)+((lane>>4)&1)*32+(lane&3)*8+(4*hi+((lane&15)>>2))*64;
  const char*Kbase=shm+LDS_K; bf16x8 kf[8];
  const lds_cptr shm3=(lds_cptr)shm; const lds_cptr kp0=shm3+LDS_K+hi*1024+r32*16; const lds_cptr vp0=shm3+LDS_V+((lane>>4)&1)*32+(lane&3)*8+(4*hi+((lane&15)>>2))*64;
  const int NT=(q0+QB)/KVBLK;
  const float*ckg=CKH+((long)b*NHEAD+h)*SEQ; float*ckl=(float*)(shm+LDS_CK); const lds_fptr ckl3=(lds_fptr)(shm3+LDS_CK);
  f32x4 ckv0=f32x4{0.f,0.f,0.f,0.f},ckv1=f32x4{0.f,0.f,0.f,0.f}; if(tid*4<q0+QB)ckv0=*reinterpret_cast<const f32x4*>(ckg+tid*4); if(2048+tid*4<q0+QB)ckv1=*reinterpret_cast<const f32x4*>(ckg+2048+tid*4);
  const float cq=ckg[q0+wid*QBLK+r32];
  DMA_K(0,0);DMA_V(0,0);DMA_K(1,SLOTB);
  bf16x8 qr[4];
  #pragma unroll
  for(int d0=0;d0<4;++d0)qr[d0]=*reinterpret_cast<const bf16x8*>(&Qw[(long)r32*DM+d0*16+hi*8]);
  float mhat=-cq,l_reg=0.f;f32x16 o[2];o[0]=f32x16{};o[1]=f32x16{};
  const int qrel=wid*QBLK+r32;
  #define CMASK(P0,P1,t) do{int jb_=(t)-(NT-4); if(jb_>=0)cmask(P0,P1,jb_,qrel,hi);}while(0)
  bool resc=false;
  #define START(P0,P1) do{ const float rm=rowmax(P0,P1); resc=false; \
    { const float dl=__builtin_fmaxf(rm,0.f); mhat=fadd_s(mhat,dl); \
      _Pragma("unroll") for(int r=0;r<16;++r){P0[r]=fsub_s(P0[r],dl);P1[r]=fsub_s(P1[r],dl);} } \
    _Pragma("unroll") for(int r=0;r<16;++r)P0[r]=__builtin_amdgcn_exp2f(P0[r]); }while(0)
  #define RESC() do{ if(resc){ asm volatile("s_waitcnt lgkmcnt(0)":::"memory"); \
      _Pragma("unroll") for(int d_=0;d_<2;++d_) _Pragma("unroll") for(int r=0;r<16;++r)o[d_][r]*=wsf[crow(r,hi)]; } }while(0)
  #define BGRP(X,g,base) do{ const f32x4 cv_=*(const __attribute__((address_space(3))) f32x4*)(ckl3+(base)+8*(g)+4*hi); const float nm_=-mhat; \
      X[4*(g)]=nm_-cv_[0]; X[4*(g)+1]=nm_-cv_[1]; X[4*(g)+2]=nm_-cv_[2]; X[4*(g)+3]=nm_-cv_[3]; }while(0)
  #define BINIT(X0,X1,tt) do{ _Pragma("unroll") for(int g_=0;g_<4;++g_){ BGRP(X0,g_,64*(tt)); BGRP(X1,g_,64*(tt)+32); } }while(0)
  f32x16 pA0,pA1,pB0,pB1;
  int sl_prev=0,sl_cur=0,sl_next=SLOTB;
  #define ROT() do{sl_prev=sl_cur;sl_cur=sl_next;sl_next=(sl_next==(NSLOT-1)*SLOTB)?0:sl_next+SLOTB;}while(0)
  DMA_K(2,2*SLOTB);
  *reinterpret_cast<f32x4*>(ckl+tid*4)=ckv0; *reinterpret_cast<f32x4*>(ckl+2048+tid*4)=ckv1;
  WAIT_BAR(3);
  BINIT(pA0,pA1,0);
  qkt(pA0,pA1,Kbase,qr,r32,hi);asm volatile("s_nop 15\n\ts_nop 7":"+v"(pA0),"+v"(pA1));CMASK(pA0,pA1,0);
  START(pA0,pA1);
  _Pragma("unroll") for(int r=0;r<16;++r)pA1[r]=__builtin_amdgcn_exp2f(pA1[r]);
  BINIT(pB0,pB1,1);
  WAIT_BAR(0);
  DMA_K(3,0);DMA_V(1,SLOTB);
  ROT();
  kload8(kf,kp0+sl_cur);
  WAIT_BAR(2);
  s16x4 vlo[8],vhi[8]; u32x4 pw0,pw1,pw2,pw3;
  #define PKW(P,B) cvtpk_s(P[B],P[B+1])
  #define PAF(k) __builtin_bit_cast(bf16x8,pw##k)
  #define VFR(i) (bf16x8){vlo[i][0],vlo[i][1],vlo[i][2],vlo[i][3],vhi[i][0],vhi[i][1],vhi[i][2],vhi[i][3]}
  #define PIN(x) asm volatile("":"+v"(x))
  #define MX3(a,b,c) __builtin_fmaxf(__builtin_fmaxf((a),(b)),(c))
  #define GAPA(MF,A0,A1,A2,A3,W0,W1,PW) do{ MF; sacc+=A0; sacc+=A1; sacc+=A2; sacc+=A3; PIN(sacc); W0; W1; PIN(PW); SBAR(); }while(0)
  #define EX(v) __builtin_amdgcn_exp2f(v)
  #define GAPB(MF,X,B) do{ MF; X[B]=EX(X[B]); X[B+1]=EX(X[B+1]); X[B+2]=EX(X[B+2]); X[B+3]=EX(X[B+3]); PIN(X); SBAR(); }while(0)
  #define VRD(i) do{ vlo[i]=vtr(vp_+(((i)>>2)*4096+((i)&3)*1024)); vhi[i]=vtr(vp_+(((i)>>2)*4096+((i)&3)*1024+512)); }while(0)
  #define KRD(G,j) do{ if(G){ kload2(kf,kp0+sl_next,j); SBAR(); } }while(0)
  #define NXB(G,X,g,tt,off) do{ if(G){ BGRP(X,g,64*(tt)+(off)); PIN(X); SBAR(); } }while(0)
  #define STEP(C0,C1,P0,P1,t,GK,GV,GL) do{ SBAR(); \
    const lds_cptr vp_=vp0+sl_prev; \
    VRD(0); SBAR(); float sacc=(P0[0]+P0[1]); \
    GAPA(C0=__builtin_amdgcn_mfma_f32_32x32x16_bf16(kf[0],qr[0],C0,0,0,0), P0[2],P0[3],P0[4],P0[5],     pw0[0]=PKW(P0,0), pw0[1]=PKW(P0,2), pw0); \
    VRD(4); SBAR(); GAPA(C1=__builtin_amdgcn_mfma_f32_32x32x16_bf16(kf[1],qr[0],C1,0,0,0), P0[6],P0[7],P0[8],P0[9],     pw0[2]=PKW(P0,4), pw0[3]=PKW(P0,6), pw0); \
    VRD(1); SBAR(); GAPA(C0=__builtin_amdgcn_mfma_f32_32x32x16_bf16(kf[2],qr[1],C0,0,0,0),   P0[10],P0[11],P0[12],P0[13], pw1[0]=PKW(P0,8), pw1[1]=PKW(P0,10), pw1); \
    VRD(5); SBAR(); GAPA(C1=__builtin_amdgcn_mfma_f32_32x32x16_bf16(kf[3],qr[1],C1,0,0,0),   P0[14],P0[15],P1[0],P1[1],   pw1[2]=PKW(P0,12),pw1[3]=PKW(P0,14), pw1); \
    VRD(2); SBAR(); GAPA(C0=__builtin_amdgcn_mfma_f32_32x32x16_bf16(kf[4],qr[2],C0,0,0,0),   P1[2],P1[3],P1[4],P1[5],     pw2[0]=PKW(P1,0), pw2[1]=PKW(P1,2), pw2); \
    VRD(6); SBAR(); GAPA(C1=__builtin_amdgcn_mfma_f32_32x32x16_bf16(kf[5],qr[2],C1,0,0,0),   P1[6],P1[7],P1[8],P1[9],     pw2[2]=PKW(P1,4), pw2[3]=PKW(P1,6), pw2); \
    VRD(3); SBAR(); GAPA(C0=__builtin_amdgcn_mfma_f32_32x32x16_bf16(kf[6],qr[3],C0,0,0,0),   P1[10],P1[11],P1[12],P1[13], pw3[0]=PKW(P1,8), pw3[1]=PKW(P1,10), pw3); \
    VRD(7); SBAR(); GAPA(C1=__builtin_amdgcn_mfma_f32_32x32x16_bf16(kf[7],qr[3],C1,0,0,0),   P1[14],P1[15],0.f,0.f,       pw3[2]=PKW(P1,12),pw3[3]=PKW(P1,14), pw3); \
    l_reg+=sacc; \
    if(GK){DMA_K((t)+3,sl_cur);} if(GV){DMA_V((t)+1,sl_next);} \
    CMASK(C0,C1,t); \
    { float a=MX3(C0[0],C0[1],C1[0]),b=MX3(C0[2],C0[3],C1[1]); a=MX3(a,C1[2],C1[3]); \
      _Pragma("unroll") for(int r=4;r<16;r+=4){a=MX3(a,C0[r],C0[r+1]);b=MX3(b,C0[r+2],C0[r+3]);a=MX3(a,C1[r],C1[r+1]);b=MX3(b,C1[r+2],C1[r+3]);} \
      float rm=__builtin_fmaxf(a,b); { auto rr=__builtin_amdgcn_permlane32_swap(__float_as_uint(rm),__float_as_uint(rm),false,false); rm=__builtin_fmaxf(__uint_as_float(rr[0]),__uint_as_float(rr[1])); } \
      resc=false; \
      if(__builtin_expect(__any(rm>(float)THRL),0)){ const float dl=__builtin_fmaxf(rm,0.f); mhat+=dl; \
        _Pragma("unroll") for(int r=0;r<16;++r){C0[r]-=dl;C1[r]-=dl;} \
        const float f=__builtin_amdgcn_exp2f(-dl); l_reg*=f; if(hi==0)wsf[r32]=f; resc=true; } } \
    SBAR(); \
    GAPB(o[0]=__builtin_amdgcn_mfma_f32_32x32x16_bf16(PAF(0),VFR(0),o[0],0,0,0), C0,0);  NXB(GL,P0,0,(t)+1,0); \
    GAPB(o[1]=__builtin_amdgcn_mfma_f32_32x32x16_bf16(PAF(0),VFR(4),o[1],0,0,0), C0,4);  NXB(GL,P0,1,(t)+1,0); \
    KRD(GL,0); GAPB(o[0]=__builtin_amdgcn_mfma_f32_32x32x16_bf16(PAF(1),VFR(1),o[0],0,0,0), C0,8);  NXB(GL,P0,2,(t)+1,0); \
    KRD(GL,1); GAPB(o[1]=__builtin_amdgcn_mfma_f32_32x32x16_bf16(PAF(1),VFR(5),o[1],0,0,0), C0,12); NXB(GL,P0,3,(t)+1,0); \
    KRD(GL,2); GAPB(o[0]=__builtin_amdgcn_mfma_f32_32x32x16_bf16(PAF(2),VFR(2),o[0],0,0,0), C1,0);  NXB(GL,P1,0,(t)+1,32); \
    KRD(GL,3); GAPB(o[1]=__builtin_amdgcn_mfma_f32_32x32x16_bf16(PAF(2),VFR(6),o[1],0,0,0), C1,4);  NXB(GL,P1,1,(t)+1,32); \
    GAPB(o[0]=__builtin_amdgcn_mfma_f32_32x32x16_bf16(PAF(3),VFR(3),o[0],0,0,0), C1,8);  NXB(GL,P1,2,(t)+1,32); \
    GAPB(o[1]=__builtin_amdgcn_mfma_f32_32x32x16_bf16(PAF(3),VFR(7),o[1],0,0,0), C1,12); NXB(GL,P1,3,(t)+1,32); \
    }while(0)
  int t=1;
  #undef CMASK
  #define CMASK(P0,P1,t) do{}while(0)
  for(;t+5<NT;t+=2){
    STEP(pB0,pB1,pA0,pA1,t,true,true,true);     WAIT_BAR(2); RESC(); ROT();
    STEP(pA0,pA1,pB0,pB1,t+1,true,true,true);   WAIT_BAR(2); RESC(); ROT();
  }
  #undef CMASK
  #define CMASK(P0,P1,t) do{int jb_=(t)-(NT-4); if(jb_>=0)cmask(P0,P1,jb_,qrel,hi);}while(0)
  #define ENDW(tt) do{ if((tt)+3<NT){WAIT_BAR(2);} else if((tt)+2<NT){WAIT_BAR(1);} else {WAIT_BAR(0);} }while(0)
  for(;t+1<NT;t+=2){
    STEP(pB0,pB1,pA0,pA1,t,(t+3<NT),(t+1<NT),(t+1<NT));       ENDW(t);   RESC(); ROT();
    STEP(pA0,pA1,pB0,pB1,t+1,(t+4<NT),(t+2<NT),(t+2<NT));     ENDW(t+1); RESC(); ROT();
  }
  STEP(pB0,pB1,pA0,pA1,NT-1,false,false,false); RESC();
  { float sacc=pB0[0]+pB0[1]; _Pragma("unroll") for(int r=2;r<16;++r)sacc+=pB0[r]; _Pragma("unroll") for(int r=0;r<16;++r)sacc+=pB1[r]; l_reg+=sacc;
    pw0=(u32x4){PKW(pB0,0),PKW(pB0,2),PKW(pB0,4),PKW(pB0,6)};pw1=(u32x4){PKW(pB0,8),PKW(pB0,10),PKW(pB0,12),PKW(pB0,14)};pw2=(u32x4){PKW(pB1,0),PKW(pB1,2),PKW(pB1,4),PKW(pB1,6)};pw3=(u32x4){PKW(pB1,8),PKW(pB1,10),PKW(pB1,12),PKW(pB1,14)};
    SBAR(); pv(o,vb0+sl_cur,PAF(0),PAF(1),PAF(2),PAF(3)); }
  #undef PKW
  #undef PAF
  #undef VFR
  #undef PIN
  #undef MX3
  #undef GAPA
  #undef GAPB
  #undef EX
  #undef VRD
  #undef KRD
  #undef NXB
  #undef STEP
  #undef ENDW
  {auto rr=__builtin_amdgcn_permlane32_swap(__float_as_uint(l_reg),__float_as_uint(l_reg),false,false);l_reg=__uint_as_float(rr[0])+__uint_as_float(rr[1]);}
  if(hi==0)wsf[32+r32]=l_reg;asm volatile("s_waitcnt lgkmcnt(0)":::"memory");
  float rli[16];
  #pragma unroll
  for(int r=0;r<16;++r)rli[r]=__builtin_amdgcn_rcpf(wsf[32+crow(r,hi)]);
  bf16*Ow=O+(rowbase+q0+wid*QBLK)*DM+h*D;
  { bf16*stg=(bf16*)(shm+LDS_OST)+wid*2048;
    #pragma unroll
    for(int r=0;r<16;++r){const int orow=crow(r,hi);
      #pragma unroll
      for(int d0=0;d0<2;++d0)stg[orow*64+d0*32+r32]=(bf16)(cvtpk_s(o[d0][r]*rli[r],0.f)&0xffffu);}
    asm volatile("s_waitcnt lgkmcnt(0)":::"memory");
    #pragma unroll
    for(int i=0;i<4;++i){const int row=i*8+(lane>>3),ch=lane&7; const u32x4 v=*(const u32x4*)(stg+row*64+ch*8); ATTN_STORE16(Ow+(long)row*DM+ch*8,v);} }
  asm volatile("s_waitcnt lgkmcnt(0)\n\ts_barrier":::"memory");
  #undef DMA_K
  #undef DMA_V
  #undef BINIT
  #undef BGRP
  #undef CMASK
  #undef START
  #undef RESC
  #undef ROT
}
constexpr int ATTN_LDS_BYTES=LDS_BYTES;
struct AttnTensors { const bf16* Q; const bf16* K; const bf16* V; bf16* O; const float* CKH; };
struct AttnUnit { int bh; int qb; };
struct StaticOrder {
  int G,c;
  __device__ __forceinline__ StaticOrder(int grid,int block):G(grid),c(block){}
  __device__ __forceinline__ bool next(int i,AttnUnit&u)const{ const int L=i*G+c; if(L>=BATCH*NHEAD*NQB)return false; const int ii=L>>8,g=L&255,s=g>>7,base=2*(ii>>1)+s; u.bh=g&127; u.qb=(ii&1)?(NQB-1-base):base; return true; }
  __device__ __forceinline__ void a_ready(const AttnUnit&)const{}
  __device__ __forceinline__ void done(const AttnUnit&)const{}
};
template<class Sched,int THRL=8> __device__ __forceinline__ void attn_phase(char*lds,const AttnTensors&T,const Sched&S){
  AttnUnit u;
  for(int i=0;S.next(i,u);++i){ S.a_ready(u); attn_unit<THRL>(u.bh/NHEAD,u.bh%NHEAD,u.qb,T.Q,T.K,T.V,T.O,T.CKH,lds); S.done(u); }
}
#undef SBAR
#undef WAIT_BAR
}

DI void ln_rows(const float* src, const float* g, const float* b, float* dst, bf16_t* xb, int gw, int ngw, int lane) {
    f32x4 gv[4], bv[4];
#pragma unroll
    for (int j = 0; j < 4; ++j) { gv[j] = *(const f32x4*)(g + lane * 4 + 256 * j); bv[j] = *(const f32x4*)(b + lane * 4 + 256 * j); }
    for (int row = gw; row < NTOK; row += ngw) {
        f32x4 v[4]; float s = 0.f;
#pragma unroll
        for (int j = 0; j < 4; ++j) { v[j] = *(const f32x4*)(src + (size_t)row * DM + lane * 4 + 256 * j); s += (v[j][0] + v[j][1]) + (v[j][2] + v[j][3]); }
        const float mean = wave_sum(s) * (1.f / DM); float s2 = 0.f;
#pragma unroll
        for (int j = 0; j < 4; ++j) { v[j] = v[j] - mean; s2 += (v[j][0] * v[j][0] + v[j][1] * v[j][1]) + (v[j][2] * v[j][2] + v[j][3] * v[j][3]); }
        const float rstd = 1.0f / sqrtf(wave_sum(s2) * (1.f / DM) + LN_EPS);
#pragma unroll
        for (int j = 0; j < 4; ++j) { const f32x4 y = v[j] * rstd * gv[j] + bv[j];
            if (dst) *(f32x4*)(dst + (size_t)row * DM + lane * 4 + 256 * j) = y;
            if (xb) *(u32x2*)(xb + (size_t)row * DM + lane * 4 + 256 * j) = pk4(y); }
    }
}

DI void moe_tables(const unsigned* cnt, LAS int* tstart, LAS int* cntl) {
    __syncthreads();
    if (threadIdx.x == 0) {
        int t = 0;
        for (int e = 0; e < NEXP; ++e) { const int c = (int)cnt[e]; cntl[e] = c; tstart[e] = t; t += (c + 255) >> 8; }
        tstart[NEXP] = t;
    }
    __syncthreads();
}

#define XB_TMO      128
#define XB_XCNT(j)  (256  + 64 * (j))
#define XB_XSUB(j)  (1280 + 64 * (j))
#define XB_XGEN(j)  (2304 + 64 * (j))
#define XB_TOP      3328
#define XB_TOPGEN   3392
#define XCD_BAR_WORDS 3456
#define XB_SPIN_CAP (1u << 18)
__device__ __forceinline__ unsigned xb_ld(unsigned* p)              { return __hip_atomic_load(p, __ATOMIC_RELAXED, __HIP_MEMORY_SCOPE_AGENT); }
__device__ __forceinline__ unsigned xb_add(unsigned* p, unsigned v) { return __hip_atomic_fetch_add(p, v, __ATOMIC_RELAXED, __HIP_MEMORY_SCOPE_AGENT); }
__device__ __forceinline__ unsigned xb_xcc_id() { return (unsigned)__builtin_amdgcn_s_getreg((3 << 11) | 20) & 0xFu; }
#define XB_SPIN(cond, bar) do { unsigned _sp = 0; while (cond) { __builtin_amdgcn_s_sleep(1); \
    if ((++_sp & 255u) == 0u) { if (xb_ld(&(bar)[XB_TMO])) break; if (_sp > XB_SPIN_CAP) { atomicAdd(&(bar)[XB_TMO], 1u); break; } } } } while (0)
struct XcdBarrier { unsigned* bar; unsigned x; volatile LAS unsigned* st; };
__device__ __forceinline__ XcdBarrier xcd_barrier_post(unsigned* bar, volatile LAS unsigned* st) {
    XcdBarrier b; b.bar = bar; b.x = xb_xcc_id(); b.st = st;
    if (threadIdx.x == 0) (void)xb_add(&bar[XB_XCNT(b.x)], 1u);
    return b;
}
__device__ __forceinline__ void xcd_barrier_complete(unsigned* bar, unsigned x, unsigned& nloc, unsigned& nx) {
    const unsigned G = gridDim.x * gridDim.y * gridDim.z;
    unsigned sum, cnt, mine, sp = 0u;
    for (;;) {
        sum = 0u; cnt = 0u; mine = 0u;
#pragma unroll
        for (unsigned j = 0; j < 16; ++j) { const unsigned c = xb_ld(&bar[XB_XCNT(j)]); sum += c; cnt += (c > 0u) ? 1u : 0u; mine = (j == x) ? c : mine; }
        if (sum == G) break;
        __builtin_amdgcn_s_sleep(1);
        if ((++sp & 255u) == 0u) { if (xb_ld(&bar[XB_TMO])) break; if (sp > XB_SPIN_CAP) { atomicAdd(&bar[XB_TMO], 1u); break; } }
    }
    nloc = mine > 0u ? mine : 1u; nx = cnt > 0u ? cnt : 1u;
}
__device__ __forceinline__ void xcd_barrier(const XcdBarrier& b) {
    asm volatile("s_waitcnt vmcnt(0)" ::: "memory");
    __syncthreads();
    if (threadIdx.x == 0) {
        unsigned* bar = b.bar;
        __builtin_amdgcn_s_waitcnt(0);
        unsigned nloc = b.st[0], nx = b.st[1];
        if (nloc == 0u) { xcd_barrier_complete(bar, b.x, nloc, nx); b.st[0] = nloc; b.st[1] = nx; }
        const unsigned old = xb_add(&bar[XB_XSUB(b.x)], 1u);
        const unsigned gen = old / nloc;
        if (old + 1u == (gen + 1u) * nloc) {
            __builtin_amdgcn_fence(__ATOMIC_RELEASE, "agent");
            asm volatile("s_waitcnt vmcnt(0)" ::: "memory");
            const unsigned og = xb_add(&bar[XB_TOP], 1u);
            const unsigned tg = og / nx;
            if (og + 1u == (tg + 1u) * nx) xb_add(&bar[XB_TOPGEN], 1u);
            else XB_SPIN(xb_ld(&bar[XB_TOPGEN]) == tg, bar);
            __builtin_amdgcn_fence(__ATOMIC_ACQUIRE, "agent");
            xb_add(&bar[XB_XGEN(b.x)], 1u);
            asm volatile("s_waitcnt vmcnt(0)" ::: "memory");
        } else {
            XB_SPIN(xb_ld(&bar[XB_XGEN(b.x)]) == gen, bar);
            __builtin_amdgcn_fence(__ATOMIC_ACQUIRE, "agent");
            asm volatile("s_waitcnt vmcnt(0)" ::: "memory");
        }
    }
    __syncthreads();
}

template <int PH> DI void run_phase(const Args& a, LAS unsigned char* lds) {
    int tid_ = threadIdx.x; asm volatile("" : "+v"(tid_));
    const int tid = tid_, lane = tid & 63, wid = tid >> 6;
    const int G = gridDim.x, bid = blockIdx.x;
    const int gw = bid * 8 + wid, ngw = G * 8, gtid = bid * 512 + tid, gthreads = G * 512;
    unsigned char* ws = a.ws;
    constexpr int L = (PH >= 10) ? 1 : 0;
    constexpr int IB_MOE = L ? 32 : 16;
    unsigned* cnt = (unsigned*)(ws + WS_CTL) + 64 * L;
    bf16_t* XB = (bf16_t*)(ws + WS_XB);
    LAS unsigned char* misc = lds + 131072;
    LAS int* tstart = (LAS int*)misc; LAS int* cntl = tstart + 72;
    float* SSQ_Q = (float*)(ws + WS_CTL + 256 * 1024); float* SSQ_KV = (float*)(ws + WS_TAB + 128 * 1024);

    if constexpr (PH == 0) {
        LAS float* scr = (LAS float*)(lds + wid * 8448);
        constexpr int I_IN = (1024 / 64) * (N_IN0 / 64), I_UQ = (256 / 64) * (768 / 64), I_UKV = (256 / 64) * (1280 / 64), I_OUT = (1024 / 64) * (1024 / 64);
        for (int it = gw; it < I_IN + I_UQ + I_UKV + I_OUT; it += ngw) {
            int r = it;
            if (r < I_IN) { prep_item((const float*)a.in(2), nullptr, 1440, 1024, nullptr, (bf16_t*)(ws + W_IN), 1024, N_IN0, map_in0, scr, r, lane); continue; } r -= I_IN;
            if (r < I_UQ) { prep_item((const float*)a.in(9), nullptr, 768, 256, (const float*)a.in(8), (bf16_t*)(ws + W_UQ), 256, 768, map_q, scr, r, lane); continue; } r -= I_UQ;
            if (r < I_UKV) { prep_item((const float*)a.in(11), nullptr, 1024, 128, (const float*)a.in(10), (bf16_t*)(ws + W_UKV), 256, 1280, map_kv, scr, r, lane); continue; } r -= I_UKV;
            prep_item((const float*)a.in(12), nullptr, 1024, 1024, nullptr, (bf16_t*)(ws + W_OUT), 1024, 1024, map_ident, scr, r, lane);
        }
        prep_moe(a, 16, scr, gw, ngw, lane, gtid, gthreads);
        float* b0 = (float*)(ws + WS_TAB); float* b1 = (float*)(ws + WS_TAB + 8192);
        for (int n = gtid; n < N_IN0; n += gthreads) { const int s = map_in0(n); b0[n] = s >= 0 ? ((const float*)a.in(3))[s] : 0.f; }
        for (int n = gtid; n < N_IN1; n += gthreads) b1[n] = n < 3088 ? ((const float*)a.in(27))[n] : 0.f;
        float* ct = (float*)(ws + WS_COS); float* st = (float*)(ws + WS_SIN); const int* pos = (const int*)a.in(1);
        for (int idx = gtid; idx < NTOK * 16; idx += gthreads) {
            const int t = idx >> 4, p = idx & 15;
            const float inv = 1.0f / exp2f((float)p * (13.287712379549449f / 16.0f));
            const float ang = (float)pos[t] * inv;
            double rev = (double)ang * 0.15915494309189535; rev -= rint(rev);
            ct[idx] = __builtin_amdgcn_cosf((float)rev); st[idx] = __builtin_amdgcn_sinf((float)rev);
        }
        const float* x = (const float*)a.in(0);
        for (int idx = gtid; idx < NTOK * DM / 8; idx += gthreads) {
            const f32x4 v0 = *(const f32x4*)(x + (size_t)idx * 8), v1 = *(const f32x4*)(x + (size_t)idx * 8 + 4);
            u32x4 o; o.x = pk2(v0[0], v0[1]); o.y = pk2(v0[2], v0[3]); o.z = pk2(v1[0], v1[1]); o.w = pk2(v1[2], v1[3]);
            *(u32x4*)(XB + (size_t)idx * 8) = o;
        }
    }
    else if constexpr (PH == 1) {
        const bf16_t* Bt = (const bf16_t*)(ws + W_IN); const float* bias = (const float*)(ws + WS_TAB);
        bf16_t* UPRE = (bf16_t*)(ws + B_UPRE); bf16_t* QL = (bf16_t*)(ws + B_QL); bf16_t* KVL = (bf16_t*)(ws + B_KVL);
        pg8::DenseOrder S; S.init(NTOK, N_IN0, 1024, Bt, G, bid);
        auto f = [=](const pg8::Unit& u, int r, int c, f32x4 l0, f32x4 l1, f32x4 h0, f32x4 h1) {
            const int nt = u.pn; const size_t row = (size_t)u.pm * 256 + r;
            l0 = l0 + *(const f32x4*)(bias + nt * 256 + c); l1 = l1 + *(const f32x4*)(bias + nt * 256 + c + 4);
            h0 = h0 + *(const f32x4*)(bias + nt * 256 + 128 + c); h1 = h1 + *(const f32x4*)(bias + nt * 256 + 128 + c + 4);
            if (nt < 4) {
#pragma unroll
                for (int i = 0; i < 4; ++i) { l0[i] = l0[i] * sigmoidf_(h0[i]); l1[i] = l1[i] * sigmoidf_(h1[i]); }
                *(u32x4*)(UPRE + row * 512 + nt * 128 + c) = pk8(l0, l1);
            } else {
                bf16_t* dst = QL + (size_t)(nt - 4) * (B_KVL - B_QL) / 2;
                *(u32x4*)(dst + row * 256 + c) = pk8(l0, l1); *(u32x4*)(dst + row * 256 + 128 + c) = pk8(h0, h1);
                float ss = dot4(l0) + dot4(l1); if (nt == 4) ss += dot4(h0) + dot4(h1);
                ss += __shfl_xor(ss, 16); ss += __shfl_xor(ss, 32);
                if ((lane >> 4) == 0) { if (nt == 4) SSQ_Q[row * 4 + (c >> 5)] = ss; else SSQ_KV[row * 4 + (c >> 5)] = ss; }
            }
        };
        pg8::gemm_phase(lds, XB, 1024, S, pg8::make_epi(f));
    }
    else if constexpr (PH == 2) {
        const bf16_t* UPRE = (const bf16_t*)(ws + B_UPRE); bf16_t* UO = (bf16_t*)(ws + B_UO);
        {
            const float* cw = (const float*)a.in(4); const float* cb = (const float*)a.in(5); const float* lg = (const float*)a.in(6); const float* lb = (const float*)a.in(7);
            LAS bf16_t* U = (LAS bf16_t*)lds;
            LAS float* CO = (LAS float*)(lds + 94 * 512 * 2);
            float w[31];
#pragma unroll
            for (int j = 0; j < 31; ++j) w[j] = cw[j * 512 + tid];
            const float bch = cb[tid];
            f32x4 g0 = *(const f32x4*)(lg + lane * 8), g1 = *(const f32x4*)(lg + lane * 8 + 4), b0 = *(const f32x4*)(lb + lane * 8), b1 = *(const f32x4*)(lb + lane * 8 + 4);
            for (int u = bid; u < NTOK / 64; u += G) {
                const int tok0 = u * 64, s0 = tok0 % SEQ;
                __syncthreads();
                for (int c = tid; c < 94 * 64; c += 512) { const int r = c >> 6, ch = c & 63; const int s = s0 - 30 + r;
                    u32x4 v = (u32x4){0u, 0u, 0u, 0u}; if (s >= 0) v = *(const u32x4*)(UPRE + (size_t)(tok0 - 30 + r) * 512 + ch * 8);
                    *(LAS u32x4*)(U + r * 512 + ch * 8) = v; }
                __syncthreads();
                for (int sub = 0; sub < 4; ++sub) {
                    for (int tt = 0; tt < 16; ++tt) { const int tl = sub * 16 + tt; float acc = bch;
#pragma unroll
                        for (int j = 0; j < 31; ++j) acc += w[j] * bf2f(U[(tl + j) * 512 + tid]);
                        CO[tt * 512 + tid] = acc; }
                    __syncthreads();
#pragma unroll
                    for (int k = 0; k < 2; ++k) { const int tt = 2 * wid + k;
                        f32x4 v0 = *(LAS f32x4*)(CO + tt * 512 + lane * 8), v1 = *(LAS f32x4*)(CO + tt * 512 + lane * 8 + 4);
                        const float mean = wave_sum((v0[0] + v0[1]) + (v0[2] + v0[3]) + (v1[0] + v1[1]) + (v1[2] + v1[3])) * (1.f / 512.f);
                        v0 = v0 - mean; v1 = v1 - mean;
                        const float var = wave_sum((v0[0] * v0[0] + v0[1] * v0[1]) + (v0[2] * v0[2] + v0[3] * v0[3]) + (v1[0] * v1[0] + v1[1] * v1[1]) + (v1[2] * v1[2] + v1[3] * v1[3])) * (1.f / 512.f);
                        const float rstd = 1.0f / sqrtf(var + LN_EPS);
                        f32x4 y0 = v0 * rstd * g0 + b0, y1 = v1 * rstd * g1 + b1;
#pragma unroll
                        for (int i = 0; i < 4; ++i) { y0[i] = siluf_(y0[i]); y1[i] = siluf_(y1[i]); }
                        u32x4 o; o.x = pk2(y0[0], y0[1]); o.y = pk2(y0[2], y0[3]); o.z = pk2(y1[0], y1[1]); o.w = pk2(y1[2], y1[3]);
                        *(u32x4*)(UO + (size_t)(tok0 + sub * 16 + tt) * 1024 + lane * 8) = o; }
                    __syncthreads();
                }
            }
        }
        const float* ct = (const float*)(ws + WS_COS); const float* st = (const float*)(ws + WS_SIN);
        {
            const bf16_t* QL = (const bf16_t*)(ws + B_QL); bf16_t* Q0 = (bf16_t*)(ws + B_Q0);
            pg8::DenseOrder S; S.init(NTOK, 768, 256, (const bf16_t*)(ws + W_UQ), G, bid);
            auto f = [=](const pg8::Unit& u, int r, int c, f32x4 l0, f32x4 l1, f32x4 h0, f32x4 h1) {
                const size_t row = (size_t)u.pm * 256 + r; const f32x4 sq = *(const f32x4*)(SSQ_Q + row * 4); const float s = 1.0f / sqrtf(((sq[0] + sq[1]) + (sq[2] + sq[3])) * (1.f / 256.f) + RMS_EPS);
#pragma unroll
                for (int hh = 0; hh < 2; ++hh) { f32x4 v0 = (hh ? h0 : l0) * s, v1 = (hh ? h1 : l1) * s; const int col = u.pn * 256 + c + 128 * hh; const int d = col % 96;
                    if (d >= 64) rope8(v0, v1, ct, st, row, (d - 64) >> 1);
                    *(u32x4*)(Q0 + row * 768 + col) = pk8(v0 * C2_MLA, v1 * C2_MLA); }
            };
            pg8::gemm_phase(lds, QL, 256, S, pg8::make_epi(f));
        }
        {
            const bf16_t* KVL = (const bf16_t*)(ws + B_KVL); bf16_t* K0 = (bf16_t*)(ws + B_K0); bf16_t* V0 = (bf16_t*)(ws + B_V0);
            pg8::DenseOrder S; S.init(NTOK, 1280, 256, (const bf16_t*)(ws + W_UKV), G, bid);
            auto f = [=](const pg8::Unit& u, int r, int c, f32x4 l0, f32x4 l1, f32x4 h0, f32x4 h1) {
                const size_t row = (size_t)u.pm * 256 + r; const f32x4 sq = *(const f32x4*)(SSQ_KV + row * 4); const float s = 1.0f / sqrtf(((sq[0] + sq[1]) + (sq[2] + sq[3])) * (1.f / 128.f) + RMS_EPS);
#pragma unroll
                for (int hh = 0; hh < 2; ++hh) { f32x4 v0 = (hh ? h0 : l0), v1 = (hh ? h1 : l1); const int col = u.pn * 256 + c + 128 * hh;
                    if (col < 768) { const int d = col % 96;
                        if (d >= 64) rope8(v0, v1, ct, st, row, (d - 64) >> 1); else { v0 = v0 * s; v1 = v1 * s; }
                        *(u32x4*)(K0 + row * 768 + col) = pk8(v0, v1); }
                    else *(u32x4*)(V0 + row * 512 + (col - 768)) = pk8(v0 * s, v1 * s); }
            };
            pg8::gemm_phase(lds, KVL, 256, S, pg8::make_epi(f));
        }
    }
    else if constexpr (PH == 3) {
        const bf16_t* Q0 = (const bf16_t*)(ws + B_Q0); const bf16_t* K0 = (const bf16_t*)(ws + B_K0); const bf16_t* V0 = (const bf16_t*)(ws + B_V0); bf16_t* UO = (bf16_t*)(ws + B_UO);
        for (int u = bid; u < 64 * 16; u += G) {
            const int i = u >> 8, gp = u & 255, s = gp >> 6, bh = gp & 63, base = 4 * (i >> 1) + s, qb = (i & 1) ? 15 - base : base;
            const int b = bh >> 3, h = bh & 7;
            attn_simple_unit<96, 768, 768, 512, 1024, false>(lds, Q0, K0, V0, UO, nullptr, b, h * 96, h * 64, 0, 512 + h * 64, qb);
        }
    }
    else if constexpr (PH == 4 || PH == 13) {
        const bf16_t* A = (const bf16_t*)(ws + (L ? B_O1 : B_UO));
        const float* bias = (const float*)a.in(L ? 29 : 13); const float* xres = L ? (const float*)a.out : (const float*)a.in(0); float* pre = a.out;
        pg8::DenseOrder S; S.init(NTOK, 1024, 1024, (const bf16_t*)(ws + W_OUT), G, bid);
        auto f = [=](const pg8::Unit& u, int r, int c, f32x4 l0, f32x4 l1, f32x4 h0, f32x4 h1) {
            const int col = u.pn * 256 + c; const size_t off = ((size_t)u.pm * 256 + r) * 1024 + col;
            const f32x4 x0 = *(const f32x4*)(xres + off), x1 = *(const f32x4*)(xres + off + 4), x2 = *(const f32x4*)(xres + off + 128), x3 = *(const f32x4*)(xres + off + 132);
            *(f32x4*)(pre + off) = x0 * ALPHA + l0 + *(const f32x4*)(bias + col); *(f32x4*)(pre + off + 4) = x1 * ALPHA + l1 + *(const f32x4*)(bias + col + 4);
            *(f32x4*)(pre + off + 128) = x2 * ALPHA + h0 + *(const f32x4*)(bias + col + 128); *(f32x4*)(pre + off + 132) = x3 * ALPHA + h1 + *(const f32x4*)(bias + col + 132);
        };
        pg8::gemm_phase(lds, A, 1024, S, pg8::make_epi(f));
    }
    else if constexpr (PH == 5 || PH == 14) {
        ln_rows(a.out, (const float*)a.in(L ? 30 : 14), (const float*)a.in(L ? 31 : 15), a.out, XB, gw, ngw, lane);
    }
    else if constexpr (PH == 6 || PH == 15) {
        {
            const float* x1 = a.out; const bf16_t* rhi = (const bf16_t*)(ws + W_RHI); const bf16_t* rlo = (const bf16_t*)(ws + W_RLO);
            const float* rbias = (const float*)a.in(IB_MOE + 1);
            int* LIST = (int*)(ws + B_LIST); float* LISTW = (float*)(ws + B_LISTW);
            LAS float* lgl = (LAS float*)(lds + 49152);
            LAS int* lcnt = (LAS int*)(lds + 49152 + 33280);
            LAS int* lbase = lcnt + 64;
            LAS int* sel_e = lbase + 64;
            LAS int* sel_p = sel_e + 768;
            LAS float* sel_w = (LAS float*)(sel_p + 768);
            const int fr = lane & 15, fq = lane >> 4;
            const float mybias = rbias[lane];
            for (int u = bid; u < NTOK / 128; u += G) {
                const int t0 = u * 128;
                f32x4 acc[4];
#pragma unroll
                for (int n = 0; n < 4; ++n) acc[n] = (f32x4){0.f, 0.f, 0.f, 0.f};
                const int sr = tid >> 2, sc = (tid & 3) * 8;
                const float* xp = x1 + (size_t)(t0 + sr) * 1024 + sc; const bf16_t* wp = (tid < 256 ? rhi : rlo) + (size_t)((tid & 255) >> 2) * 1024 + (tid & 3) * 8;
                f32x4 v0, v1; u32x4 wv;
#define RT_WRITE(b) do { LAS unsigned char* base_ = lds + (b) * 24576; u32x4 h, lo_; \
                    h.x = pk2(v0[0], v0[1]); h.y = pk2(v0[2], v0[3]); h.z = pk2(v1[0], v1[1]); h.w = pk2(v1[2], v1[3]); \
                    lo_.x = pk2(v0[0] - __uint_as_float(h.x << 16), v0[1] - __uint_as_float(h.x & 0xffff0000u)); \
                    lo_.y = pk2(v0[2] - __uint_as_float(h.y << 16), v0[3] - __uint_as_float(h.y & 0xffff0000u)); \
                    lo_.z = pk2(v1[0] - __uint_as_float(h.z << 16), v1[1] - __uint_as_float(h.z & 0xffff0000u)); \
                    lo_.w = pk2(v1[2] - __uint_as_float(h.w << 16), v1[3] - __uint_as_float(h.w & 0xffff0000u)); \
                    *(LAS u32x4*)(base_ + sr * 64 + sc * 2) = h; *(LAS u32x4*)(base_ + 8192 + sr * 64 + sc * 2) = lo_; \
                    *(LAS u32x4*)(base_ + (tid < 256 ? 16384 : 20480) + ((tid & 255) >> 2) * 64 + (tid & 3) * 16) = wv; } while (0)
                v0 = *(const f32x4*)(xp); v1 = *(const f32x4*)(xp + 4); wv = *(const u32x4*)(wp);
                __syncthreads();
                RT_WRITE(0);
                __syncthreads();
                for (int kt = 0; kt < 32; ++kt) {
                    if (kt + 1 < 32) { v0 = *(const f32x4*)(xp + (kt + 1) * 32); v1 = *(const f32x4*)(xp + (kt + 1) * 32 + 4); wv = *(const u32x4*)(wp + (kt + 1) * 32); }
                    LAS unsigned char* base = lds + (kt & 1) * 24576;
                    const bf16x8 ah = *(LAS bf16x8*)(base + (16 * wid + fr) * 64 + fq * 16), al = *(LAS bf16x8*)(base + 8192 + (16 * wid + fr) * 64 + fq * 16);
#pragma unroll
                    for (int n = 0; n < 4; ++n) { const bf16x8 bh = *(LAS bf16x8*)(base + 16384 + (16 * n + fr) * 64 + fq * 16), bl = *(LAS bf16x8*)(base + 20480 + (16 * n + fr) * 64 + fq * 16);
                        acc[n] = mfma16(bh, ah, acc[n]); acc[n] = mfma16(bh, al, acc[n]); acc[n] = mfma16(bl, ah, acc[n]); }
                    if (kt + 1 < 32) RT_WRITE((kt + 1) & 1);
                    __syncthreads();
                }
#undef RT_WRITE
#pragma unroll
                for (int n = 0; n < 4; ++n)
#pragma unroll
                    for (int j = 0; j < 4; ++j) lgl[(16 * wid + fr) * 65 + 16 * n + 4 * fq + j] = acc[n][j];
                if (tid < 64) lcnt[tid] = 0;
                __syncthreads();
                for (int tt = 0; tt < 16; ++tt) {
                    const int tl = 16 * wid + tt;
                    const float sg = sigmoidf_(lgl[tl * 65 + lane]); const float ch = sg + mybias;
                    const int g = lane >> 3; int rk = 0;
#pragma unroll
                    for (int jj = 0; jj < 8; ++jj) { const int oj = (lane & ~7) + jj; const float o = __shfl(ch, oj); rk += ((o > ch) || (o == ch && oj < lane)) ? 1 : 0; }
                    float top = rk < 2 ? ch : 0.f; top += __shfl_xor(top, 1); top += __shfl_xor(top, 2); top += __shfl_xor(top, 4);
                    int grk = 0;
#pragma unroll
                    for (int gg = 0; gg < 8; ++gg) { const float o = __shfl(top, gg * 8); grk += ((o > top) || (o == top && gg < g)) ? 1 : 0; }
                    const bool gsel = grk < 4; const float mv = gsel ? ch : -INFINITY; int erk = 0;
#pragma unroll 8
                    for (int j = 0; j < 64; ++j) { const float o = __shfl(mv, j); erk += ((o > mv) || (o == mv && j < lane)) ? 1 : 0; }
                    const bool sel = gsel && erk < TOPK;
                    const float tot = wave_sum(sel ? sg : 0.f); const float w = sg / tot * 2.5f;
                    if (sel) { const int lp = __hip_atomic_fetch_add(lcnt + lane, 1, __ATOMIC_RELAXED, __HIP_MEMORY_SCOPE_WORKGROUP);
                        sel_e[tl * 6 + erk] = lane; sel_p[tl * 6 + erk] = lp; sel_w[tl * 6 + erk] = w; }
                }
                __syncthreads();
                if (tid < 64) { const int c = lcnt[tid]; lbase[tid] = c ? (int)atomicAdd(cnt + tid, (unsigned)c) : 0; }
                __syncthreads();
                for (int idx = tid; idx < 768; idx += 512) { const int e = sel_e[idx], pos = lbase[e] + sel_p[idx], tl = idx / 6, j = idx % 6; LIST[(size_t)e * LISTCAP + pos] = ((t0 + tl) << 3) | j; LISTW[(size_t)e * LISTCAP + pos] = sel_w[idx]; }
                __syncthreads();
            }
        }
        {
            bf16_t* SH = (bf16_t*)(ws + B_SH);
            pg8::DenseOrder S; S.init(NTOK, 512, 1024, (const bf16_t*)(ws + W_SGU), G, bid);
            auto f = [=](const pg8::Unit& u, int r, int c, f32x4 l0, f32x4 l1, f32x4 h0, f32x4 h1) {
#pragma unroll
                for (int i = 0; i < 4; ++i) { l0[i] = siluf_(l0[i]) * h0[i]; l1[i] = siluf_(l1[i]) * h1[i]; }
                *(u32x4*)(SH + ((size_t)u.pm * 256 + r) * 256 + u.pn * 128 + c) = pk8(l0, l1); };
            pg8::gemm_phase(lds, XB, 1024, S, pg8::make_epi(f));
        }
    }
    else if constexpr (PH == 7 || PH == 16) {
        moe_tables(cnt, tstart, cntl);
        bf16_t* H = (bf16_t*)(ws + B_H);
        pg8::GroupedOrder<true> S{tstart, cntl, 2, G, bid, (const char*)(ws + W_GU), (size_t)512 * 1024 * 2, (size_t)256 * 1024 * 2, (const int*)(ws + B_LIST), 0};
        auto f = [=](const pg8::Unit& u, int r, int c, f32x4 l0, f32x4 l1, f32x4 h0, f32x4 h1) {
#pragma unroll
            for (int i = 0; i < 4; ++i) { l0[i] = siluf_(l0[i]) * h0[i]; l1[i] = siluf_(l1[i]) * h1[i]; }
            *(u32x4*)(H + ((size_t)(tstart[u.e] + u.pm) * 256 + r) * 256 + u.pn * 128 + c) = pk8(l0, l1); };
        pg8::gemm_phase(lds, XB, 1024, S, pg8::make_epi(f));
    }
    else if constexpr (PH == 8 || PH == 17) {
        moe_tables(cnt, tstart, cntl);
        pg8::GroupedOrder<false> S{tstart, cntl, 4, G, bid, (const char*)(ws + W_D), (size_t)1024 * 256 * 2, (size_t)256 * 256 * 2, (const int*)(ws + B_LIST), NTOK / 256};
        EpiDown E{cntl, (const int*)(ws + B_LIST), (const float*)(ws + B_LISTW), ws + B_YT};
        pg8::gemm_phase(lds, (const bf16_t*)(ws + B_H), 256, S, E);
    }
    else if constexpr (PH == 9 || PH == 18) {
        {
            const unsigned char* YT = ws + B_YT; float* xo = a.out;
            const float* g = (const float*)a.in(IB_MOE + 8); const float* b = (const float*)a.in(IB_MOE + 9);
            f32x4 gv[4], bv[4];
#pragma unroll
            for (int j = 0; j < 4; ++j) { gv[j] = *(const f32x4*)(g + lane * 16 + 4 * j); bv[j] = *(const f32x4*)(b + lane * 16 + 4 * j); }
            for (int row = gw; row < NTOK; row += ngw) {
                f32x4 v[4]; u32x4 y[7];
#pragma unroll
                for (int j = 0; j < 4; ++j) v[j] = *(const f32x4*)(xo + (size_t)row * DM + lane * 16 + 4 * j);
#pragma unroll
                for (int s = 0; s < 7; ++s) y[s] = *(const u32x4*)(YT + ((size_t)row * 7 + s) * 1024 + lane * 16);
                f32x4 acc[4];
#pragma unroll
                for (int j = 0; j < 4; ++j) acc[j] = (f32x4){0.f, 0.f, 0.f, 0.f};
#pragma unroll
                for (int s = 0; s < 7; ++s)
#pragma unroll
                    for (int j = 0; j < 4; ++j) { const f32x2_t lo = __builtin_amdgcn_cvt_pk_f32_fp8((int)y[s][j], false), hi = __builtin_amdgcn_cvt_pk_f32_fp8((int)y[s][j], true);
                        acc[j][0] += lo[0]; acc[j][1] += lo[1]; acc[j][2] += hi[0]; acc[j][3] += hi[1]; }
                float sm = 0.f;
#pragma unroll
                for (int j = 0; j < 4; ++j) { v[j] = v[j] * ALPHA + acc[j] * (1.0f / YSCALE); sm += (v[j][0] + v[j][1]) + (v[j][2] + v[j][3]); }
                const float mean = wave_sum(sm) * (1.f / DM); float s2 = 0.f;
#pragma unroll
                for (int j = 0; j < 4; ++j) { v[j] = v[j] - mean; s2 += (v[j][0] * v[j][0] + v[j][1] * v[j][1]) + (v[j][2] * v[j][2] + v[j][3] * v[j][3]); }
                const float rstd = 1.0f / sqrtf(wave_sum(s2) * (1.f / DM) + LN_EPS);
#pragma unroll
                for (int j = 0; j < 4; ++j) { v[j] = v[j] * rstd * gv[j] + bv[j]; *(f32x4*)(xo + (size_t)row * DM + lane * 16 + 4 * j) = v[j]; }
                if (PH == 9) { *(u32x4*)(XB + (size_t)row * DM + lane * 16) = pk8(v[0], v[1]); *(u32x4*)(XB + (size_t)row * DM + lane * 16 + 8) = pk8(v[2], v[3]); }
            }
        }
        if constexpr (PH == 9) {
            LAS float* scr = nullptr;
            constexpr int I_IN = (1024 / 64) * (N_IN1 / 64), I_OUT = (1024 / 64) * (1024 / 64);
            for (int it = gw; it < I_IN + I_OUT; it += ngw) {
                int r = it;
                if (r < I_IN) { prep_item((const float*)a.in(26), nullptr, 3088, 1024, nullptr, (bf16_t*)(ws + W_IN), 1024, N_IN1, map_in1, scr, r, lane); continue; } r -= I_IN;
                prep_item((const float*)a.in(28), nullptr, 1024, 1024, nullptr, (bf16_t*)(ws + W_OUT), 1024, 1024, map_ident, scr, r, lane);
            }
            prep_moe(a, 32, scr, gw, ngw, lane, gtid, gthreads);
        }
    }
    else if constexpr (PH == 10) {
        const float* bias = (const float*)(ws + WS_TAB + 8192);
        bf16_t* Q1 = (bf16_t*)(ws + B_Q1); bf16_t* K1 = (bf16_t*)(ws + B_K1); bf16_t* V1 = (bf16_t*)(ws + B_V1); float* GL = (float*)(ws + B_GL);
        pg8::DenseOrder S; S.init(NTOK, N_IN1, 1024, (const bf16_t*)(ws + W_IN), G, bid);
        auto f = [=](const pg8::Unit& u, int r, int c, f32x4 l0, f32x4 l1, f32x4 h0, f32x4 h1) {
            const int nt = u.pn; const size_t row = (size_t)u.pm * 256 + r;
            l0 = l0 + *(const f32x4*)(bias + nt * 256 + c); l1 = l1 + *(const f32x4*)(bias + nt * 256 + c + 4);
            h0 = h0 + *(const f32x4*)(bias + nt * 256 + 128 + c); h1 = h1 + *(const f32x4*)(bias + nt * 256 + 128 + c + 4);
            if (nt < 4) { *(u32x4*)(Q1 + row * 1024 + nt * 256 + c) = pk8(l0 * C2_FOX, l1 * C2_FOX); *(u32x4*)(Q1 + row * 1024 + nt * 256 + 128 + c) = pk8(h0 * C2_FOX, h1 * C2_FOX); }
            else if (nt < 8) { *(u32x4*)(K1 + row * 1024 + (nt - 4) * 256 + c) = pk8(l0, l1); *(u32x4*)(K1 + row * 1024 + (nt - 4) * 256 + 128 + c) = pk8(h0, h1); }
            else if (nt < 12) { *(u32x4*)(V1 + row * 1024 + (nt - 8) * 256 + c) = pk8(l0, l1); *(u32x4*)(V1 + row * 1024 + (nt - 8) * 256 + 128 + c) = pk8(h0, h1); }
            else if (c < 16) {
#pragma unroll
                for (int i = 0; i < 4; ++i) { float x = l0[i]; l0[i] = fminf(x, 0.f) - log1pf(__expf(-fabsf(x))); x = l1[i]; l1[i] = fminf(x, 0.f) - log1pf(__expf(-fabsf(x))); }
                *(f32x4*)(GL + row * 16 + c) = l0; *(f32x4*)(GL + row * 16 + c + 4) = l1; }
        };
        pg8::gemm_phase(lds, XB, 1024, S, pg8::make_epi(f));
    }
    else if constexpr (PH == 11) {
        const float* GL = (const float*)(ws + B_GL); float* CK = (float*)(ws + B_CK);
        for (int sq = gw; sq < NBATCH * 16; sq += ngw) {
            const int b = sq >> 4, h = sq & 15; float v[64];
            const float* gp = GL + ((size_t)b * SEQ + lane * 64) * 16 + h;
#pragma unroll
            for (int i = 0; i < 64; ++i) v[i] = gp[i * 16];
#pragma unroll
            for (int i = 1; i < 64; ++i) v[i] += v[i - 1];
            const float tot = v[63]; float inc = tot;
#pragma unroll
            for (int o = 1; o < 64; o <<= 1) { const float n = __shfl_up(inc, o); if (lane >= o) inc += n; }
            const float excl = inc - tot;
            float* op = CK + ((size_t)b * 16 + h) * SEQ + lane * 64;
#pragma unroll
            for (int i = 0; i < 16; ++i) { f32x4 o; o[0] = (v[4 * i] + excl) * LOG2E; o[1] = (v[4 * i + 1] + excl) * LOG2E; o[2] = (v[4 * i + 2] + excl) * LOG2E; o[3] = (v[4 * i + 3] + excl) * LOG2E; *(f32x4*)(op + 4 * i) = o; }
        }
    }
    else if constexpr (PH == 12) {
        static_assert(attn_fox::ATTN_LDS_BYTES <= 131072, "attention LDS");
        const attn_fox::AttnTensors AT{(const bf16_t*)(ws + B_Q1), (const bf16_t*)(ws + B_K1), (const bf16_t*)(ws + B_V1), (bf16_t*)(ws + B_O1), (const float*)(ws + B_CK)};
        const attn_fox::StaticOrder S(G, bid);
        attn_fox::attn_phase<attn_fox::StaticOrder>((char*)lds, AT, S);
    }
}

constexpr int LDS_BYTES = 147456;
constexpr int CW_BAR = 4096;
constexpr int NPHASE = 19;
template <int PH, int END> struct RunAll {
    static DI void run(const Args& a, LAS unsigned char* lds, const XcdBarrier& bar) {
        run_phase<PH>(a, lds);
#ifdef PROBE_MASK
        if constexpr ((PROBE_MASK >> PH) & 1u) { xcd_barrier(bar); run_phase<PH>(a, lds); }
#endif
        if (PH + 1 < END) xcd_barrier(bar);
        RunAll<PH + 1, END>::run(a, lds, bar);
    }
};
template <int END> struct RunAll<END, END> { static DI void run(const Args&, LAS unsigned char*, const XcdBarrier&) {} };

__global__ void __launch_bounds__(512, 2) k_all(KArgs ka) {
    extern __shared__ __attribute__((aligned(16))) unsigned char lds_raw[];
    LAS unsigned char* lds = (LAS unsigned char*)lds_raw;
    Args a; a.tab = (LAS unsigned long long*)(lds + 131072 + 1024); a.out = ka.out; a.ws = ka.ws;
    { const int t_ = threadIdx.x;
#pragma unroll
      for (int k = 0; k < 42; ++k) if (t_ == k) a.tab[k] = (unsigned long long)ka.in[k]; }
    volatile LAS unsigned* st = (volatile LAS unsigned*)(lds + LDS_BYTES - 16);
    if (threadIdx.x == 0) { st[0] = 0u; st[1] = 0u; st[2] = 0u; st[3] = 0u; }
    __syncthreads();
    const XcdBarrier bar = xcd_barrier_post((unsigned*)(a.ws + WS_CTL) + CW_BAR, st);
    RunAll<0, NPHASE>::run(a, lds, bar);
}

extern "C" void kernel_launch(void* const* d_in, const int* in_sizes, int n_in, void* d_out, int out_size, void* d_ws, size_t ws_size, hipStream_t stream) {
    static int grid = 0;
    if (grid == 0) {
        if (n_in != 42 || out_size != NTOK * DM || ws_size < WS_END) { fprintf(stderr, "kernel_launch: unexpected shapes (n_in %d, out %d, ws %zu < %zu)\n", n_in, out_size, ws_size, (size_t)WS_END); grid = -1; return; }
        int dev = 0, cus = 0, per_cu = 0;
        (void)hipGetDevice(&dev); (void)hipDeviceGetAttribute(&cus, hipDeviceAttributeMultiprocessorCount, dev);
        (void)hipFuncSetAttribute((const void*)k_all, hipFuncAttributeMaxDynamicSharedMemorySize, LDS_BYTES);
        if (hipOccupancyMaxActiveBlocksPerMultiprocessor(&per_cu, (const void*)k_all, 512, LDS_BYTES) != hipSuccess || per_cu < 1) { fprintf(stderr, "kernel_launch: occupancy query reports %d blocks per CU\n", per_cu); per_cu = 1; }
        (void)hipGetLastError();
        grid = cus > 0 ? cus : 256;
    }
    if (grid < 0) return;
    (void)hipMemsetAsync((char*)d_ws + WS_CTL, 0, 1 * MiB, stream);
    KArgs a{};
    for (int i = 0; i < 42; ++i) a.in[i] = d_in[i];
    a.out = (float*)d_out; a.ws = (unsigned char*)d_ws;
    hipLaunchKernelGGL(k_all, dim3(grid), dim3(512), LDS_BYTES, stream, a);
}
```

```cpp
#include <hip/hip_runtime.h>
#include <cstdio>
#include <cstdint>
#include <cmath>

#define LAS __attribute__((address_space(3)))
#define DI __device__ __forceinline__
typedef unsigned short bf16_t;
typedef short bf16x8 __attribute__((ext_vector_type(8)));
typedef short s16x4 __attribute__((ext_vector_type(4)));
typedef float f32x4 __attribute__((ext_vector_type(4)));
typedef float f32x16 __attribute__((ext_vector_type(16)));
typedef unsigned u32x4 __attribute__((ext_vector_type(4)));
typedef unsigned u32x2 __attribute__((ext_vector_type(2)));
typedef float f32x2_t __attribute__((ext_vector_type(2)));
typedef __bf16 bf16x2_t __attribute__((ext_vector_type(2)));

constexpr int NTOK = 32768, DM = 1024, NBATCH = 8, SEQ = 4096;
constexpr int NEXP = 64, TOPK = 6, EHID = 256;
constexpr float ALPHA = 1.4142135623730951f;
constexpr float LN_EPS = 1e-5f, RMS_EPS = 1e-6f;
constexpr float LOG2E = 1.4426950408889634f;
constexpr float C2_MLA = 0.10206207261596577f * LOG2E;
constexpr float C2_FOX = 0.125f * LOG2E;
constexpr int N_IN0 = 1536, N_IN1 = 3328;
constexpr int LISTCAP = 32768;
constexpr int HROWS = 212992;

constexpr size_t MiB = 1u << 20;
constexpr size_t WS_CTL = 0;
constexpr size_t WS_TAB = 1 * MiB;
constexpr size_t WS_COS = 2 * MiB, WS_SIN = 4 * MiB;
constexpr size_t WS_W = 6 * MiB;
constexpr size_t W_GU = WS_W + 0, W_D = WS_W + 64 * MiB, W_SD = WS_W + 96 * MiB  , W_RHI = WS_W + 96 * MiB + 512 * 1024, W_RLO = W_RHI + 128 * 1024,
                 W_SGU = WS_W + 97 * MiB, W_IN = WS_W + 99 * MiB, W_OUT = WS_W + 106 * MiB,
                 W_UQ = WS_W + 108 * MiB, W_UKV = WS_W + 108 * MiB + 512 * 1024;
constexpr size_t WS_XB = 116 * MiB;
constexpr size_t WS_BIG = 180 * MiB;
constexpr size_t B_UPRE = WS_BIG, B_QL = WS_BIG + 32 * MiB, B_KVL = WS_BIG + 48 * MiB, B_Q0 = WS_BIG + 64 * MiB, B_K0 = WS_BIG + 112 * MiB,
                 B_V0 = WS_BIG + 160 * MiB, B_UO = WS_BIG + 192 * MiB;
constexpr size_t B_Q1 = WS_BIG, B_K1 = WS_BIG + 64 * MiB, B_V1 = WS_BIG + 128 * MiB, B_O1 = WS_BIG + 192 * MiB, B_GL = WS_BIG + 256 * MiB, B_CK = WS_BIG + 258 * MiB;
constexpr size_t B_H = WS_BIG, B_SH = WS_BIG + 104 * MiB, B_YT = WS_BIG + 120 * MiB, B_LIST = WS_BIG + 344 * MiB, B_LISTW = WS_BIG + 352 * MiB;
constexpr size_t WS_END = WS_BIG + 360 * MiB;
constexpr float YSCALE = 32.0f;

struct KArgs { const void* in[42]; float* out; unsigned char* ws; };
struct Args {
    LAS unsigned long long* tab; float* out; unsigned char* ws;
    __device__ __forceinline__ const void* in(int k) const { const unsigned long long v = tab[k]; const unsigned lo = __builtin_amdgcn_readfirstlane((unsigned)v), hi = __builtin_amdgcn_readfirstlane((unsigned)(v >> 32)); return (const void*)(const __attribute__((address_space(1))) char*)(((unsigned long long)hi << 32) | lo); }
};

DI unsigned pk2(float lo, float hi) { f32x2_t v = {lo, hi}; bf16x2_t b = __builtin_convertvector(v, bf16x2_t); return __builtin_bit_cast(unsigned, b); }
DI float bf2f(unsigned short b) { return __uint_as_float(((unsigned)b) << 16); }
DI unsigned short f2bf(float f) { return (unsigned short)(pk2(f, 0.f) & 0xffffu); }
DI float sigmoidf_(float x) { return 1.0f / (1.0f + __expf(-x)); }
DI float siluf_(float x) { return x * sigmoidf_(x); }
DI float wave_sum(float v) {
#pragma unroll
    for (int o = 1; o < 64; o <<= 1) v += __shfl_xor(v, o);
    return v;
}
DI int crow(int r, int hi) { return (r & 3) + 8 * (r >> 2) + 4 * hi; }
DI f32x16 mfma32(bf16x8 a, bf16x8 b, f32x16 c) { return __builtin_amdgcn_mfma_f32_32x32x16_bf16(a, b, c, 0, 0, 0); }
DI f32x4 mfma16(bf16x8 a, bf16x8 b, f32x4 c) { return __builtin_amdgcn_mfma_f32_16x16x32_bf16(a, b, c, 0, 0, 0); }
DI u32x2 pk4(f32x4 v) { u32x2 r; r.x = pk2(v[0], v[1]); r.y = pk2(v[2], v[3]); return r; }

DI int map_ident(int n) { return n; }
DI int map_gu(int n) { const int tile = n >> 8, w = n & 255, half = w >> 7, idx = tile * 128 + (w & 127); return idx | (half << 20); }
DI int map_in0(int n) {
    const int tile = n >> 8, w = n & 255;
    if (tile < 4) { const int half = w >> 7, idx = tile * 128 + (w & 127); return half * 512 + idx; }
    if (tile == 4) return 1024 + w;
    if (w < 128) return 1280 + w;
    if (w < 160) { const int i = w - 128; return 1408 + (i & 1) * 16 + (i >> 1); }
    return -1;
}
DI int map_q(int n) { const int h = n / 96, d = n % 96; if (d < 64) return h * 96 + d; const int i = d - 64; return h * 96 + 64 + (i & 1) * 16 + (i >> 1); }
DI int map_kv(int n) {
    if (n < 768) { const int h = n / 96, d = n % 96; if (d < 64) return h * 128 + d; return -2 - (128 + d - 64); }
    const int m = n - 768; return (m >> 6) * 128 + 64 + (m & 63);
}
DI int map_in1(int n) { return n < 3088 ? n : -1; }

template <class MapF>
DI void prep_item(const float* W0, const float* W1, int ldw, int Ksrc, const float* gk, bf16_t* WT, int Kout, int Nout, MapF map, LAS float*, int item, int lane) {
    const int nblk = Nout / 64, kb = item / nblk, nb = item % nblk, k0 = 64 * kb, n = nb * 64 + lane;
    const int sc = map(n);
    const float* W = (sc >= 0 && (sc >> 20)) ? W1 : W0; const int col = sc & 0xFFFFF;
#pragma unroll
    for (int hs = 0; hs < 2; ++hs) {
        float v[32];
#pragma unroll
        for (int i = 0; i < 32; ++i) { const int k = k0 + 32 * hs + i; float x = 0.f;
            if (sc >= 0) { if (k < Ksrc) { x = W[(size_t)k * ldw + col]; if (gk) x *= gk[k]; } }
            else if (sc <= -2) x = (k == -2 - sc) ? 1.f : 0.f;
            v[i] = x; }
#pragma unroll
        for (int j = 0; j < 4; ++j) { u32x4 o; o.x = pk2(v[8 * j], v[8 * j + 1]); o.y = pk2(v[8 * j + 2], v[8 * j + 3]); o.z = pk2(v[8 * j + 4], v[8 * j + 5]); o.w = pk2(v[8 * j + 6], v[8 * j + 7]);
            *(u32x4*)(WT + (size_t)n * Kout + k0 + 32 * hs + 8 * j) = o; }
    }
}

DI void prep_moe(const Args& a, int ib, LAS float* scr, int gw, int ngw, int lane, int gtid, int gthreads) {
    unsigned char* ws = a.ws;
    constexpr int I_GU = (1024 / 64) * (512 / 64), I_D = (256 / 64) * (1024 / 64);
    const int NIT = NEXP * (I_GU + I_D) + I_GU + I_D;
    for (int it = gw; it < NIT; it += ngw) {
        int r = it;
        if (r < NEXP * I_GU) { const int e = r / I_GU; r %= I_GU;
            prep_item((const float*)a.in(ib + 2) + (size_t)e * 1024 * 256, (const float*)a.in(ib + 3) + (size_t)e * 1024 * 256, 256, 1024, nullptr, (bf16_t*)(ws + W_GU) + (size_t)e * 512 * 1024, 1024, 512, map_gu, scr, r, lane); continue; }
        r -= NEXP * I_GU;
        if (r < NEXP * I_D) { const int e = r / I_D; r %= I_D;
            prep_item((const float*)a.in(ib + 4) + (size_t)e * 256 * 1024, nullptr, 1024, 256, nullptr, (bf16_t*)(ws + W_D) + (size_t)e * 1024 * 256, 256, 1024, map_ident, scr, r, lane); continue; }
        r -= NEXP * I_D;
        if (r < I_GU) { prep_item((const float*)a.in(ib + 5), (const float*)a.in(ib + 6), 256, 1024, nullptr, (bf16_t*)(ws + W_SGU), 1024, 512, map_gu, scr, r, lane); continue; }
        r -= I_GU;
        prep_item((const float*)a.in(ib + 7), nullptr, 1024, 256, nullptr, (bf16_t*)(ws + W_SD), 256, 1024, map_ident, scr, r, lane);
    }
    const float* rw = (const float*)a.in(ib);
    bf16_t* rhi = (bf16_t*)(ws + W_RHI); bf16_t* rlo = (bf16_t*)(ws + W_RLO);
    for (int idx = gtid; idx < 64 * 1024; idx += gthreads) { const int n = idx >> 10, k = idx & 1023; const float v = rw[k * 64 + n]; const unsigned short h = f2bf(v); rhi[idx] = h; rlo[idx] = f2bf(v - bf2f(h)); }
}

constexpr int SG_LDS = 49152;
namespace pg8 {
constexpr int BM = 256, BK = 64, HALF = 128, HTB = HALF * BK * 2, STAGE_BYTES = 8 * HTB, NXCD = 8, WGM = 8;
DI int lds_byte(int r, int c) { const int st = (r >> 4) * 2 + (c >> 5), rr = r & 15, cc = c & 31, ob = rr * 64 + cc * 2; return st * 1024 + (ob ^ (((ob >> 9) & 1) << 5)); }
DI void stage_rc(int b, int& R, int& C) { const int st = b / 1024, sb = b % 1024, swz = sb ^ (((sb >> 9) & 1) << 5); R = (st >> 1) * 16 + swz / 64; C = (st & 1) * 32 + (swz % 64) / 2; }
DI int perm32(int rho) { const int n = rho >> 4, i = rho & 15; return 8 * (i >> 2) + 4 * n + (i & 3); }
struct Unit { int pm, pn, e; };

struct DenseOrder {
    int nM, nN, nwg, G, c; const char* Bt; size_t tstepB;
    DI void init(int M, int N, int K, const bf16_t* Bt_, int G_, int c_) { nM = M / BM; nN = N / BM; nwg = nM * nN; G = G_; c = c_; Bt = (const char*)Bt_; tstepB = (size_t)BM * K * 2; }
    DI bool next(int i, Unit& u) const {
        const long L = (long)i * G + c; if (L >= nwg) return false;
        int wgid = (int)L; { const int q = nwg / NXCD, r = nwg % NXCD, xcd = wgid % NXCD, off = wgid / NXCD; wgid = (xcd < r ? xcd * (q + 1) : r * (q + 1) + (xcd - r) * q) + off; }
        const int nig = WGM * nN, gid = wgid / nig, fm = gid * WGM, gsz = (nM - fm) < WGM ? (nM - fm) : WGM;
        u.pm = fm + ((wgid % nig) % gsz); u.pn = (wgid % nig) / gsz; u.e = 0; return true;
    }
    DI const char* bptr(const Unit& u) const { return Bt + (size_t)u.pn * tstepB; }
    static constexpr bool GATHER_A = false;
    DI const int* lptr(const Unit&) const { return nullptr; }
    DI int lcnt(const Unit&) const { return 0; }
    DI unsigned arow0(const Unit& u) const { return (unsigned)(u.pm * BM); }
    DI unsigned arow(const Unit& u, int rt) const { return (unsigned)(u.pm * BM + rt); }
};
DI int find_expert(const LAS int* tstart, int tile) { int e = 0;
#pragma unroll
    for (int s = 32; s > 0; s >>= 1) if (tstart[e + s] <= tile) e += s;
    return e; }
template <bool GATHER> struct GroupedOrder {
    const LAS int* tstart; const LAS int* cntl; int NT, G, c; const char* Bt; size_t estepB, tstepB; const int* LIST; int nshared  ;
    DI bool next(int i, Unit& u) const {
        const int vc = (G % NXCD == 0) ? (c % NXCD) * (G / NXCD) + c / NXCD : c;
        const int L = i * G + vc; if (L >= (tstart[NEXP] + nshared) * NT) return false;
        const int tile = L / NT; u.pn = L - tile * NT;
        if (tile >= tstart[NEXP]) { u.e = NEXP; u.pm = tile - tstart[NEXP]; } else { u.e = find_expert(tstart, tile); u.pm = tile - tstart[u.e]; }
        return true;
    }
    DI const char* bptr(const Unit& u) const { return Bt + (size_t)u.e * estepB + (size_t)u.pn * tstepB; }
    static constexpr bool GATHER_A = GATHER;
    DI const int* lptr(const Unit& u) const { return LIST + (size_t)u.e * LISTCAP + u.pm * BM; }
    DI int lcnt(const Unit& u) const { return cntl[u.e] - u.pm * BM; }
    DI unsigned arow0(const Unit& u) const { return u.e == NEXP ? (unsigned)(HROWS + u.pm * BM) : (unsigned)((tstart[u.e] + u.pm) * BM); }
    DI unsigned arow(const Unit& u, int rt) const {
        if (GATHER) { int i = u.pm * BM + rt; i = i < cntl[u.e] ? i : u.pm * BM; return (unsigned)(LIST[(size_t)u.e * LISTCAP + i] >> 3); }
        return arow0(u) + (unsigned)rt;
    }
};
struct NoMeta {};
struct NoCtx {};
template <int RPF, class CF, class F> struct EpiFn {
    CF cf; F f;
    typedef NoMeta Meta;
    DI Meta prefetch(const Unit&, int, int) const { return Meta{}; }
    DI void operator()(const f32x4 (&acc)[2][2][4][2], const Unit& u, int wr, int wc, int fr, int fq, const Meta&) const {
        const int c = wc * 32 + 8 * fq;
        const auto ctx = cf(u, c);
#pragma unroll
        for (int ai = 0; ai < 2; ++ai)
#pragma unroll
            for (int m = 0; m < 4; ++m) { int r_ = ai * HALF + wr * 64 + m * 16 + fr; asm volatile("" : "+v"(r_));
                f(ctx, u, r_, c, acc[ai][0][m][0], acc[ai][0][m][1], acc[ai][1][m][0], acc[ai][1][m][1]);
                if (((ai * 4 + m) % RPF) == RPF - 1) asm volatile("" ::: "memory"); }
    }
};
template <int RPF, class CF, class F> DI EpiFn<RPF, CF, F> make_epi(const CF& cf, const F& f) { return EpiFn<RPF, CF, F>{cf, f}; }
struct Bias4 { f32x4 b[4]; };
DI Bias4 load_bias4(const float* bias, int col) { Bias4 r; r.b[0] = *(const f32x4*)(bias + col); r.b[1] = *(const f32x4*)(bias + col + 4); r.b[2] = *(const f32x4*)(bias + col + 128); r.b[3] = *(const f32x4*)(bias + col + 132); return r; }

template <class Epi, class Sched>
DI void gemm_phase(LAS unsigned char* lds, const bf16_t* Abase, const int K, const Sched& S, const Epi& E) {
    int tid_ = threadIdx.x; asm volatile("" : "+v"(tid_));
    const int tid = tid_, wid = __builtin_amdgcn_readfirstlane(tid >> 6), lane = tid & 63, wr = wid >> 2, wc = wid & 3, fr = lane & 15, fq = lane >> 4;
    const int nt = K / BK;
    unsigned voffB[2];
#pragma unroll
    for (int i = 0; i < 2; ++i) { int R_, C_; stage_rc(tid * 16 + i * 8192, R_, C_); const int Rb = (R_ & ~31) + perm32(R_ & 31); voffB[i] = (unsigned)(Rb * K + C_) * 2u; }
    const size_t kstep = (size_t)(BK * 2);
    const size_t hstep = (size_t)HALF * K * 2;
    const unsigned ldsw = (unsigned)wid * 1024u;
    const int aoff = lds_byte(wr * 64 + fr, fq * 8), boff = lds_byte(wc * 32 + fr, fq * 8);
#define PG8_SA(b, h) (((b) * 2 + (h)) * HTB)
#define PG8_SB(b, h) ((4 + (b) * 2 + (h)) * HTB)
#define PG8_STAGE(bufoff, gbase, voff) do { _Pragma("unroll") for (int _i = 0; _i < 2; ++_i) \
        __builtin_amdgcn_global_load_lds((const unsigned*)((const char*)(gbase) + (voff)[_i]), (LAS unsigned*)(lds + (bufoff) + ldsw + _i * 8192), 16, 0, 0); } while (0)
#define PG8_LDA(dst, b, h) do { _Pragma("unroll") for (int m = 0; m < 4; ++m) _Pragma("unroll") for (int k = 0; k < 2; ++k) dst[m][k] = *(const LAS bf16x8*)(lds + PG8_SA(b, h) + aoff + m * 2048 + k * 1024); } while (0)
#define PG8_LDB(dst, b, h) do { _Pragma("unroll") for (int n = 0; n < 2; ++n) _Pragma("unroll") for (int k = 0; k < 2; ++k) dst[n][k] = *(const LAS bf16x8*)(lds + PG8_SB(b, h) + boff + n * 2048 + k * 1024); } while (0)
#define PG8_MMA(ai, bj, At, Bt) do { __builtin_amdgcn_s_setprio(1); _Pragma("unroll") for (int m = 0; m < 4; ++m) _Pragma("unroll") for (int n = 0; n < 2; ++n) _Pragma("unroll") for (int k = 0; k < 2; ++k) \
        acc[ai][bj][m][n] = __builtin_amdgcn_mfma_f32_16x16x32_bf16(Bt[n][k], At[m][k], acc[ai][bj][m][n], 0, 0, 0); __builtin_amdgcn_s_setprio(0); } while (0)
#define PG8_WAIT_V(n) asm volatile("s_waitcnt vmcnt(" #n ")" ::: "memory")
#define PG8_WAIT_L(n) asm volatile("s_waitcnt lgkmcnt(" #n ")" ::: "memory")
#define PG8_BAR __builtin_amdgcn_s_barrier()
#define PG8_SCHED __builtin_amdgcn_sched_barrier(0)
#define PG8_AOFFS(dst, u) do { _Pragma("unroll") for (int _i = 0; _i < 2; ++_i) { int R_, C_; stage_rc(tid * 16 + _i * 8192, R_, C_); _Pragma("unroll") for (int _h = 0; _h < 2; ++_h) dst[_h][_i] = (S.arow(u, _h * HALF + R_) * (unsigned)K + (unsigned)C_) * 2u; } } while (0)
    Unit cur, nxt; int ui = 0;
    if (!S.next(0, cur)) return;
#ifndef GEMM_SKEW_TICKS
#define GEMM_SKEW_TICKS 0
#endif
    if (GEMM_SKEW_TICKS > 0) {
        const unsigned long long t0_ = __builtin_amdgcn_s_memrealtime(), dl_ = (unsigned long long)(blockIdx.x % NXCD) * GEMM_SKEW_TICKS;
        while (__builtin_amdgcn_s_memrealtime() - t0_ < dl_) __builtin_amdgcn_s_sleep(4);
    }
    f32x4 acc[2][2][4][2];
#pragma unroll
    for (int a = 0; a < 2; ++a)
#pragma unroll
        for (int b = 0; b < 2; ++b)
#pragma unroll
            for (int m = 0; m < 4; ++m)
#pragma unroll
                for (int n = 0; n < 2; ++n) acc[a][b][m][n] = (f32x4){0.f, 0.f, 0.f, 0.f};
    bf16x8 At[4][2], B0[2][2], B1[2][2];
    constexpr bool GA = Sched::GATHER_A;
    unsigned vcur[2][2], vnxt[2][2];
    const char* const Ab = (const char*)Abase;
    const char* cA = Ab;
    if constexpr (GA) { PG8_AOFFS(vcur, cur); }
    else {
#pragma unroll
        for (int i = 0; i < 2; ++i) { int R_, C_; stage_rc(tid * 16 + i * 8192, R_, C_); vcur[0][i] = (unsigned)(R_ * K + C_) * 2u; vcur[1][i] = vcur[0][i]; }
        cA = Ab + (size_t)S.arow0(cur) * K * 2;
    }
    const size_t ah = GA ? (size_t)0 : hstep;
    const char* cB = S.bptr(cur);
    typename Epi::Meta meta = E.prefetch(cur, wr, fr);
    PG8_STAGE(PG8_SB(0, 0), cB, voffB); PG8_STAGE(PG8_SB(0, 1), cB + hstep, voffB); PG8_STAGE(PG8_SA(0, 0), cA, vcur[0]); PG8_STAGE(PG8_SA(0, 1), cA + ah, vcur[1]);
    if (wr == 1) PG8_BAR;
    PG8_WAIT_V(2); PG8_BAR;
    PG8_STAGE(PG8_SB(1, 0), cB + kstep, voffB); PG8_STAGE(PG8_SA(1, 0), cA + kstep, vcur[0]); PG8_STAGE(PG8_SB(1, 1), cB + hstep + kstep, voffB);
    PG8_WAIT_V(6); PG8_BAR;
    for (;;) {
        const bool has_next = S.next(ui + 1, nxt);
        const char* nB = cB; const char* nA = cA;
        if (has_next) { nB = S.bptr(nxt);
            if constexpr (GA) {
                const int* lp_ = S.lptr(nxt); const int cn_ = S.lcnt(nxt);
#pragma unroll
                for (int i = 0; i < 2; ++i) { int R_, C_; stage_rc(tid * 16 + i * 8192, R_, C_);
#pragma unroll
                    for (int h = 0; h < 2; ++h) { int rt_ = h * HALF + R_; rt_ = rt_ < cn_ ? rt_ : 0; const int* p_ = lp_ + rt_; asm volatile("global_load_dword %0, %1, off" : "=v"(vnxt[h][i]) : "v"(p_) : "memory"); } }
            } else nA = Ab + (size_t)S.arow0(nxt) * K * 2; }
        else if constexpr (GA) {
#pragma unroll
            for (int h = 0; h < 2; ++h)
#pragma unroll
                for (int i = 0; i < 2; ++i) vnxt[h][i] = vcur[h][i];
        }
#pragma unroll 1
        for (int t = 0; t < nt; t += 2) {
            const bool last = (t == nt - 2);
            const char* a1 = cA + (size_t)(t + 1) * kstep;
            const char* a2 = last ? nA : cA + (size_t)(t + 2) * kstep; const char* b2 = last ? nB : cB + (size_t)(t + 2) * kstep;
            const char* a3 = a2 + kstep; const char* b3 = b2 + kstep;
            if constexpr (GA) { if (last && has_next) {
                asm volatile("" : "+v"(vnxt[0][0]), "+v"(vnxt[0][1]), "+v"(vnxt[1][0]), "+v"(vnxt[1][1]));
#pragma unroll
                for (int i = 0; i < 2; ++i) { int R_, C_; stage_rc(tid * 16 + i * 8192, R_, C_);
#pragma unroll
                    for (int h = 0; h < 2; ++h) vnxt[h][i] = ((vnxt[h][i] >> 3) * (unsigned)K + (unsigned)C_) * 2u; } } }
            unsigned v2[2][2];
#pragma unroll
            for (int h = 0; h < 2; ++h)
#pragma unroll
                for (int i = 0; i < 2; ++i) v2[h][i] = (GA && last) ? vnxt[h][i] : vcur[h][i];
            PG8_LDB(B0, 0, 0); PG8_LDB(B1, 0, 1); PG8_SCHED; PG8_LDA(At, 0, 0); PG8_STAGE(PG8_SA(1, 1), a1 + ah, vcur[1]);
            PG8_WAIT_V(8); PG8_WAIT_L(0); PG8_BAR; PG8_MMA(0, 0, At, B0); PG8_MMA(0, 1, At, B1); PG8_BAR; PG8_SCHED;
            PG8_LDA(At, 0, 1); PG8_STAGE(PG8_SB(0, 0), b2, voffB); PG8_STAGE(PG8_SB(0, 1), b2 + hstep, voffB); PG8_STAGE(PG8_SA(0, 0), a2, v2[0]);
            PG8_WAIT_V(8); PG8_WAIT_L(0); PG8_BAR; PG8_MMA(1, 0, At, B0); PG8_MMA(1, 1, At, B1); PG8_BAR; PG8_SCHED;
            PG8_LDB(B0, 1, 0); PG8_LDB(B1, 1, 1); PG8_SCHED; PG8_LDA(At, 1, 0); PG8_STAGE(PG8_SA(0, 1), a2 + ah, v2[1]);
            PG8_WAIT_V(8); PG8_WAIT_L(0); PG8_BAR; PG8_MMA(0, 0, At, B0); PG8_MMA(0, 1, At, B1); PG8_BAR; PG8_SCHED;
            PG8_LDA(At, 1, 1); PG8_STAGE(PG8_SB(1, 0), b3, voffB); PG8_STAGE(PG8_SB(1, 1), b3 + hstep, voffB); PG8_STAGE(PG8_SA(1, 0), a3, v2[0]);
            PG8_WAIT_V(8); PG8_WAIT_L(0); PG8_BAR; PG8_MMA(1, 0, At, B0); PG8_MMA(1, 1, At, B1); PG8_BAR; PG8_SCHED;
        }
        if (wr == 0) PG8_BAR;
        { int fr_ = fr, fq_ = fq; asm volatile("" : "+v"(fr_), "+v"(fq_));
          E(acc, cur, wr, wc, fr_, fq_, meta); }
        if (!has_next) break;
#pragma unroll
        for (int a = 0; a < 2; ++a)
#pragma unroll
            for (int b = 0; b < 2; ++b)
#pragma unroll
                for (int m = 0; m < 4; ++m)
#pragma unroll
                    for (int n = 0; n < 2; ++n) acc[a][b][m][n] = (f32x4){0.f, 0.f, 0.f, 0.f};
        cur = nxt; cB = nB; cA = nA; ++ui;
        meta = E.prefetch(cur, wr, fr);
        if constexpr (GA) {
#pragma unroll
            for (int h = 0; h < 2; ++h)
#pragma unroll
                for (int i = 0; i < 2; ++i) vcur[h][i] = vnxt[h][i];
        }
        if (wr == 1) PG8_BAR;
    }
    PG8_WAIT_V(0);
    PG8_BAR;
#undef PG8_SA
#undef PG8_SB
#undef PG8_STAGE
#undef PG8_LDA
#undef PG8_LDB
#undef PG8_MMA
#undef PG8_WAIT_V
#undef PG8_WAIT_L
#undef PG8_BAR
#undef PG8_SCHED
#undef PG8_AOFFS
}
}
DI u32x4 pk8(f32x4 a, f32x4 b) { u32x4 o; o.x = pk2(a[0], a[1]); o.y = pk2(a[2], a[3]); o.z = pk2(b[0], b[1]); o.w = pk2(b[2], b[3]); return o; }
struct EpiDown {
    const LAS int* cntl; const int* LIST; const float* LISTW; unsigned char* YT;
    struct Meta { int raw[2][4]; float w[2][4]; unsigned ok; };
    DI Meta prefetch(const pg8::Unit& u, int wr, int fr) const {
        Meta m; m.ok = 0u;
        if (u.e == NEXP) {
#pragma unroll
            for (int ai = 0; ai < 2; ++ai)
#pragma unroll
                for (int mm = 0; mm < 4; ++mm) { const int i = u.pm * 256 + ai * 128 + wr * 64 + mm * 16 + fr; m.raw[ai][mm] = (i << 3) | 6; m.w[ai][mm] = 1.0f; }
            m.ok = 0xffu;
        } else {
            const int cn = cntl[u.e] - u.pm * 256; const size_t base = (size_t)u.e * LISTCAP + u.pm * 256;
#pragma unroll
            for (int ai = 0; ai < 2; ++ai)
#pragma unroll
                for (int mm = 0; mm < 4; ++mm) { const int rt = ai * 128 + wr * 64 + mm * 16 + fr; const bool ok = rt < cn; m.ok |= ok ? (1u << (ai * 4 + mm)) : 0u;
                    const int* p1 = LIST + base + (ok ? rt : 0); const float* p2 = LISTW + base + (ok ? rt : 0);
                    asm volatile("global_load_dword %0, %1, off" : "=v"(m.raw[ai][mm]) : "v"(p1) : "memory");
                    asm volatile("global_load_dword %0, %1, off" : "=v"(m.w[ai][mm]) : "v"(p2) : "memory"); }
        }
        return m;
    }
    DI void operator()(const f32x4 (&acc)[2][2][4][2], const pg8::Unit& u, int wr, int wc, int fr, int fq, const Meta& m0) const {
        Meta m = m0;
        asm volatile("" : "+v"(m.raw[0][0]), "+v"(m.raw[0][1]), "+v"(m.raw[0][2]), "+v"(m.raw[0][3]), "+v"(m.raw[1][0]), "+v"(m.raw[1][1]), "+v"(m.raw[1][2]), "+v"(m.raw[1][3]));
        asm volatile("" : "+v"(m.w[0][0]), "+v"(m.w[0][1]), "+v"(m.w[0][2]), "+v"(m.w[0][3]), "+v"(m.w[1][0]), "+v"(m.w[1][1]), "+v"(m.w[1][2]), "+v"(m.w[1][3]));
#pragma unroll
        for (int ai = 0; ai < 2; ++ai)
#pragma unroll
            for (int mm = 0; mm < 4; ++mm) { const int v = m.raw[ai][mm]; const float w = m.w[ai][mm] * YSCALE;
                if ((m.ok >> (ai * 4 + mm)) & 1u) { unsigned char* p = YT + (size_t)((v >> 3) * 7 + (v & 7)) * 1024 + u.pn * 256 + wc * 32 + 8 * fq;
#pragma unroll
                    for (int bj = 0; bj < 2; ++bj) { const f32x4 a0 = acc[ai][bj][mm][0] * w, a1 = acc[ai][bj][mm][1] * w; u32x2 o;
                        int t = __builtin_amdgcn_cvt_pk_fp8_f32(a0[0], a0[1], 0, false); t = __builtin_amdgcn_cvt_pk_fp8_f32(a0[2], a0[3], t, true); o.x = (unsigned)t;
                        t = __builtin_amdgcn_cvt_pk_fp8_f32(a1[0], a1[1], 0, false); t = __builtin_amdgcn_cvt_pk_fp8_f32(a1[2], a1[3], t, true); o.y = (unsigned)t;
                        *(u32x2*)(p + 128 * bj) = o; } } }
    }
};
DI float dot4(f32x4 a) { return (a[0] * a[0] + a[1] * a[1]) + (a[2] * a[2] + a[3] * a[3]); }
DI void rope8(f32x4& v0, f32x4& v1, const float* ct, const float* st, size_t row, int p) {
    const f32x4 cs = *(const f32x4*)(ct + row * 16 + p), sn = *(const f32x4*)(st + row * 16 + p);
    float a, b;
    a = v0[0]; b = v0[1]; v0[0] = a * cs[0] - b * sn[0]; v0[1] = b * cs[0] + a * sn[0];
    a = v0[2]; b = v0[3]; v0[2] = a * cs[1] - b * sn[1]; v0[3] = b * cs[1] + a * sn[1];
    a = v1[0]; b = v1[1]; v1[0] = a * cs[2] - b * sn[2]; v1[1] = b * cs[2] + a * sn[2];
    a = v1[2]; b = v1[3]; v1[2] = a * cs[3] - b * sn[3]; v1[3] = b * cs[3] + a * sn[3];
}

struct EpiIn1 {
    const float* bias; bf16_t* Q1; bf16_t* K1; bf16_t* V1; float* GL; unsigned* NRM;
    typedef pg8::NoMeta Meta;
    DI Meta prefetch(const pg8::Unit&, int, int) const { return Meta{}; }
    DI void operator()(const f32x4 (&acc)[2][2][4][2], const pg8::Unit& u, int wr, int wc, int fr, int fq, const Meta&) const {
        const int nt = u.pn, c = wc * 32 + 8 * fq;
        const pg8::Bias4 bb = pg8::load_bias4(bias, nt * 256 + c);
        float mx0 = 0.f, mx1 = 0.f;
#pragma unroll
        for (int ai = 0; ai < 2; ++ai)
#pragma unroll
            for (int m = 0; m < 4; ++m) { int r_ = ai * 128 + wr * 64 + m * 16 + fr; asm volatile("" : "+v"(r_));
                const size_t row = (size_t)u.pm * 256 + r_;
                f32x4 l0 = acc[ai][0][m][0] + bb.b[0], l1 = acc[ai][0][m][1] + bb.b[1], h0 = acc[ai][1][m][0] + bb.b[2], h1 = acc[ai][1][m][1] + bb.b[3];
                if (nt < 4) { l0 = l0 * C2_FOX; l1 = l1 * C2_FOX; h0 = h0 * C2_FOX; h1 = h1 * C2_FOX;
                    *(u32x4*)(Q1 + row * 1024 + nt * 256 + c) = pk8(l0, l1); *(u32x4*)(Q1 + row * 1024 + nt * 256 + 128 + c) = pk8(h0, h1); }
                else if (nt < 8) { *(u32x4*)(K1 + row * 1024 + (nt - 4) * 256 + c) = pk8(l0, l1); *(u32x4*)(K1 + row * 1024 + (nt - 4) * 256 + 128 + c) = pk8(h0, h1); }
                else if (nt < 12) { *(u32x4*)(V1 + row * 1024 + (nt - 8) * 256 + c) = pk8(l0, l1); *(u32x4*)(V1 + row * 1024 + (nt - 8) * 256 + 128 + c) = pk8(h0, h1); }
                else if (c < 16) {
#pragma unroll
                    for (int i = 0; i < 4; ++i) { float x = l0[i]; l0[i] = fminf(x, 0.f) - log1pf(__expf(-fabsf(x))); x = l1[i]; l1[i] = fminf(x, 0.f) - log1pf(__expf(-fabsf(x))); }
                    *(f32x4*)(GL + row * 16 + c) = l0; *(f32x4*)(GL + row * 16 + c + 4) = l1; }
                if (nt < 8) { float s0 = dot4(l0) + dot4(l1), s1 = dot4(h0) + dot4(h1);
                    s0 += __shfl_xor(s0, 16); s0 += __shfl_xor(s0, 32); s1 += __shfl_xor(s1, 16); s1 += __shfl_xor(s1, 32);
                    mx0 = fmaxf(mx0, s0); mx1 = fmaxf(mx1, s1); }
                asm volatile("" ::: "memory"); }
        if (nt < 8) {
#pragma unroll
            for (int o = 1; o < 16; o <<= 1) { mx0 = fmaxf(mx0, __shfl_xor(mx0, o)); mx1 = fmaxf(mx1, __shfl_xor(mx1, o)); }
            if (fr == 0 && fq == 0) { const int b = u.pm >> 4, which = nt >> 2, head0 = (nt & 3) * 4 + (wc >> 1), half = wc & 1;
                atomicMax(NRM + ((which * 8 + b) * 16 + head0) * 2 + half, __float_as_uint(mx0)); atomicMax(NRM + ((which * 8 + b) * 16 + head0 + 2) * 2 + half, __float_as_uint(mx1)); }
        }
    }
};

template <int DK, int QP, int KP, int VP, int OP, bool BIAS>
DI void attn_simple_unit(LAS unsigned char* lds, const bf16_t* Q, const bf16_t* K, const bf16_t* V, bf16_t* O, const float* CK, int b, int hq, int hv, int hc, int ho, int qb) {
    constexpr int KS = DK + 8, VS = 72;
    LAS bf16_t* Ks = (LAS bf16_t*)lds;
    LAS bf16_t* VT = (LAS bf16_t*)(lds + 64 * KS * 2);
    LAS float* ckl = (LAS float*)(lds + 64 * KS * 2 + 64 * VS * 2);
    int tid_ = threadIdx.x; asm volatile("" : "+v"(tid_));
    const int tid = tid_, lane = tid & 63, wid = tid >> 6, r32 = lane & 31, hi = lane >> 5;
    const size_t rowbase = (size_t)b * SEQ; const int q0 = qb * 256, qw = q0 + 32 * wid;
    bf16x8 qr[DK / 16];
#pragma unroll
    for (int d0 = 0; d0 < DK / 16; ++d0) qr[d0] = *(const bf16x8*)(Q + (rowbase + qw + r32) * QP + hq + 16 * d0 + 8 * hi);
    f32x16 o0, o1;
#pragma unroll
    for (int i = 0; i < 16; ++i) { o0[i] = 0.f; o1[i] = 0.f; }
    float m = -INFINITY, l = 0.f;
    const int ntile = (q0 + 256) / 64;
    for (int jt = 0; jt < ntile; ++jt) {
        const int kv0 = jt * 64;
        __syncthreads();
        for (int c = tid; c < 64 * (DK / 8); c += 512) { const int r = c / (DK / 8), ch = c % (DK / 8);
            const u32x4 v = *(const u32x4*)(K + (rowbase + kv0 + r) * KP + hq + ch * 8); *(LAS u32x4*)(Ks + r * KS + ch * 8) = v; }
        { const int r = tid >> 3, ch = tid & 7; const u32x4 v = *(const u32x4*)(V + (rowbase + kv0 + r) * VP + hv + ch * 8);
#pragma unroll
          for (int i = 0; i < 4; ++i) { VT[(ch * 8 + 2 * i) * VS + r] = (bf16_t)(v[i] & 0xffffu); VT[(ch * 8 + 2 * i + 1) * VS + r] = (bf16_t)(v[i] >> 16); } }
        if (BIAS) { if (tid < 64) ckl[tid] = CK[(rowbase + kv0 + tid) * 16 + hc]; }
        __syncthreads();
        if (kv0 <= qw + 31) {
            f32x16 p0, p1;
#pragma unroll
            for (int i = 0; i < 16; ++i) { p0[i] = 0.f; p1[i] = 0.f; }
#pragma unroll
            for (int d0 = 0; d0 < DK / 16; ++d0) {
                const bf16x8 a0 = *(LAS bf16x8*)(Ks + r32 * KS + 16 * d0 + 8 * hi), a1 = *(LAS bf16x8*)(Ks + (32 + r32) * KS + 16 * d0 + 8 * hi);
                p0 = mfma32(a0, qr[d0], p0); p1 = mfma32(a1, qr[d0], p1);
            }
            if (BIAS) {
#pragma unroll
                for (int i = 0; i < 16; ++i) { p0[i] -= ckl[crow(i, hi)]; p1[i] -= ckl[32 + crow(i, hi)]; }
            }
            if (kv0 + 63 > qw) { const int q = qw + r32;
#pragma unroll
                for (int i = 0; i < 16; ++i) { const int kv = kv0 + crow(i, hi); if (kv > q) p0[i] = -INFINITY; if (kv + 32 > q) p1[i] = -INFINITY; } }
            float rm = p0[0];
#pragma unroll
            for (int i = 0; i < 16; ++i) { rm = fmaxf(rm, p0[i]); rm = fmaxf(rm, p1[i]); }
            rm = fmaxf(rm, __shfl_xor(rm, 32));
            const float mn = fmaxf(m, rm); const float f = __builtin_amdgcn_exp2f(m - mn);
            float rs = 0.f;
#pragma unroll
            for (int i = 0; i < 16; ++i) { p0[i] = __builtin_amdgcn_exp2f(p0[i] - mn); p1[i] = __builtin_amdgcn_exp2f(p1[i] - mn); rs += p0[i] + p1[i]; }
            rs += __shfl_xor(rs, 32);
            l = l * f + rs; m = mn;
#pragma unroll
            for (int i = 0; i < 16; ++i) { const float fi = __shfl(f, crow(i, hi)); o0[i] *= fi; o1[i] *= fi; }
            bf16x8 pf[4];
            { u32x4 t;
              t.x = pk2(p0[0], p0[1]); t.y = pk2(p0[2], p0[3]); t.z = pk2(p0[4], p0[5]); t.w = pk2(p0[6], p0[7]); pf[0] = __builtin_bit_cast(bf16x8, t);
              t.x = pk2(p0[8], p0[9]); t.y = pk2(p0[10], p0[11]); t.z = pk2(p0[12], p0[13]); t.w = pk2(p0[14], p0[15]); pf[1] = __builtin_bit_cast(bf16x8, t);
              t.x = pk2(p1[0], p1[1]); t.y = pk2(p1[2], p1[3]); t.z = pk2(p1[4], p1[5]); t.w = pk2(p1[6], p1[7]); pf[2] = __builtin_bit_cast(bf16x8, t);
              t.x = pk2(p1[8], p1[9]); t.y = pk2(p1[10], p1[11]); t.z = pk2(p1[12], p1[13]); t.w = pk2(p1[14], p1[15]); pf[3] = __builtin_bit_cast(bf16x8, t); }
#pragma unroll
            for (int ks = 0; ks < 4; ++ks) {
                { const s16x4 lo = *(LAS s16x4*)(VT + r32 * VS + 16 * ks + 4 * hi), hh = *(LAS s16x4*)(VT + r32 * VS + 16 * ks + 8 + 4 * hi);
                  const bf16x8 vf = __builtin_shufflevector(lo, hh, 0, 1, 2, 3, 4, 5, 6, 7); o0 = mfma32(pf[ks], vf, o0); }
                { const s16x4 lo = *(LAS s16x4*)(VT + (32 + r32) * VS + 16 * ks + 4 * hi), hh = *(LAS s16x4*)(VT + (32 + r32) * VS + 16 * ks + 8 + 4 * hi);
                  const bf16x8 vf = __builtin_shufflevector(lo, hh, 0, 1, 2, 3, 4, 5, 6, 7); o1 = mfma32(pf[ks], vf, o1); }
            }
        }
    }
    const float inv = 1.0f / l;
#pragma unroll
    for (int i = 0; i < 16; ++i) { const float ii = __shfl(inv, crow(i, hi)); const size_t row = rowbase + qw + crow(i, hi);
        O[row * OP + ho + r32] = f2bf(o0[i] * ii); O[row * OP + ho + 32 + r32] = f2bf(o1[i] * ii); }
}

namespace attn_fox {
using bf16=unsigned short;
constexpr int BATCH=8,NHEAD=16,SEQ=4096,D=64,DM=NHEAD*D;
constexpr int NW=8,QBLK=32,QB=QBLK*NW,KVBLK=64,NQB=SEQ/QB;
constexpr int ATTN_PITCH=DM, ATTN_UNIT_ROWS=QB;
__device__ __forceinline__ int crow(int r,int hi){return (r&3)+8*(r>>2)+4*hi;}
#define SBAR() __builtin_amdgcn_sched_barrier(0)
__device__ __forceinline__ void cmask(f32x16&p0,f32x16&p1,int jb,int qrel,int hi){
  const float NEG=-INFINITY; int kb=64*jb+4*hi;
  #pragma unroll
  for(int r=0;r<16;++r){int kv=kb+(r&3)+8*(r>>2); if(kv>qrel)p0[r]=NEG; if(kv+32>qrel)p1[r]=NEG;}
}

constexpr int NSLOT=3, SLOTB=8192;
constexpr int LDS_K=0, LDS_V=NSLOT*SLOTB, LDS_WS=2*NSLOT*SLOTB, LDS_OST=LDS_WS+NW*64*4, LDS_CK=LDS_OST+NW*4096, LDS_BYTES=LDS_CK+SEQ*4;
constexpr float C2=0.125f*1.4426950408889634f;
__device__ __forceinline__ void glds16(const void*gsrc,unsigned lds_dst){unsigned keep;
  asm volatile("s_mov_b32 %0, m0\n\ts_mov_b32 m0, %2\n\ts_nop 0\n\tglobal_load_lds_dwordx4 %1, off\n\ts_mov_b32 m0, %0":"=&s"(keep):"v"(gsrc),"s"(lds_dst):"memory");}
__device__ __forceinline__ float max3f(float a,float b,float c){float r;asm("v_max3_f32 %0, %1, %2, %3":"=v"(r):"v"(a),"v"(b),"v"(c));return r;}
__device__ __forceinline__ float max2f(float a,float b){float r;asm("v_max_f32_e32 %0, %1, %2":"=v"(r):"v"(a),"v"(b));return r;}
__device__ __forceinline__ float fadd_s(float a,float b){float r;asm("v_add_f32_e32 %0, %1, %2":"=v"(r):"v"(a),"v"(b));return r;}
__device__ __forceinline__ float fsub_s(float a,float b){float r;asm("v_sub_f32_e32 %0, %1, %2":"=v"(r):"v"(a),"v"(b));return r;}
typedef float f32x2_t __attribute__((ext_vector_type(2))); typedef __bf16 bf16x2_t __attribute__((ext_vector_type(2)));
__device__ __forceinline__ unsigned cvtpk_s(float lo,float hi){f32x2_t v={lo,hi};bf16x2_t b=__builtin_convertvector(v,bf16x2_t);return __builtin_bit_cast(unsigned,b);}
#define WAIT_BAR(N) asm volatile("s_waitcnt vmcnt(" #N ") lgkmcnt(0)\n\ts_barrier":::"memory")

__device__ __forceinline__ void qkt(f32x16&p0,f32x16&p1,const char*Kslot,const bf16x8*qr,int r32,int hi){
  const char*kb=Kslot+hi*1024+r32*16;
  #pragma unroll
  for(int d0=0;d0<4;++d0){
    const bf16x8 b0=*reinterpret_cast<const bf16x8*>(kb+d0*2048);
    const bf16x8 b1=*reinterpret_cast<const bf16x8*>(kb+d0*2048+512);
    p0=__builtin_amdgcn_mfma_f32_32x32x16_bf16(b0,qr[d0],p0,0,0,0);p1=__builtin_amdgcn_mfma_f32_32x32x16_bf16(b1,qr[d0],p1,0,0,0);}
}
typedef __attribute__((address_space(3))) const char* lds_cptr;
typedef __attribute__((address_space(3))) const float* lds_fptr;
typedef short v4i16_t __attribute__((ext_vector_type(4)));
__device__ __forceinline__ void kload8(bf16x8*kf,lds_cptr kp){
  kf[0]=*(const __attribute__((address_space(3))) bf16x8*)(kp);      kf[1]=*(const __attribute__((address_space(3))) bf16x8*)(kp+512);
  kf[2]=*(const __attribute__((address_space(3))) bf16x8*)(kp+2048); kf[3]=*(const __attribute__((address_space(3))) bf16x8*)(kp+2560);
  kf[4]=*(const __attribute__((address_space(3))) bf16x8*)(kp+4096); kf[5]=*(const __attribute__((address_space(3))) bf16x8*)(kp+4608);
  kf[6]=*(const __attribute__((address_space(3))) bf16x8*)(kp+6144); kf[7]=*(const __attribute__((address_space(3))) bf16x8*)(kp+6656);
}
__device__ __forceinline__ void kload2(bf16x8*kf,lds_cptr kp,int j){ kf[2*j]=*(const __attribute__((address_space(3))) bf16x8*)(kp+j*2048); kf[2*j+1]=*(const __attribute__((address_space(3))) bf16x8*)(kp+j*2048+512); }
__device__ __forceinline__ s16x4 vtr(lds_cptr p){ return __builtin_bit_cast(s16x4,__builtin_amdgcn_ds_read_tr16_b64_v4i16((__attribute__((address_space(3))) v4i16_t*)p)); }
__device__ __forceinline__ float rowmax(const f32x16&p0,const f32x16&p1){
  float a=max3f(p0[0],p0[1],p1[0]),b=max3f(p0[2],p0[3],p1[1]);a=max3f(a,p1[2],p1[3]);
  #pragma unroll
  for(int r=4;r<16;r+=4){a=max3f(a,p0[r],p0[r+1]);b=max3f(b,p0[r+2],p0[r+3]);a=max3f(a,p1[r],p1[r+1]);b=max3f(b,p1[r+2],p1[r+3]);}
  const float m=max2f(a,b);
  auto rr=__builtin_amdgcn_permlane32_swap(__float_as_uint(m),__float_as_uint(m),false,false);
  return max2f(__uint_as_float(rr[0]),__uint_as_float(rr[1]));
}
__device__ __forceinline__ void pv(f32x16*o,int vb,bf16x8 pa0,bf16x8 pa1,bf16x8 pa2,bf16x8 pa3){
  #pragma unroll
  for(int d0=0;d0<2;++d0){s16x4 lo[4],hi[4];
    #pragma unroll
    for(int ks=0;ks<4;++ks){
      asm volatile("ds_read_b64_tr_b16 %0,%1 offset:%c2":"=&v"(lo[ks]):"v"(vb),"i"(d0*4096+ks*1024):"memory");
      asm volatile("ds_read_b64_tr_b16 %0,%1 offset:%c2":"=&v"(hi[ks]):"v"(vb),"i"(d0*4096+ks*1024+512):"memory");}
    asm volatile("s_waitcnt lgkmcnt(0)":::"memory");SBAR();
    #define PK(k) (bf16x8){lo[k][0],lo[k][1],lo[k][2],lo[k][3],hi[k][0],hi[k][1],hi[k][2],hi[k][3]}
    o[d0]=__builtin_amdgcn_mfma_f32_32x32x16_bf16(pa0,PK(0),o[d0],0,0,0);
    o[d0]=__builtin_amdgcn_mfma_f32_32x32x16_bf16(pa1,PK(1),o[d0],0,0,0);
    o[d0]=__builtin_amdgcn_mfma_f32_32x32x16_bf16(pa2,PK(2),o[d0],0,0,0);
    o[d0]=__builtin_amdgcn_mfma_f32_32x32x16_bf16(pa3,PK(3),o[d0],0,0,0);
    #undef PK
  }
}

#ifndef ATTN_STORE16
#define ATTN_STORE16(p,v) (*(u32x4*)(p)=(v))
#endif
template<int THRL> __device__ __forceinline__ void attn_unit(int b,int h,int qb,const bf16*Q,const bf16*__restrict__ K,const bf16*__restrict__ V,bf16*O,const float*__restrict__ CKH,const float*__restrict__ NRM,char*shm){
  const int tid=threadIdx.x,lane=tid&63,r32=lane&31,hi=lane>>5; const int wid=__builtin_amdgcn_readfirstlane(tid>>6);
  const long rowbase=(long)b*SEQ; const int q0=qb*QB;
  const bf16*Qw=Q+(rowbase+q0+wid*QBLK)*DM+h*D;
  const bf16*Kh=K+rowbase*DM+h*D,*Vh=V+rowbase*DM+h*D;
  const unsigned lds0=(unsigned)(uintptr_t)shm;
  float*wsf=(float*)(shm+LDS_WS)+wid*64;
  const bf16*ksrc=Kh+(long)lane*DM+wid*8;
  const bf16*vsrc=Vh+(long)(16*(wid&3)+(lane>>2))*DM+(wid>>2)*32+(lane&3)*8;
  const unsigned kdst=lds0+LDS_K+wid*1024, vdst=lds0+LDS_V+wid*1024;
  #define DMA_K(t,slot) glds16(ksrc+(long)((t)+T0)*KVBLK*DM,(unsigned)__builtin_amdgcn_readfirstlane(kdst+(slot)))
  #define DMA_V(t,slot) glds16(vsrc+(long)((t)+T0)*KVBLK*DM,(unsigned)__builtin_amdgcn_readfirstlane(vdst+(slot)))
  const int vb0=(int)(lds0+LDS_V)+((lane>>4)&1)*32+(lane&3)*8+(4*hi+((lane&15)>>2))*64;
  const char*Kbase=shm+LDS_K; bf16x8 kf[8];
  const lds_cptr shm3=(lds_cptr)shm; const lds_cptr kp0=shm3+LDS_K+hi*1024+r32*16; const lds_cptr vp0=shm3+LDS_V+((lane>>4)&1)*32+(lane&3)*8+(4*hi+((lane&15)>>2))*64;
  const int NT=(q0+QB)/KVBLK;
  const float*ckg=CKH+((long)b*NHEAD+h)*SEQ; float*ckl=(float*)(shm+LDS_CK); const lds_fptr ckl3=(lds_fptr)(shm3+LDS_CK);
  f32x4 ckv0=f32x4{0.f,0.f,0.f,0.f},ckv1=f32x4{0.f,0.f,0.f,0.f}; if(tid*4<q0+QB)ckv0=*reinterpret_cast<const f32x4*>(ckg+tid*4); if(2048+tid*4<q0+QB)ckv1=*reinterpret_cast<const f32x4*>(ckg+2048+tid*4);
  int T0;
  { const float*nr=NRM+((long)b*NHEAD+h)*2; const float qn=nr[0]+nr[1], kn=nr[BATCH*NHEAD*2]+nr[BATCH*NHEAD*2+1];
    const float bnd=__builtin_sqrtf(qn)*__builtin_sqrtf(kn)*1.02f+1.0f; const float cq0=ckg[q0];
    const float cj=(lane<NT)?ckg[64*lane+63]:0.f; const bool sk=(lane<NT)&&(bnd+cq0-cj<-160.f);
    const int ns=__builtin_popcountll(__ballot(sk)); T0=ns&~1; if(T0>NT-4)T0=NT-4; T0=__builtin_amdgcn_readfirstlane(T0); }
  const int NTL=NT-T0;
  const float cq=ckg[q0+wid*QBLK+r32];
  DMA_K(0,0);DMA_V(0,0);DMA_K(1,SLOTB);
  bf16x8 qr[4];
  #pragma unroll
  for(int d0=0;d0<4;++d0)qr[d0]=*reinterpret_cast<const bf16x8*>(&Qw[(long)r32*DM+d0*16+hi*8]);
  float mhat=-cq,l_reg=0.f;f32x16 o[2];o[0]=f32x16{};o[1]=f32x16{};
  const int qrel=wid*QBLK+r32;
  #define CMASK(P0,P1,t) do{int jb_=(t)-(NTL-4); if(jb_>=0)cmask(P0,P1,jb_,qrel,hi);}while(0)
  bool resc=false;
  #define START(P0,P1) do{ const float rm=rowmax(P0,P1); resc=false; \
    { const float dl=__builtin_fmaxf(rm,0.f); mhat=fadd_s(mhat,dl); \
      _Pragma("unroll") for(int r=0;r<16;++r){P0[r]=fsub_s(P0[r],dl);P1[r]=fsub_s(P1[r],dl);} } \
    _Pragma("unroll") for(int r=0;r<16;++r)P0[r]=__builtin_amdgcn_exp2f(P0[r]); }while(0)
  #define RESC() do{ if(resc){ asm volatile("s_waitcnt lgkmcnt(0)":::"memory"); \
      _Pragma("unroll") for(int d_=0;d_<2;++d_) _Pragma("unroll") for(int r=0;r<16;++r)o[d_][r]*=wsf[crow(r,hi)]; } }while(0)
  #define BGRP(X,g,base) do{ const f32x4 cv_=*(const __attribute__((address_space(3))) f32x4*)(ckl3+(base)+8*(g)+4*hi); const float nm_=-mhat; \
      X[4*(g)]=nm_-cv_[0]; X[4*(g)+1]=nm_-cv_[1]; X[4*(g)+2]=nm_-cv_[2]; X[4*(g)+3]=nm_-cv_[3]; }while(0)
  #define BINIT(X0,X1,tt) do{ _Pragma("unroll") for(int g_=0;g_<4;++g_){ BGRP(X0,g_,64*((tt)+T0)); BGRP(X1,g_,64*((tt)+T0)+32); } }while(0)
  f32x16 pA0,pA1,pB0,pB1;
  int sl_prev=0,sl_cur=0,sl_next=SLOTB;
  #define ROT() do{sl_prev=sl_cur;sl_cur=sl_next;sl_next=(sl_next==(NSLOT-1)*SLOTB)?0:sl_next+SLOTB;}while(0)
  DMA_K(2,2*SLOTB);
  *reinterpret_cast<f32x4*>(ckl+tid*4)=ckv0; *reinterpret_cast<f32x4*>(ckl+2048+tid*4)=ckv1;
  WAIT_BAR(3);
  BINIT(pA0,pA1,0);
  qkt(pA0,pA1,Kbase,qr,r32,hi);asm volatile("s_nop 15\n\ts_nop 7":"+v"(pA0),"+v"(pA1));CMASK(pA0,pA1,0);
  START(pA0,pA1);
  _Pragma("unroll") for(int r=0;r<16;++r)pA1[r]=__builtin_amdgcn_exp2f(pA1[r]);
  BINIT(pB0,pB1,1);
  WAIT_BAR(0);
  DMA_K(3,0);DMA_V(1,SLOTB);
  ROT();
  kload8(kf,kp0+sl_cur);
  WAIT_BAR(2);
  s16x4 vlo[8],vhi[8]; u32x4 pw0,pw1,pw2,pw3;
  #define PKW(P,B) cvtpk_s(P[B],P[B+1])
  #define PAF(k) __builtin_bit_cast(bf16x8,pw##k)
  #define VFR(i) (bf16x8){vlo[i][0],vlo[i][1],vlo[i][2],vlo[i][3],vhi[i][0],vhi[i][1],vhi[i][2],vhi[i][3]}
  #define PIN(x) asm volatile("":"+v"(x))
  #define MX3(a,b,c) __builtin_fmaxf(__builtin_fmaxf((a),(b)),(c))
  #define GAPA(MF,A0,A1,A2,A3,W0,W1,PW) do{ MF; sacc+=A0; sacc+=A1; sacc+=A2; sacc+=A3; PIN(sacc); W0; W1; PIN(PW); SBAR(); }while(0)
  #define EX(v) __builtin_amdgcn_exp2f(v)
  #define GAPB(MF,X,B) do{ MF; X[B]=EX(X[B]); X[B+1]=EX(X[B+1]); X[B+2]=EX(X[B+2]); X[B+3]=EX(X[B+3]); PIN(X); SBAR(); }while(0)
  #define VRD(i) do{ vlo[i]=vtr(vp_+(((i)>>2)*4096+((i)&3)*1024)); vhi[i]=vtr(vp_+(((i)>>2)*4096+((i)&3)*1024+512)); }while(0)
  #define KRD(G,j) do{ if(G){ kload2(kf,kp0+sl_next,j); SBAR(); } }while(0)
  #define NXB(G,X,g,tt,off) do{ if(G){ BGRP(X,g,64*((tt)+T0)+(off)); PIN(X); SBAR(); } }while(0)
  #define STEP(C0,C1,P0,P1,t,GK,GV,GL) do{ SBAR(); \
    const lds_cptr vp_=vp0+sl_prev; \
    VRD(0); SBAR(); float sacc=(P0[0]+P0[1]); \
    GAPA(C0=__builtin_amdgcn_mfma_f32_32x32x16_bf16(kf[0],qr[0],C0,0,0,0), P0[2],P0[3],P0[4],P0[5],     pw0[0]=PKW(P0,0), pw0[1]=PKW(P0,2), pw0); \
    VRD(4); SBAR(); GAPA(C1=__builtin_amdgcn_mfma_f32_32x32x16_bf16(kf[1],qr[0],C1,0,0,0), P0[6],P0[7],P0[8],P0[9],     pw0[2]=PKW(P0,4), pw0[3]=PKW(P0,6), pw0); \
    VRD(1); SBAR(); GAPA(C0=__builtin_amdgcn_mfma_f32_32x32x16_bf16(kf[2],qr[1],C0,0,0,0),   P0[10],P0[11],P0[12],P0[13], pw1[0]=PKW(P0,8), pw1[1]=PKW(P0,10), pw1); \
    VRD(5); SBAR(); GAPA(C1=__builtin_amdgcn_mfma_f32_32x32x16_bf16(kf[3],qr[1],C1,0,0,0),   P0[14],P0[15],P1[0],P1[1],   pw1[2]=PKW(P0,12),pw1[3]=PKW(P0,14), pw1); \
    VRD(2); SBAR(); GAPA(C0=__builtin_amdgcn_mfma_f32_32x32x16_bf16(kf[4],qr[2],C0,0,0,0),   P1[2],P1[3],P1[4],P1[5],     pw2[0]=PKW(P1,0), pw2[1]=PKW(P1,2), pw2); \
    VRD(6); SBAR(); GAPA(C1=__builtin_amdgcn_mfma_f32_32x32x16_bf16(kf[5],qr[2],C1,0,0,0),   P1[6],P1[7],P1[8],P1[9],     pw2[2]=PKW(P1,4), pw2[3]=PKW(P1,6), pw2); \
    VRD(3); SBAR(); GAPA(C0=__builtin_amdgcn_mfma_f32_32x32x16_bf16(kf[6],qr[3],C0,0,0,0),   P1[10],P1[11],P1[12],P1[13], pw3[0]=PKW(P1,8), pw3[1]=PKW(P1,10), pw3); \
    VRD(7); SBAR(); GAPA(C1=__builtin_amdgcn_mfma_f32_32x32x16_bf16(kf[7],qr[3],C1,0,0,0),   P1[14],P1[15],0.f,0.f,       pw3[2]=PKW(P1,12),pw3[3]=PKW(P1,14), pw3); \
    l_reg+=sacc; \
    if(GK){DMA_K((t)+3,sl_cur);} if(GV){DMA_V((t)+1,sl_next);} \
    CMASK(C0,C1,t); \
    { float a=MX3(C0[0],C0[1],C1[0]),b=MX3(C0[2],C0[3],C1[1]); a=MX3(a,C1[2],C1[3]); \
      _Pragma("unroll") for(int r=4;r<16;r+=4){a=MX3(a,C0[r],C0[r+1]);b=MX3(b,C0[r+2],C0[r+3]);a=MX3(a,C1[r],C1[r+1]);b=MX3(b,C1[r+2],C1[r+3]);} \
      float rm=__builtin_fmaxf(a,b); { auto rr=__builtin_amdgcn_permlane32_swap(__float_as_uint(rm),__float_as_uint(rm),false,false); rm=__builtin_fmaxf(__uint_as_float(rr[0]),__uint_as_float(rr[1])); } \
      resc=false; \
      if(__builtin_expect(__any(rm>(float)THRL),0)){ const float dl=__builtin_fmaxf(rm,0.f); mhat+=dl; \
        _Pragma("unroll") for(int r=0;r<16;++r){C0[r]-=dl;C1[r]-=dl;} \
        const float f=__builtin_amdgcn_exp2f(-dl); l_reg*=f; if(hi==0)wsf[r32]=f; resc=true; } } \
    SBAR(); \
    GAPB(o[0]=__builtin_amdgcn_mfma_f32_32x32x16_bf16(PAF(0),VFR(0),o[0],0,0,0), C0,0);  NXB(GL,P0,0,(t)+1,0); \
    GAPB(o[1]=__builtin_amdgcn_mfma_f32_32x32x16_bf16(PAF(0),VFR(4),o[1],0,0,0), C0,4);  NXB(GL,P0,1,(t)+1,0); \
    KRD(GL,0); GAPB(o[0]=__builtin_amdgcn_mfma_f32_32x32x16_bf16(PAF(1),VFR(1),o[0],0,0,0), C0,8);  NXB(GL,P0,2,(t)+1,0); \
    KRD(GL,1); GAPB(o[1]=__builtin_amdgcn_mfma_f32_32x32x16_bf16(PAF(1),VFR(5),o[1],0,0,0), C0,12); NXB(GL,P0,3,(t)+1,0); \
    KRD(GL,2); GAPB(o[0]=__builtin_amdgcn_mfma_f32_32x32x16_bf16(PAF(2),VFR(2),o[0],0,0,0), C1,0);  NXB(GL,P1,0,(t)+1,32); \
    KRD(GL,3); GAPB(o[1]=__builtin_amdgcn_mfma_f32_32x32x16_bf16(PAF(2),VFR(6),o[1],0,0,0), C1,4);  NXB(GL,P1,1,(t)+1,32); \
    GAPB(o[0]=__builtin_amdgcn_mfma_f32_32x32x16_bf16(PAF(3),VFR(3),o[0],0,0,0), C1,8);  NXB(GL,P1,2,(t)+1,32); \
    GAPB(o[1]=__builtin_amdgcn_mfma_f32_32x32x16_bf16(PAF(3),VFR(7),o[1],0,0,0), C1,12); NXB(GL,P1,3,(t)+1,32); \
    }while(0)
  int t=1;
  #undef CMASK
  #define CMASK(P0,P1,t) do{}while(0)
  for(;t+5<NTL;t+=2){
    STEP(pB0,pB1,pA0,pA1,t,true,true,true);     WAIT_BAR(2); RESC(); ROT();
    STEP(pA0,pA1,pB0,pB1,t+1,true,true,true);   WAIT_BAR(2); RESC(); ROT();
  }
  #undef CMASK
  #define CMASK(P0,P1,t) do{int jb_=(t)-(NTL-4); if(jb_>=0)cmask(P0,P1,jb_,qrel,hi);}while(0)
  #define ENDW(tt) do{ if((tt)+3<NTL){WAIT_BAR(2);} else if((tt)+2<NTL){WAIT_BAR(1);} else {WAIT_BAR(0);} }while(0)
  for(;t+1<NTL;t+=2){
    STEP(pB0,pB1,pA0,pA1,t,(t+3<NTL),(t+1<NTL),(t+1<NTL));       ENDW(t);   RESC(); ROT();
    STEP(pA0,pA1,pB0,pB1,t+1,(t+4<NTL),(t+2<NTL),(t+2<NTL));     ENDW(t+1); RESC(); ROT();
  }
  STEP(pB0,pB1,pA0,pA1,NTL-1,false,false,false); RESC();
  { float sacc=pB0[0]+pB0[1]; _Pragma("unroll") for(int r=2;r<16;++r)sacc+=pB0[r]; _Pragma("unroll") for(int r=0;r<16;++r)sacc+=pB1[r]; l_reg+=sacc;
    pw0=(u32x4){PKW(pB0,0),PKW(pB0,2),PKW(pB0,4),PKW(pB0,6)};pw1=(u32x4){PKW(pB0,8),PKW(pB0,10),PKW(pB0,12),PKW(pB0,14)};pw2=(u32x4){PKW(pB1,0),PKW(pB1,2),PKW(pB1,4),PKW(pB1,6)};pw3=(u32x4){PKW(pB1,8),PKW(pB1,10),PKW(pB1,12),PKW(pB1,14)};
    SBAR(); pv(o,vb0+sl_cur,PAF(0),PAF(1),PAF(2),PAF(3)); }
  #undef PKW
  #undef PAF
  #undef VFR
  #undef PIN
  #undef MX3
  #undef GAPA
  #undef GAPB
  #undef EX
  #undef VRD
  #undef KRD
  #undef NXB
  #undef STEP
  #undef ENDW
  {auto rr=__builtin_amdgcn_permlane32_swap(__float_as_uint(l_reg),__float_as_uint(l_reg),false,false);l_reg=__uint_as_float(rr[0])+__uint_as_float(rr[1]);}
  if(hi==0)wsf[32+r32]=l_reg;asm volatile("s_waitcnt lgkmcnt(0)":::"memory");
  float rli[16];
  #pragma unroll
  for(int r=0;r<16;++r)rli[r]=__builtin_amdgcn_rcpf(wsf[32+crow(r,hi)]);
  bf16*Ow=O+(rowbase+q0+wid*QBLK)*DM+h*D;
  { bf16*stg=(bf16*)(shm+LDS_OST)+wid*2048;
    #pragma unroll
    for(int r=0;r<16;++r){const int orow=crow(r,hi);
      #pragma unroll
      for(int d0=0;d0<2;++d0)stg[orow*64+d0*32+r32]=(bf16)(cvtpk_s(o[d0][r]*rli[r],0.f)&0xffffu);}
    asm volatile("s_waitcnt lgkmcnt(0)":::"memory");
    #pragma unroll
    for(int i=0;i<4;++i){const int row=i*8+(lane>>3),ch=lane&7; const u32x4 v=*(const u32x4*)(stg+row*64+ch*8); ATTN_STORE16(Ow+(long)row*DM+ch*8,v);} }
  asm volatile("s_waitcnt lgkmcnt(0)\n\ts_barrier":::"memory");
  #undef DMA_K
  #undef DMA_V
  #undef BINIT
  #undef BGRP
  #undef CMASK
  #undef START
  #undef RESC
  #undef ROT
}
constexpr int ATTN_LDS_BYTES=LDS_BYTES;
struct AttnTensors { const bf16* Q; const bf16* K; const bf16* V; bf16* O; const float* CKH; const float* NRM; };
struct AttnUnit { int bh; int qb; };
struct StaticOrder {
  int G,c;
  __device__ __forceinline__ StaticOrder(int grid,int block):G(grid),c(block){}
  __device__ __forceinline__ bool next(int i,AttnUnit&u)const{ int L=i*G+c;
#ifdef FOX_TWICE
    if(L>=2*BATCH*NHEAD*NQB)return false; L%=BATCH*NHEAD*NQB;
#else
    if(L>=BATCH*NHEAD*NQB)return false;
#endif
    const int ii=L>>8,g=L&255,s=g>>7,base=2*(ii>>1)+s; u.bh=g&127; u.qb=(ii&1)?(NQB-1-base):base; return true; }
  __device__ __forceinline__ void a_ready(const AttnUnit&)const{}
  __device__ __forceinline__ void done(const AttnUnit&)const{}
};
template<class Sched,int THRL=8> __device__ __forceinline__ void attn_phase(char*lds,const AttnTensors&T,const Sched&S){
  AttnUnit u;
  for(int i=0;S.next(i,u);++i){ S.a_ready(u); attn_unit<THRL>(u.bh/NHEAD,u.bh%NHEAD,u.qb,T.Q,T.K,T.V,T.O,T.CKH,T.NRM,lds); S.done(u); }
}
#undef SBAR
#undef WAIT_BAR
}

DI void ln_rows(const float* src, const float* g, const float* b, float* dst, bf16_t* xb, int gw, int ngw, int lane) {
    f32x4 gv[4], bv[4];
#pragma unroll
    for (int j = 0; j < 4; ++j) { gv[j] = *(const f32x4*)(g + lane * 4 + 256 * j); bv[j] = *(const f32x4*)(b + lane * 4 + 256 * j); }
    for (int row = gw; row < NTOK; row += ngw) {
        f32x4 v[4]; float s = 0.f;
#pragma unroll
        for (int j = 0; j < 4; ++j) { v[j] = *(const f32x4*)(src + (size_t)row * DM + lane * 4 + 256 * j); s += (v[j][0] + v[j][1]) + (v[j][2] + v[j][3]); }
        const float mean = wave_sum(s) * (1.f / DM); float s2 = 0.f;
#pragma unroll
        for (int j = 0; j < 4; ++j) { v[j] = v[j] - mean; s2 += (v[j][0] * v[j][0] + v[j][1] * v[j][1]) + (v[j][2] * v[j][2] + v[j][3] * v[j][3]); }
        const float rstd = 1.0f / sqrtf(wave_sum(s2) * (1.f / DM) + LN_EPS);
#pragma unroll
        for (int j = 0; j < 4; ++j) { const f32x4 y = v[j] * rstd * gv[j] + bv[j];
            if (dst) *(f32x4*)(dst + (size_t)row * DM + lane * 4 + 256 * j) = y;
            if (xb) *(u32x2*)(xb + (size_t)row * DM + lane * 4 + 256 * j) = pk4(y); }
    }
}

DI void moe_tables(const unsigned* cnt, LAS int* tstart, LAS int* cntl) {
    __syncthreads();
    if (threadIdx.x == 0) {
        int t = 0;
        for (int e = 0; e < NEXP; ++e) { const int c = (int)cnt[e]; cntl[e] = c; tstart[e] = t; t += (c + 255) >> 8; }
        tstart[NEXP] = t;
    }
    __syncthreads();
}

#define XB_TMO      128
#define XB_XCNT(j)  (256  + 64 * (j))
#define XB_XSUB(j)  (1280 + 64 * (j))
#define XB_XGEN(j)  (2304 + 64 * (j))
#define XB_TOP      3328
#define XB_TOPGEN   3392
#define XCD_BAR_WORDS 3456
#define XB_SPIN_CAP (1u << 18)
__device__ __forceinline__ unsigned xb_ld(unsigned* p)              { return __hip_atomic_load(p, __ATOMIC_RELAXED, __HIP_MEMORY_SCOPE_AGENT); }
__device__ __forceinline__ unsigned xb_add(unsigned* p, unsigned v) { return __hip_atomic_fetch_add(p, v, __ATOMIC_RELAXED, __HIP_MEMORY_SCOPE_AGENT); }
__device__ __forceinline__ unsigned xb_xcc_id() { return (unsigned)__builtin_amdgcn_s_getreg((3 << 11) | 20) & 0xFu; }
#define XB_SPIN(cond, bar) do { unsigned _sp = 0; while (cond) { __builtin_amdgcn_s_sleep(1); \
    if ((++_sp & 255u) == 0u) { if (xb_ld(&(bar)[XB_TMO])) break; if (_sp > XB_SPIN_CAP) { atomicAdd(&(bar)[XB_TMO], 1u); break; } } } } while (0)
struct XcdBarrier { unsigned* bar; unsigned x; volatile LAS unsigned* st; };
__device__ __forceinline__ XcdBarrier xcd_barrier_post(unsigned* bar, volatile LAS unsigned* st) {
    XcdBarrier b; b.bar = bar; b.x = xb_xcc_id(); b.st = st;
    if (threadIdx.x == 0) (void)xb_add(&bar[XB_XCNT(b.x)], 1u);
    return b;
}
__device__ __forceinline__ void xcd_barrier_complete(unsigned* bar, unsigned x, unsigned& nloc, unsigned& nx) {
    const unsigned G = gridDim.x * gridDim.y * gridDim.z;
    unsigned sum, cnt, mine, sp = 0u;
    for (;;) {
        sum = 0u; cnt = 0u; mine = 0u;
#pragma unroll
        for (unsigned j = 0; j < 16; ++j) { const unsigned c = xb_ld(&bar[XB_XCNT(j)]); sum += c; cnt += (c > 0u) ? 1u : 0u; mine = (j == x) ? c : mine; }
        if (sum == G) break;
        __builtin_amdgcn_s_sleep(1);
        if ((++sp & 255u) == 0u) { if (xb_ld(&bar[XB_TMO])) break; if (sp > XB_SPIN_CAP) { atomicAdd(&bar[XB_TMO], 1u); break; } }
    }
    nloc = mine > 0u ? mine : 1u; nx = cnt > 0u ? cnt : 1u;
}
__device__ __forceinline__ void xcd_barrier(const XcdBarrier& b) {
    asm volatile("s_waitcnt vmcnt(0)" ::: "memory");
    __syncthreads();
    if (threadIdx.x == 0) {
        unsigned* bar = b.bar;
        __builtin_amdgcn_s_waitcnt(0);
        unsigned nloc = b.st[0], nx = b.st[1];
        if (nloc == 0u) { xcd_barrier_complete(bar, b.x, nloc, nx); b.st[0] = nloc; b.st[1] = nx; }
        const unsigned old = xb_add(&bar[XB_XSUB(b.x)], 1u);
        const unsigned gen = old / nloc;
        if (old + 1u == (gen + 1u) * nloc) {
            __builtin_amdgcn_fence(__ATOMIC_RELEASE, "agent");
            asm volatile("s_waitcnt vmcnt(0)" ::: "memory");
            const unsigned og = xb_add(&bar[XB_TOP], 1u);
            const unsigned tg = og / nx;
            if (og + 1u == (tg + 1u) * nx) xb_add(&bar[XB_TOPGEN], 1u);
            else XB_SPIN(xb_ld(&bar[XB_TOPGEN]) == tg, bar);
            __builtin_amdgcn_fence(__ATOMIC_ACQUIRE, "agent");
            xb_add(&bar[XB_XGEN(b.x)], 1u);
            asm volatile("s_waitcnt vmcnt(0)" ::: "memory");
        } else {
            XB_SPIN(xb_ld(&bar[XB_XGEN(b.x)]) == gen, bar);
            __builtin_amdgcn_fence(__ATOMIC_ACQUIRE, "agent");
            asm volatile("s_waitcnt vmcnt(0)" ::: "memory");
        }
    }
    __syncthreads();
}

template <int PH> DI void run_phase(const Args& a, LAS unsigned char* lds) {
    int tid_ = threadIdx.x; asm volatile("" : "+v"(tid_));
    const int tid = tid_, lane = tid & 63, wid = tid >> 6;
    const int G = gridDim.x, bid = blockIdx.x;
    const int gw = bid * 8 + wid, ngw = G * 8, gtid = bid * 512 + tid, gthreads = G * 512;
    unsigned char* ws = a.ws;
    constexpr int L = (PH >= 10) ? 1 : 0;
    constexpr int IB_MOE = L ? 32 : 16;
    unsigned* cnt = (unsigned*)(ws + WS_CTL) + 64 * L;
    bf16_t* XB = (bf16_t*)(ws + WS_XB);
    LAS unsigned char* misc = lds + 131072;
    LAS int* tstart = (LAS int*)misc; LAS int* cntl = tstart + 72;
    float* SSQ_Q = (float*)(ws + WS_CTL + 256 * 1024); float* SSQ_KV = (float*)(ws + WS_TAB + 128 * 1024);

    if constexpr (PH == 0) {
        LAS float* scr = (LAS float*)(lds + wid * 8448);
        constexpr int I_IN = (1024 / 64) * (N_IN0 / 64), I_UQ = (256 / 64) * (768 / 64), I_UKV = (256 / 64) * (1280 / 64), I_OUT = (1024 / 64) * (1024 / 64);
        for (int it = gw; it < I_IN + I_UQ + I_UKV + I_OUT; it += ngw) {
            int r = it;
            if (r < I_IN) { prep_item((const float*)a.in(2), nullptr, 1440, 1024, nullptr, (bf16_t*)(ws + W_IN), 1024, N_IN0, map_in0, scr, r, lane); continue; } r -= I_IN;
            if (r < I_UQ) { prep_item((const float*)a.in(9), nullptr, 768, 256, (const float*)a.in(8), (bf16_t*)(ws + W_UQ), 256, 768, map_q, scr, r, lane); continue; } r -= I_UQ;
            if (r < I_UKV) { prep_item((const float*)a.in(11), nullptr, 1024, 128, (const float*)a.in(10), (bf16_t*)(ws + W_UKV), 256, 1280, map_kv, scr, r, lane); continue; } r -= I_UKV;
            prep_item((const float*)a.in(12), nullptr, 1024, 1024, nullptr, (bf16_t*)(ws + W_OUT), 1024, 1024, map_ident, scr, r, lane);
        }
        prep_moe(a, 16, scr, gw, ngw, lane, gtid, gthreads);
        float* b0 = (float*)(ws + WS_TAB); float* b1 = (float*)(ws + WS_TAB + 8192);
        for (int n = gtid; n < N_IN0; n += gthreads) { const int s = map_in0(n); b0[n] = s >= 0 ? ((const float*)a.in(3))[s] : 0.f; }
        for (int n = gtid; n < N_IN1; n += gthreads) b1[n] = n < 3088 ? ((const float*)a.in(27))[n] : 0.f;
        float* ct = (float*)(ws + WS_COS); float* st = (float*)(ws + WS_SIN); const int* pos = (const int*)a.in(1);
        for (int idx = gtid; idx < NTOK * 16; idx += gthreads) {
            const int t = idx >> 4, p = idx & 15;
            const float inv = 1.0f / exp2f((float)p * (13.287712379549449f / 16.0f));
            const float ang = (float)pos[t] * inv;
            double rev = (double)ang * 0.15915494309189535; rev -= rint(rev);
            ct[idx] = __builtin_amdgcn_cosf((float)rev); st[idx] = __builtin_amdgcn_sinf((float)rev);
        }
        const float* x = (const float*)a.in(0);
        for (int idx = gtid; idx < NTOK * DM / 8; idx += gthreads) {
            const f32x4 v0 = *(const f32x4*)(x + (size_t)idx * 8), v1 = *(const f32x4*)(x + (size_t)idx * 8 + 4);
            u32x4 o; o.x = pk2(v0[0], v0[1]); o.y = pk2(v0[2], v0[3]); o.z = pk2(v1[0], v1[1]); o.w = pk2(v1[2], v1[3]);
            *(u32x4*)(XB + (size_t)idx * 8) = o;
        }
    }
    else if constexpr (PH == 1) {
        const bf16_t* Bt = (const bf16_t*)(ws + W_IN); const float* bias = (const float*)(ws + WS_TAB);
        bf16_t* UPRE = (bf16_t*)(ws + B_UPRE); bf16_t* QL = (bf16_t*)(ws + B_QL); bf16_t* KVL = (bf16_t*)(ws + B_KVL);
        pg8::DenseOrder S; S.init(NTOK, N_IN0, 1024, Bt, G, bid);
        auto cf = [=](const pg8::Unit& u, int c) { return pg8::load_bias4(bias, u.pn * 256 + c); };
        auto f = [=](const pg8::Bias4& bb, const pg8::Unit& u, int r, int c, f32x4 l0, f32x4 l1, f32x4 h0, f32x4 h1) {
            const int nt = u.pn; const size_t row = (size_t)u.pm * 256 + r;
            l0 = l0 + bb.b[0]; l1 = l1 + bb.b[1]; h0 = h0 + bb.b[2]; h1 = h1 + bb.b[3];
            if (nt < 4) {
#pragma unroll
                for (int i = 0; i < 4; ++i) { l0[i] = l0[i] * sigmoidf_(h0[i]); l1[i] = l1[i] * sigmoidf_(h1[i]); }
                *(u32x4*)(UPRE + row * 512 + nt * 128 + c) = pk8(l0, l1);
            } else {
                bf16_t* dst = QL + (size_t)(nt - 4) * (B_KVL - B_QL) / 2;
                *(u32x4*)(dst + row * 256 + c) = pk8(l0, l1); *(u32x4*)(dst + row * 256 + 128 + c) = pk8(h0, h1);
                float ss = dot4(l0) + dot4(l1); if (nt == 4) ss += dot4(h0) + dot4(h1);
                ss += __shfl_xor(ss, 16); ss += __shfl_xor(ss, 32);
                if ((lane >> 4) == 0) { if (nt == 4) SSQ_Q[row * 4 + (c >> 5)] = ss; else SSQ_KV[row * 4 + (c >> 5)] = ss; }
            }
        };
        pg8::gemm_phase(lds, XB, 1024, S, pg8::make_epi<8>(cf, f));
    }
    else if constexpr (PH == 2) {
        const bf16_t* UPRE = (const bf16_t*)(ws + B_UPRE); bf16_t* UO = (bf16_t*)(ws + B_UO);
        {
            const float* cw = (const float*)a.in(4); const float* cb = (const float*)a.in(5); const float* lg = (const float*)a.in(6); const float* lb = (const float*)a.in(7);
            LAS bf16_t* U = (LAS bf16_t*)lds;
            LAS float* CO = (LAS float*)(lds + 94 * 512 * 2);
            float w[31];
#pragma unroll
            for (int j = 0; j < 31; ++j) w[j] = cw[j * 512 + tid];
            const float bch = cb[tid];
            f32x4 g0 = *(const f32x4*)(lg + lane * 8), g1 = *(const f32x4*)(lg + lane * 8 + 4), b0 = *(const f32x4*)(lb + lane * 8), b1 = *(const f32x4*)(lb + lane * 8 + 4);
            for (int u = bid; u < NTOK / 64; u += G) {
                const int tok0 = u * 64, s0 = tok0 % SEQ;
                __syncthreads();
                for (int c = tid; c < 94 * 64; c += 512) { const int r = c >> 6, ch = c & 63; const int s = s0 - 30 + r;
                    u32x4 v = (u32x4){0u, 0u, 0u, 0u}; if (s >= 0) v = *(const u32x4*)(UPRE + (size_t)(tok0 - 30 + r) * 512 + ch * 8);
                    *(LAS u32x4*)(U + r * 512 + ch * 8) = v; }
                __syncthreads();
                for (int sub = 0; sub < 4; ++sub) {
                    for (int tt = 0; tt < 16; ++tt) { const int tl = sub * 16 + tt; float acc = bch;
#pragma unroll
                        for (int j = 0; j < 31; ++j) acc += w[j] * bf2f(U[(tl + j) * 512 + tid]);
                        CO[tt * 512 + tid] = acc; }
                    __syncthreads();
#pragma unroll
                    for (int k = 0; k < 2; ++k) { const int tt = 2 * wid + k;
                        f32x4 v0 = *(LAS f32x4*)(CO + tt * 512 + lane * 8), v1 = *(LAS f32x4*)(CO + tt * 512 + lane * 8 + 4);
                        const float mean = wave_sum((v0[0] + v0[1]) + (v0[2] + v0[3]) + (v1[0] + v1[1]) + (v1[2] + v1[3])) * (1.f / 512.f);
                        v0 = v0 - mean; v1 = v1 - mean;
                        const float var = wave_sum((v0[0] * v0[0] + v0[1] * v0[1]) + (v0[2] * v0[2] + v0[3] * v0[3]) + (v1[0] * v1[0] + v1[1] * v1[1]) + (v1[2] * v1[2] + v1[3] * v1[3])) * (1.f / 512.f);
                        const float rstd = 1.0f / sqrtf(var + LN_EPS);
                        f32x4 y0 = v0 * rstd * g0 + b0, y1 = v1 * rstd * g1 + b1;
#pragma unroll
                        for (int i = 0; i < 4; ++i) { y0[i] = siluf_(y0[i]); y1[i] = siluf_(y1[i]); }
                        u32x4 o; o.x = pk2(y0[0], y0[1]); o.y = pk2(y0[2], y0[3]); o.z = pk2(y1[0], y1[1]); o.w = pk2(y1[2], y1[3]);
                        *(u32x4*)(UO + (size_t)(tok0 + sub * 16 + tt) * 1024 + lane * 8) = o; }
                    __syncthreads();
                }
            }
        }
        const float* ct = (const float*)(ws + WS_COS); const float* st = (const float*)(ws + WS_SIN);
        {
            const bf16_t* QL = (const bf16_t*)(ws + B_QL); bf16_t* Q0 = (bf16_t*)(ws + B_Q0);
            pg8::DenseOrder S; S.init(NTOK, 768, 256, (const bf16_t*)(ws + W_UQ), G, bid);
            auto f = [=](const pg8::NoCtx&, const pg8::Unit& u, int r, int c, f32x4 l0, f32x4 l1, f32x4 h0, f32x4 h1) {
                const size_t row = (size_t)u.pm * 256 + r; const f32x4 sq = *(const f32x4*)(SSQ_Q + row * 4); const float s = 1.0f / sqrtf(((sq[0] + sq[1]) + (sq[2] + sq[3])) * (1.f / 256.f) + RMS_EPS);
#pragma unroll
                for (int hh = 0; hh < 2; ++hh) { f32x4 v0 = (hh ? h0 : l0) * s, v1 = (hh ? h1 : l1) * s; const int col = u.pn * 256 + c + 128 * hh; const int d = col % 96;
                    if (d >= 64) rope8(v0, v1, ct, st, row, (d - 64) >> 1);
                    *(u32x4*)(Q0 + row * 768 + col) = pk8(v0 * C2_MLA, v1 * C2_MLA); }
            };
            pg8::gemm_phase(lds, QL, 256, S, pg8::make_epi<2>([](const pg8::Unit&, int) { return pg8::NoCtx{}; }, f));
        }
        {
            const bf16_t* KVL = (const bf16_t*)(ws + B_KVL); bf16_t* K0 = (bf16_t*)(ws + B_K0); bf16_t* V0 = (bf16_t*)(ws + B_V0);
            pg8::DenseOrder S; S.init(NTOK, 1280, 256, (const bf16_t*)(ws + W_UKV), G, bid);
            auto f = [=](const pg8::NoCtx&, const pg8::Unit& u, int r, int c, f32x4 l0, f32x4 l1, f32x4 h0, f32x4 h1) {
                const size_t row = (size_t)u.pm * 256 + r; const f32x4 sq = *(const f32x4*)(SSQ_KV + row * 4); const float s = 1.0f / sqrtf(((sq[0] + sq[1]) + (sq[2] + sq[3])) * (1.f / 128.f) + RMS_EPS);
#pragma unroll
                for (int hh = 0; hh < 2; ++hh) { f32x4 v0 = (hh ? h0 : l0), v1 = (hh ? h1 : l1); const int col = u.pn * 256 + c + 128 * hh;
                    if (col < 768) { const int d = col % 96;
                        if (d >= 64) rope8(v0, v1, ct, st, row, (d - 64) >> 1); else { v0 = v0 * s; v1 = v1 * s; }
                        *(u32x4*)(K0 + row * 768 + col) = pk8(v0, v1); }
                    else *(u32x4*)(V0 + row * 512 + (col - 768)) = pk8(v0 * s, v1 * s); }
            };
            pg8::gemm_phase(lds, KVL, 256, S, pg8::make_epi<2>([](const pg8::Unit&, int) { return pg8::NoCtx{}; }, f));
        }
    }
    else if constexpr (PH == 3) {
        const bf16_t* Q0 = (const bf16_t*)(ws + B_Q0); const bf16_t* K0 = (const bf16_t*)(ws + B_K0); const bf16_t* V0 = (const bf16_t*)(ws + B_V0); bf16_t* UO = (bf16_t*)(ws + B_UO);
        for (int u = bid; u < 64 * 16; u += G) {
            const int i = u >> 8, gp = u & 255, s = gp >> 6, bh = gp & 63, base = 4 * (i >> 1) + s, qb = (i & 1) ? 15 - base : base;
            const int b = bh >> 3, h = bh & 7;
            attn_simple_unit<96, 768, 768, 512, 1024, false>(lds, Q0, K0, V0, UO, nullptr, b, h * 96, h * 64, 0, 512 + h * 64, qb);
        }
    }
    else if constexpr (PH == 4 || PH == 13) {
        const bf16_t* A = (const bf16_t*)(ws + (L ? B_O1 : B_UO));
        const float* bias = (const float*)a.in(L ? 29 : 13); const float* xres = L ? (const float*)a.out : (const float*)a.in(0); float* pre = a.out;
        pg8::DenseOrder S; S.init(NTOK, 1024, 1024, (const bf16_t*)(ws + W_OUT), G, bid);
        auto cf = [=](const pg8::Unit& u, int c) { return pg8::load_bias4(bias, u.pn * 256 + c); };
        auto f = [=](const pg8::Bias4& bb, const pg8::Unit& u, int r, int c, f32x4 l0, f32x4 l1, f32x4 h0, f32x4 h1) {
            const int col = u.pn * 256 + c; const size_t off = ((size_t)u.pm * 256 + r) * 1024 + col;
            const f32x4 x0 = *(const f32x4*)(xres + off), x1 = *(const f32x4*)(xres + off + 4), x2 = *(const f32x4*)(xres + off + 128), x3 = *(const f32x4*)(xres + off + 132);
            *(f32x4*)(pre + off) = x0 * ALPHA + l0 + bb.b[0]; *(f32x4*)(pre + off + 4) = x1 * ALPHA + l1 + bb.b[1];
            *(f32x4*)(pre + off + 128) = x2 * ALPHA + h0 + bb.b[2]; *(f32x4*)(pre + off + 132) = x3 * ALPHA + h1 + bb.b[3];
        };
        pg8::gemm_phase(lds, A, 1024, S, pg8::make_epi<4>(cf, f));
    }
    else if constexpr (PH == 5 || PH == 14) {
        ln_rows(a.out, (const float*)a.in(L ? 30 : 14), (const float*)a.in(L ? 31 : 15), a.out, XB, gw, ngw, lane);
    }
    else if constexpr (PH == 6 || PH == 15) {
        {
            const float* x1 = a.out; const bf16_t* rhi = (const bf16_t*)(ws + W_RHI); const bf16_t* rlo = (const bf16_t*)(ws + W_RLO);
            const float* rbias = (const float*)a.in(IB_MOE + 1);
            int* LIST = (int*)(ws + B_LIST); float* LISTW = (float*)(ws + B_LISTW);
            LAS float* lgl = (LAS float*)(lds + 49152);
            LAS int* lcnt = (LAS int*)(lds + 49152 + 33280);
            LAS int* lbase = lcnt + 64;
            LAS int* sel_e = lbase + 64;
            LAS int* sel_p = sel_e + 768;
            LAS float* sel_w = (LAS float*)(sel_p + 768);
            const int fr = lane & 15, fq = lane >> 4;
            const float mybias = rbias[lane];
            for (int u = bid; u < NTOK / 128; u += G) {
                const int t0 = u * 128;
                f32x4 acc[4];
#pragma unroll
                for (int n = 0; n < 4; ++n) acc[n] = (f32x4){0.f, 0.f, 0.f, 0.f};
                const int sr = tid >> 2, sc = (tid & 3) * 8;
                const float* xp = x1 + (size_t)(t0 + sr) * 1024 + sc; const bf16_t* wp = (tid < 256 ? rhi : rlo) + (size_t)((tid & 255) >> 2) * 1024 + (tid & 3) * 8;
                f32x4 v0, v1; u32x4 wv;
#define RT_WRITE(b) do { LAS unsigned char* base_ = lds + (b) * 24576; u32x4 h, lo_; \
                    h.x = pk2(v0[0], v0[1]); h.y = pk2(v0[2], v0[3]); h.z = pk2(v1[0], v1[1]); h.w = pk2(v1[2], v1[3]); \
                    lo_.x = pk2(v0[0] - __uint_as_float(h.x << 16), v0[1] - __uint_as_float(h.x & 0xffff0000u)); \
                    lo_.y = pk2(v0[2] - __uint_as_float(h.y << 16), v0[3] - __uint_as_float(h.y & 0xffff0000u)); \
                    lo_.z = pk2(v1[0] - __uint_as_float(h.z << 16), v1[1] - __uint_as_float(h.z & 0xffff0000u)); \
                    lo_.w = pk2(v1[2] - __uint_as_float(h.w << 16), v1[3] - __uint_as_float(h.w & 0xffff0000u)); \
                    *(LAS u32x4*)(base_ + sr * 64 + sc * 2) = h; *(LAS u32x4*)(base_ + 8192 + sr * 64 + sc * 2) = lo_; \
                    *(LAS u32x4*)(base_ + (tid < 256 ? 16384 : 20480) + ((tid & 255) >> 2) * 64 + (tid & 3) * 16) = wv; } while (0)
                v0 = *(const f32x4*)(xp); v1 = *(const f32x4*)(xp + 4); wv = *(const u32x4*)(wp);
                __syncthreads();
                RT_WRITE(0);
                __syncthreads();
                for (int kt = 0; kt < 32; ++kt) {
                    if (kt + 1 < 32) { v0 = *(const f32x4*)(xp + (kt + 1) * 32); v1 = *(const f32x4*)(xp + (kt + 1) * 32 + 4); wv = *(const u32x4*)(wp + (kt + 1) * 32); }
                    LAS unsigned char* base = lds + (kt & 1) * 24576;
                    const bf16x8 ah = *(LAS bf16x8*)(base + (16 * wid + fr) * 64 + fq * 16), al = *(LAS bf16x8*)(base + 8192 + (16 * wid + fr) * 64 + fq * 16);
#pragma unroll
                    for (int n = 0; n < 4; ++n) { const bf16x8 bh = *(LAS bf16x8*)(base + 16384 + (16 * n + fr) * 64 + fq * 16), bl = *(LAS bf16x8*)(base + 20480 + (16 * n + fr) * 64 + fq * 16);
                        acc[n] = mfma16(bh, ah, acc[n]); acc[n] = mfma16(bh, al, acc[n]); acc[n] = mfma16(bl, ah, acc[n]); }
                    if (kt + 1 < 32) RT_WRITE((kt + 1) & 1);
                    __syncthreads();
                }
#undef RT_WRITE
#pragma unroll
                for (int n = 0; n < 4; ++n)
#pragma unroll
                    for (int j = 0; j < 4; ++j) lgl[(16 * wid + fr) * 65 + 16 * n + 4 * fq + j] = acc[n][j];
                if (tid < 64) lcnt[tid] = 0;
                __syncthreads();
                for (int tt = 0; tt < 16; ++tt) {
                    const int tl = 16 * wid + tt;
                    const float sg = sigmoidf_(lgl[tl * 65 + lane]); const float ch = sg + mybias;
                    const int g = lane >> 3; int rk = 0;
#pragma unroll
                    for (int jj = 0; jj < 8; ++jj) { const int oj = (lane & ~7) + jj; const float o = __shfl(ch, oj); rk += ((o > ch) || (o == ch && oj < lane)) ? 1 : 0; }
                    float top = rk < 2 ? ch : 0.f; top += __shfl_xor(top, 1); top += __shfl_xor(top, 2); top += __shfl_xor(top, 4);
                    int grk = 0;
#pragma unroll
                    for (int gg = 0; gg < 8; ++gg) { const float o = __shfl(top, gg * 8); grk += ((o > top) || (o == top && gg < g)) ? 1 : 0; }
                    const bool gsel = grk < 4; const float mv = gsel ? ch : -INFINITY; int erk = 0;
#pragma unroll 8
                    for (int j = 0; j < 64; ++j) { const float o = __shfl(mv, j); erk += ((o > mv) || (o == mv && j < lane)) ? 1 : 0; }
                    const bool sel = gsel && erk < TOPK;
                    const float tot = wave_sum(sel ? sg : 0.f); const float w = sg / tot * 2.5f;
                    if (sel) { const int lp = __hip_atomic_fetch_add(lcnt + lane, 1, __ATOMIC_RELAXED, __HIP_MEMORY_SCOPE_WORKGROUP);
                        sel_e[tl * 6 + erk] = lane; sel_p[tl * 6 + erk] = lp; sel_w[tl * 6 + erk] = w; }
                }
                __syncthreads();
                if (tid < 64) { const int c = lcnt[tid]; lbase[tid] = c ? (int)atomicAdd(cnt + tid, (unsigned)c) : 0; }
                __syncthreads();
                for (int idx = tid; idx < 768; idx += 512) { const int e = sel_e[idx], pos = lbase[e] + sel_p[idx], tl = idx / 6, j = idx % 6; LIST[(size_t)e * LISTCAP + pos] = ((t0 + tl) << 3) | j; LISTW[(size_t)e * LISTCAP + pos] = sel_w[idx]; }
                __syncthreads();
            }
        }
        {
            bf16_t* SH = (bf16_t*)(ws + B_SH);
            pg8::DenseOrder S; S.init(NTOK, 512, 1024, (const bf16_t*)(ws + W_SGU), G, bid);
            auto f = [=](const pg8::NoCtx&, const pg8::Unit& u, int r, int c, f32x4 l0, f32x4 l1, f32x4 h0, f32x4 h1) {
#pragma unroll
                for (int i = 0; i < 4; ++i) { l0[i] = siluf_(l0[i]) * h0[i]; l1[i] = siluf_(l1[i]) * h1[i]; }
                *(u32x4*)(SH + ((size_t)u.pm * 256 + r) * 256 + u.pn * 128 + c) = pk8(l0, l1); };
            pg8::gemm_phase(lds, XB, 1024, S, pg8::make_epi<8>([](const pg8::Unit&, int) { return pg8::NoCtx{}; }, f));
        }
    }
    else if constexpr (PH == 7 || PH == 16) {
        moe_tables(cnt, tstart, cntl);
        bf16_t* H = (bf16_t*)(ws + B_H);
        pg8::GroupedOrder<true> S{tstart, cntl, 2, G, bid, (const char*)(ws + W_GU), (size_t)512 * 1024 * 2, (size_t)256 * 1024 * 2, (const int*)(ws + B_LIST), 0};
        auto f = [=](const pg8::NoCtx&, const pg8::Unit& u, int r, int c, f32x4 l0, f32x4 l1, f32x4 h0, f32x4 h1) {
#pragma unroll
            for (int i = 0; i < 4; ++i) { l0[i] = siluf_(l0[i]) * h0[i]; l1[i] = siluf_(l1[i]) * h1[i]; }
            *(u32x4*)(H + ((size_t)(tstart[u.e] + u.pm) * 256 + r) * 256 + u.pn * 128 + c) = pk8(l0, l1); };
        pg8::gemm_phase(lds, XB, 1024, S, pg8::make_epi<8>([](const pg8::Unit&, int) { return pg8::NoCtx{}; }, f));
    }
    else if constexpr (PH == 8 || PH == 17) {
        moe_tables(cnt, tstart, cntl);
        pg8::GroupedOrder<false> S{tstart, cntl, 4, G, bid, (const char*)(ws + W_D), (size_t)1024 * 256 * 2, (size_t)256 * 256 * 2, (const int*)(ws + B_LIST), NTOK / 256};
        EpiDown E{cntl, (const int*)(ws + B_LIST), (const float*)(ws + B_LISTW), ws + B_YT};
        pg8::gemm_phase(lds, (const bf16_t*)(ws + B_H), 256, S, E);
    }
    else if constexpr (PH == 9 || PH == 18) {
        {
            const unsigned char* YT = ws + B_YT; float* xo = a.out;
            const float* g = (const float*)a.in(IB_MOE + 8); const float* b = (const float*)a.in(IB_MOE + 9);
            f32x4 gv[4], bv[4];
#pragma unroll
            for (int j = 0; j < 4; ++j) { gv[j] = *(const f32x4*)(g + lane * 16 + 4 * j); bv[j] = *(const f32x4*)(b + lane * 16 + 4 * j); }
            for (int row = gw; row < NTOK; row += ngw) {
                f32x4 v[4]; u32x4 y[7];
#pragma unroll
                for (int j = 0; j < 4; ++j) v[j] = *(const f32x4*)(xo + (size_t)row * DM + lane * 16 + 4 * j);
#pragma unroll
                for (int s = 0; s < 7; ++s) y[s] = *(const u32x4*)(YT + ((size_t)row * 7 + s) * 1024 + lane * 16);
                f32x4 acc[4];
#pragma unroll
                for (int j = 0; j < 4; ++j) acc[j] = (f32x4){0.f, 0.f, 0.f, 0.f};
#pragma unroll
                for (int s = 0; s < 7; ++s)
#pragma unroll
                    for (int j = 0; j < 4; ++j) { const f32x2_t lo = __builtin_amdgcn_cvt_pk_f32_fp8((int)y[s][j], false), hi = __builtin_amdgcn_cvt_pk_f32_fp8((int)y[s][j], true);
                        acc[j][0] += lo[0]; acc[j][1] += lo[1]; acc[j][2] += hi[0]; acc[j][3] += hi[1]; }
                float sm = 0.f;
#pragma unroll
                for (int j = 0; j < 4; ++j) { v[j] = v[j] * ALPHA + acc[j] * (1.0f / YSCALE); sm += (v[j][0] + v[j][1]) + (v[j][2] + v[j][3]); }
                const float mean = wave_sum(sm) * (1.f / DM); float s2 = 0.f;
#pragma unroll
                for (int j = 0; j < 4; ++j) { v[j] = v[j] - mean; s2 += (v[j][0] * v[j][0] + v[j][1] * v[j][1]) + (v[j][2] * v[j][2] + v[j][3] * v[j][3]); }
                const float rstd = 1.0f / sqrtf(wave_sum(s2) * (1.f / DM) + LN_EPS);
#pragma unroll
                for (int j = 0; j < 4; ++j) { v[j] = v[j] * rstd * gv[j] + bv[j]; *(f32x4*)(xo + (size_t)row * DM + lane * 16 + 4 * j) = v[j]; }
                if (PH == 9) { *(u32x4*)(XB + (size_t)row * DM + lane * 16) = pk8(v[0], v[1]); *(u32x4*)(XB + (size_t)row * DM + lane * 16 + 8) = pk8(v[2], v[3]); }
            }
        }
        if constexpr (PH == 9) {
            LAS float* scr = nullptr;
            constexpr int I_IN = (1024 / 64) * (N_IN1 / 64), I_OUT = (1024 / 64) * (1024 / 64);
            for (int it = gw; it < I_IN + I_OUT; it += ngw) {
                int r = it;
                if (r < I_IN) { prep_item((const float*)a.in(26), nullptr, 3088, 1024, nullptr, (bf16_t*)(ws + W_IN), 1024, N_IN1, map_in1, scr, r, lane); continue; } r -= I_IN;
                prep_item((const float*)a.in(28), nullptr, 1024, 1024, nullptr, (bf16_t*)(ws + W_OUT), 1024, 1024, map_ident, scr, r, lane);
            }
            prep_moe(a, 32, scr, gw, ngw, lane, gtid, gthreads);
        }
    }
    else if constexpr (PH == 10) {
        pg8::DenseOrder S; S.init(NTOK, N_IN1, 1024, (const bf16_t*)(ws + W_IN), G, bid);
        EpiIn1 E{(const float*)(ws + WS_TAB + 8192), (bf16_t*)(ws + B_Q1), (bf16_t*)(ws + B_K1), (bf16_t*)(ws + B_V1), (float*)(ws + B_GL), (unsigned*)(ws + WS_CTL + 8192)};
        pg8::gemm_phase(lds, XB, 1024, S, E);
    }
    else if constexpr (PH == 11) {
        const float* GL = (const float*)(ws + B_GL); float* CK = (float*)(ws + B_CK);
        for (int sq = gw; sq < NBATCH * 16; sq += ngw) {
            const int b = sq >> 4, h = sq & 15; float v[64];
            const float* gp = GL + ((size_t)b * SEQ + lane * 64) * 16 + h;
#pragma unroll
            for (int i = 0; i < 64; ++i) v[i] = gp[i * 16];
#pragma unroll
            for (int i = 1; i < 64; ++i) v[i] += v[i - 1];
            const float tot = v[63]; float inc = tot;
#pragma unroll
            for (int o = 1; o < 64; o <<= 1) { const float n = __shfl_up(inc, o); if (lane >= o) inc += n; }
            const float excl = inc - tot;
            float* op = CK + ((size_t)b * 16 + h) * SEQ + lane * 64;
#pragma unroll
            for (int i = 0; i < 16; ++i) { f32x4 o; o[0] = (v[4 * i] + excl) * LOG2E; o[1] = (v[4 * i + 1] + excl) * LOG2E; o[2] = (v[4 * i + 2] + excl) * LOG2E; o[3] = (v[4 * i + 3] + excl) * LOG2E; *(f32x4*)(op + 4 * i) = o; }
        }
    }
    else if constexpr (PH == 12) {
        static_assert(attn_fox::ATTN_LDS_BYTES <= 131072, "attention LDS");
        const attn_fox::AttnTensors AT{(const bf16_t*)(ws + B_Q1), (const bf16_t*)(ws + B_K1), (const bf16_t*)(ws + B_V1), (bf16_t*)(ws + B_O1), (const float*)(ws + B_CK), (const float*)(ws + WS_CTL + 8192)};
        const attn_fox::StaticOrder S(G, bid);
        attn_fox::attn_phase<attn_fox::StaticOrder>((char*)lds, AT, S);
    }
}

constexpr int LDS_BYTES = 147456;
constexpr int CW_BAR = 4096;
constexpr int NPHASE = 19;
template <int PH, int END> struct RunAll {
    static DI void run(const Args& a, LAS unsigned char* lds, const XcdBarrier& bar) {
#ifdef PROBE_REP_PH
        if constexpr (PH == PROBE_REP_PH) { int reps_; asm volatile("s_mov_b32 %0, 2" : "=s"(reps_));
            for (int rep_ = 0; rep_ < reps_; ++rep_) { run_phase<PH>(a, lds); if (rep_ + 1 < reps_) xcd_barrier(bar); } }
        else
#endif
        run_phase<PH>(a, lds);
#ifdef PROBE_MASK
        if constexpr ((PROBE_MASK >> PH) & 1u) { xcd_barrier(bar); run_phase<PH>(a, lds); }
#endif
        if (PH + 1 < END) xcd_barrier(bar);
        RunAll<PH + 1, END>::run(a, lds, bar);
    }
};
template <int END> struct RunAll<END, END> { static DI void run(const Args&, LAS unsigned char*, const XcdBarrier&) {} };

__global__ void __launch_bounds__(512, 2) k_all(KArgs ka) {
    extern __shared__ __attribute__((aligned(16))) unsigned char lds_raw[];
    LAS unsigned char* lds = (LAS unsigned char*)lds_raw;
    Args a; a.tab = (LAS unsigned long long*)(lds + 131072 + 1024); a.out = ka.out; a.ws = ka.ws;
    { const int t_ = threadIdx.x;
#pragma unroll
      for (int k = 0; k < 42; ++k) if (t_ == k) a.tab[k] = (unsigned long long)ka.in[k]; }
    volatile LAS unsigned* st = (volatile LAS unsigned*)(lds + LDS_BYTES - 16);
    if (threadIdx.x == 0) { st[0] = 0u; st[1] = 0u; st[2] = 0u; st[3] = 0u; }
    __syncthreads();
    const XcdBarrier bar = xcd_barrier_post((unsigned*)(a.ws + WS_CTL) + CW_BAR, st);
    RunAll<0, NPHASE>::run(a, lds, bar);
}

extern "C" void kernel_launch(void* const* d_in, const int* in_sizes, int n_in, void* d_out, int out_size, void* d_ws, size_t ws_size, hipStream_t stream) {
    static int grid = 0;
    if (grid == 0) {
        if (n_in != 42 || out_size != NTOK * DM || ws_size < WS_END) { fprintf(stderr, "kernel_launch: unexpected shapes (n_in %d, out %d, ws %zu < %zu)\n", n_in, out_size, ws_size, (size_t)WS_END); grid = -1; return; }
        int dev = 0, cus = 0, per_cu = 0;
        (void)hipGetDevice(&dev); (void)hipDeviceGetAttribute(&cus, hipDeviceAttributeMultiprocessorCount, dev);
        (void)hipFuncSetAttribute((const void*)k_all, hipFuncAttributeMaxDynamicSharedMemorySize, LDS_BYTES);
        if (hipOccupancyMaxActiveBlocksPerMultiprocessor(&per_cu, (const void*)k_all, 512, LDS_BYTES) != hipSuccess || per_cu < 1) { fprintf(stderr, "kernel_launch: occupancy query reports %d blocks per CU\n", per_cu); per_cu = 1; }
        (void)hipGetLastError();
        grid = cus > 0 ? cus : 256;
    }
    if (grid < 0) return;
    (void)hipMemsetAsync((char*)d_ws + WS_CTL, 0, 1 * MiB, stream);
    KArgs a{};
    for (int i = 0; i < 42; ++i) a.in[i] = d_in[i];
    a.out = (float*)d_out; a.ws = (unsigned char*)d_ws;
    hipLaunchKernelGGL(k_all, dim3(grid), dim3(512), LDS_BYTES, stream, a);
}
```

```cpp
#include <hip/hip_runtime.h>
#include <cstdio>
#include <cstdint>
#include <cmath>

#define LAS __attribute__((address_space(3)))
#define DI __device__ __forceinline__
typedef unsigned short bf16_t;
typedef short bf16x8 __attribute__((ext_vector_type(8)));
typedef short s16x4 __attribute__((ext_vector_type(4)));
typedef float f32x4 __attribute__((ext_vector_type(4)));
typedef float f32x16 __attribute__((ext_vector_type(16)));
typedef unsigned u32x4 __attribute__((ext_vector_type(4)));
typedef unsigned u32x2 __attribute__((ext_vector_type(2)));
typedef float f32x2_t __attribute__((ext_vector_type(2)));
typedef __bf16 bf16x2_t __attribute__((ext_vector_type(2)));

constexpr int NTOK = 32768, DM = 1024, NBATCH = 8, SEQ = 4096;
constexpr int NEXP = 64, TOPK = 6, EHID = 256;
constexpr float ALPHA = 1.4142135623730951f;
constexpr float LN_EPS = 1e-5f, RMS_EPS = 1e-6f;
constexpr float LOG2E = 1.4426950408889634f;
constexpr float C2_MLA = 0.10206207261596577f * LOG2E;
constexpr float C2_FOX = 0.125f * LOG2E;
constexpr int N_IN0 = 1536, N_IN1 = 3328;
constexpr int LISTCAP = 32768;
constexpr int HROWS = 212992;

constexpr size_t MiB = 1u << 20;
constexpr size_t WS_CTL = 0;
constexpr size_t WS_TAB = 1 * MiB;
constexpr size_t WS_COS = 2 * MiB, WS_SIN = 4 * MiB;
constexpr size_t WS_W = 6 * MiB;
constexpr size_t W_GU = WS_W + 0, W_D = WS_W + 64 * MiB, W_SD = WS_W + 96 * MiB  , W_RHI = WS_W + 96 * MiB + 512 * 1024, W_RLO = W_RHI + 128 * 1024,
                 W_SGU = WS_W + 97 * MiB, W_IN = WS_W + 99 * MiB, W_OUT = WS_W + 106 * MiB,
                 W_UQ = WS_W + 108 * MiB, W_UKV = WS_W + 108 * MiB + 512 * 1024;
constexpr size_t WS_XB = 116 * MiB;
constexpr size_t WS_BIG = 180 * MiB;
constexpr size_t B_UPRE = WS_BIG, B_QL = WS_BIG + 32 * MiB, B_KVL = WS_BIG + 48 * MiB, B_Q0 = WS_BIG + 64 * MiB, B_K0 = WS_BIG + 112 * MiB,
                 B_V0 = WS_BIG + 160 * MiB, B_UO = WS_BIG + 192 * MiB;
constexpr size_t B_Q1 = WS_BIG, B_K1 = WS_BIG + 64 * MiB, B_V1 = WS_BIG + 128 * MiB, B_O1 = WS_BIG + 192 * MiB, B_GL = WS_BIG + 256 * MiB, B_CK = WS_BIG + 258 * MiB;
constexpr size_t B_H = WS_BIG, B_SH = WS_BIG + 104 * MiB, B_YT = WS_BIG + 120 * MiB, B_LIST = WS_BIG + 344 * MiB, B_LISTW = WS_BIG + 352 * MiB;
constexpr size_t WS_END = WS_BIG + 360 * MiB;
constexpr float YSCALE = 32.0f;

struct KArgs { const void* in[42]; float* out; unsigned char* ws; };
struct Args {
    LAS unsigned long long* tab; float* out; unsigned char* ws;
    __device__ __forceinline__ const void* in(int k) const { const unsigned long long v = tab[k]; const unsigned lo = __builtin_amdgcn_readfirstlane((unsigned)v), hi = __builtin_amdgcn_readfirstlane((unsigned)(v >> 32)); return (const void*)(const __attribute__((address_space(1))) char*)(((unsigned long long)hi << 32) | lo); }
};

DI unsigned pk2(float lo, float hi) { f32x2_t v = {lo, hi}; bf16x2_t b = __builtin_convertvector(v, bf16x2_t); return __builtin_bit_cast(unsigned, b); }
DI float bf2f(unsigned short b) { return __uint_as_float(((unsigned)b) << 16); }
DI unsigned short f2bf(float f) { return (unsigned short)(pk2(f, 0.f) & 0xffffu); }
DI float sigmoidf_(float x) { return 1.0f / (1.0f + __expf(-x)); }
DI float siluf_(float x) { return x * sigmoidf_(x); }
DI float wave_sum(float v) {
#pragma unroll
    for (int o = 1; o < 64; o <<= 1) v += __shfl_xor(v, o);
    return v;
}
DI int crow(int r, int hi) { return (r & 3) + 8 * (r >> 2) + 4 * hi; }
DI f32x16 mfma32(bf16x8 a, bf16x8 b, f32x16 c) { return __builtin_amdgcn_mfma_f32_32x32x16_bf16(a, b, c, 0, 0, 0); }
DI f32x4 mfma16(bf16x8 a, bf16x8 b, f32x4 c) { return __builtin_amdgcn_mfma_f32_16x16x32_bf16(a, b, c, 0, 0, 0); }
DI u32x2 pk4(f32x4 v) { u32x2 r; r.x = pk2(v[0], v[1]); r.y = pk2(v[2], v[3]); return r; }

DI int map_ident(int n) { return n; }
DI int map_gu(int n) { const int tile = n >> 8, w = n & 255, half = w >> 7, idx = tile * 128 + (w & 127); return idx | (half << 20); }
DI int map_in0(int n) {
    const int tile = n >> 8, w = n & 255;
    if (tile < 4) { const int half = w >> 7, idx = tile * 128 + (w & 127); return half * 512 + idx; }
    if (tile == 4) return 1024 + w;
    if (w < 128) return 1280 + w;
    if (w < 160) { const int i = w - 128; return 1408 + (i & 1) * 16 + (i >> 1); }
    return -1;
}
DI int map_q(int n) { const int h = n / 96, d = n % 96; if (d < 64) return h * 96 + d; const int i = d - 64; return h * 96 + 64 + (i & 1) * 16 + (i >> 1); }
DI int map_kv(int n) {
    if (n < 768) { const int h = n / 96, d = n % 96; if (d < 64) return h * 128 + d; return -2 - (128 + d - 64); }
    const int m = n - 768; return (m >> 6) * 128 + 64 + (m & 63);
}
DI int map_in1(int n) { return n < 3088 ? n : -1; }

template <class MapF>
DI void prep_item(const float* W0, const float* W1, int ldw, int Ksrc, const float* gk, bf16_t* WT, int Kout, int Nout, MapF map, LAS float*, int item, int lane) {
    const int nblk = Nout / 64, kb = item / nblk, nb = item % nblk, k0 = 64 * kb, n = nb * 64 + lane;
    const int sc = map(n);
    const float* W = (sc >= 0 && (sc >> 20)) ? W1 : W0; const int col = sc & 0xFFFFF;
#pragma unroll
    for (int hs = 0; hs < 2; ++hs) {
        float v[32];
#pragma unroll
        for (int i = 0; i < 32; ++i) { const int k = k0 + 32 * hs + i; float x = 0.f;
            if (sc >= 0) { if (k < Ksrc) { x = W[(size_t)k * ldw + col]; if (gk) x *= gk[k]; } }
            else if (sc <= -2) x = (k == -2 - sc) ? 1.f : 0.f;
            v[i] = x; }
#pragma unroll
        for (int j = 0; j < 4; ++j) { u32x4 o; o.x = pk2(v[8 * j], v[8 * j + 1]); o.y = pk2(v[8 * j + 2], v[8 * j + 3]); o.z = pk2(v[8 * j + 4], v[8 * j + 5]); o.w = pk2(v[8 * j + 6], v[8 * j + 7]);
            *(u32x4*)(WT + (size_t)n * Kout + k0 + 32 * hs + 8 * j) = o; }
    }
}

DI void prep_moe(const Args& a, int ib, LAS float* scr, int gw, int ngw, int lane, int gtid, int gthreads) {
    unsigned char* ws = a.ws;
    constexpr int I_GU = (1024 / 64) * (512 / 64), I_D = (256 / 64) * (1024 / 64);
    const int NIT = NEXP * (I_GU + I_D) + I_GU + I_D;
    for (int it = gw; it < NIT; it += ngw) {
        int r = it;
        if (r < NEXP * I_GU) { const int e = r / I_GU; r %= I_GU;
            prep_item((const float*)a.in(ib + 2) + (size_t)e * 1024 * 256, (const float*)a.in(ib + 3) + (size_t)e * 1024 * 256, 256, 1024, nullptr, (bf16_t*)(ws + W_GU) + (size_t)e * 512 * 1024, 1024, 512, map_gu, scr, r, lane); continue; }
        r -= NEXP * I_GU;
        if (r < NEXP * I_D) { const int e = r / I_D; r %= I_D;
            prep_item((const float*)a.in(ib + 4) + (size_t)e * 256 * 1024, nullptr, 1024, 256, nullptr, (bf16_t*)(ws + W_D) + (size_t)e * 1024 * 256, 256, 1024, map_ident, scr, r, lane); continue; }
        r -= NEXP * I_D;
        if (r < I_GU) { prep_item((const float*)a.in(ib + 5), (const float*)a.in(ib + 6), 256, 1024, nullptr, (bf16_t*)(ws + W_SGU), 1024, 512, map_gu, scr, r, lane); continue; }
        r -= I_GU;
        prep_item((const float*)a.in(ib + 7), nullptr, 1024, 256, nullptr, (bf16_t*)(ws + W_SD), 256, 1024, map_ident, scr, r, lane);
    }
    const float* rw = (const float*)a.in(ib);
    bf16_t* rhi = (bf16_t*)(ws + W_RHI); bf16_t* rlo = (bf16_t*)(ws + W_RLO);
    for (int idx = gtid; idx < 64 * 1024; idx += gthreads) { const int n = idx >> 10, k = idx & 1023; const float v = rw[k * 64 + n]; const unsigned short h = f2bf(v); rhi[idx] = h; rlo[idx] = f2bf(v - bf2f(h)); }
}

constexpr int SG_LDS = 49152;
namespace pg8 {
constexpr int BM = 256, BK = 64, HALF = 128, HTB = HALF * BK * 2, STAGE_BYTES = 8 * HTB, NXCD = 8, WGM = 8;
DI int lds_byte(int r, int c) { const int st = (r >> 4) * 2 + (c >> 5), rr = r & 15, cc = c & 31, ob = rr * 64 + cc * 2; return st * 1024 + (ob ^ (((ob >> 9) & 1) << 5)); }
DI void stage_rc(int b, int& R, int& C) { const int st = b / 1024, sb = b % 1024, swz = sb ^ (((sb >> 9) & 1) << 5); R = (st >> 1) * 16 + swz / 64; C = (st & 1) * 32 + (swz % 64) / 2; }
DI int perm32(int rho) { const int n = rho >> 4, i = rho & 15; return 8 * (i >> 2) + 4 * n + (i & 3); }
struct Unit { int pm, pn, e; };

struct DenseOrder {
    int nM, nN, nwg, G, c; const char* Bt; size_t tstepB;
    DI void init(int M, int N, int K, const bf16_t* Bt_, int G_, int c_) { nM = M / BM; nN = N / BM; nwg = nM * nN; G = G_; c = c_; Bt = (const char*)Bt_; tstepB = (size_t)BM * K * 2; }
    DI bool next(int i, Unit& u) const {
        const long L = (long)i * G + c; if (L >= nwg) return false;
        int wgid = (int)L; { const int q = nwg / NXCD, r = nwg % NXCD, xcd = wgid % NXCD, off = wgid / NXCD; wgid = (xcd < r ? xcd * (q + 1) : r * (q + 1) + (xcd - r) * q) + off; }
        const int nig = WGM * nN, gid = wgid / nig, fm = gid * WGM, gsz = (nM - fm) < WGM ? (nM - fm) : WGM;
        u.pm = fm + ((wgid % nig) % gsz); u.pn = (wgid % nig) / gsz; u.e = 0; return true;
    }
    DI const char* bptr(const Unit& u) const { return Bt + (size_t)u.pn * tstepB; }
    static constexpr bool GATHER_A = false;
    DI const int* lptr(const Unit&) const { return nullptr; }
    DI int lcnt(const Unit&) const { return 0; }
    DI unsigned arow0(const Unit& u) const { return (unsigned)(u.pm * BM); }
    DI unsigned arow(const Unit& u, int rt) const { return (unsigned)(u.pm * BM + rt); }
};
DI int find_expert(const LAS int* tstart, int tile) { int e = 0;
#pragma unroll
    for (int s = 32; s > 0; s >>= 1) if (tstart[e + s] <= tile) e += s;
    return e; }
template <bool GATHER> struct GroupedOrder {
    const LAS int* tstart; const LAS int* cntl; int NT, G, c; const char* Bt; size_t estepB, tstepB; const int* LIST; int nshared  ;
    DI bool next(int i, Unit& u) const {
        const int vc = (G % NXCD == 0) ? (c % NXCD) * (G / NXCD) + c / NXCD : c;
        const int L = i * G + vc; if (L >= (tstart[NEXP] + nshared) * NT) return false;
        const int tile = L / NT; u.pn = L - tile * NT;
        if (tile >= tstart[NEXP]) { u.e = NEXP; u.pm = tile - tstart[NEXP]; } else { u.e = find_expert(tstart, tile); u.pm = tile - tstart[u.e]; }
        return true;
    }
    DI const char* bptr(const Unit& u) const { return Bt + (size_t)u.e * estepB + (size_t)u.pn * tstepB; }
    static constexpr bool GATHER_A = GATHER;
    DI const int* lptr(const Unit& u) const { return LIST + (size_t)u.e * LISTCAP + u.pm * BM; }
    DI int lcnt(const Unit& u) const { return cntl[u.e] - u.pm * BM; }
    DI unsigned arow0(const Unit& u) const { return u.e == NEXP ? (unsigned)(HROWS + u.pm * BM) : (unsigned)((tstart[u.e] + u.pm) * BM); }
    DI unsigned arow(const Unit& u, int rt) const {
        if (GATHER) { int i = u.pm * BM + rt; i = i < cntl[u.e] ? i : u.pm * BM; return (unsigned)(LIST[(size_t)u.e * LISTCAP + i] >> 3); }
        return arow0(u) + (unsigned)rt;
    }
};
struct NoMeta {};
struct NoCtx {};
template <int RPF, class CF, class F> struct EpiFn {
    CF cf; F f;
    typedef NoMeta Meta;
    DI Meta prefetch(const Unit&, int, int) const { return Meta{}; }
    DI void operator()(const f32x4 (&acc)[2][2][4][2], const Unit& u, int wr, int wc, int fr, int fq, const Meta&) const {
        const int c = wc * 32 + 8 * fq;
        const auto ctx = cf(u, c);
#pragma unroll
        for (int ai = 0; ai < 2; ++ai)
#pragma unroll
            for (int m = 0; m < 4; ++m) { int r_ = ai * HALF + wr * 64 + m * 16 + fr; asm volatile("" : "+v"(r_));
                f(ctx, u, r_, c, acc[ai][0][m][0], acc[ai][0][m][1], acc[ai][1][m][0], acc[ai][1][m][1]);
                if (((ai * 4 + m) % RPF) == RPF - 1) asm volatile("" ::: "memory"); }
    }
};
template <int RPF, class CF, class F> DI EpiFn<RPF, CF, F> make_epi(const CF& cf, const F& f) { return EpiFn<RPF, CF, F>{cf, f}; }
struct Bias4 { f32x4 b[4]; };
DI Bias4 load_bias4(const float* bias, int col) { Bias4 r; r.b[0] = *(const f32x4*)(bias + col); r.b[1] = *(const f32x4*)(bias + col + 4); r.b[2] = *(const f32x4*)(bias + col + 128); r.b[3] = *(const f32x4*)(bias + col + 132); return r; }

template <class Epi, class Sched>
DI void gemm_phase(LAS unsigned char* lds, const bf16_t* Abase, const int K, const Sched& S, const Epi& E) {
    int tid_ = threadIdx.x; asm volatile("" : "+v"(tid_));
    const int tid = tid_, wid = __builtin_amdgcn_readfirstlane(tid >> 6), lane = tid & 63, wr = wid >> 2, wc = wid & 3, fr = lane & 15, fq = lane >> 4;
    const int nt = K / BK;
    unsigned voffB[2];
#pragma unroll
    for (int i = 0; i < 2; ++i) { int R_, C_; stage_rc(tid * 16 + i * 8192, R_, C_); const int Rb = (R_ & ~31) + perm32(R_ & 31); voffB[i] = (unsigned)(Rb * K + C_) * 2u; }
    const size_t kstep = (size_t)(BK * 2);
    const size_t hstep = (size_t)HALF * K * 2;
    const unsigned ldsw = (unsigned)wid * 1024u;
    const int aoff = lds_byte(wr * 64 + fr, fq * 8), boff = lds_byte(wc * 32 + fr, fq * 8);
#define PG8_SA(b, h) (((b) * 2 + (h)) * HTB)
#define PG8_SB(b, h) ((4 + (b) * 2 + (h)) * HTB)
#define PG8_STAGE(bufoff, gbase, voff) do { _Pragma("unroll") for (int _i = 0; _i < 2; ++_i) \
        __builtin_amdgcn_global_load_lds((const unsigned*)((const char*)(gbase) + (voff)[_i]), (LAS unsigned*)(lds + (bufoff) + ldsw + _i * 8192), 16, 0, 0); } while (0)
#define PG8_LDA(dst, b, h) do { _Pragma("unroll") for (int m = 0; m < 4; ++m) _Pragma("unroll") for (int k = 0; k < 2; ++k) dst[m][k] = *(const LAS bf16x8*)(lds + PG8_SA(b, h) + aoff + m * 2048 + k * 1024); } while (0)
#define PG8_LDB(dst, b, h) do { _Pragma("unroll") for (int n = 0; n < 2; ++n) _Pragma("unroll") for (int k = 0; k < 2; ++k) dst[n][k] = *(const LAS bf16x8*)(lds + PG8_SB(b, h) + boff + n * 2048 + k * 1024); } while (0)
#define PG8_MMA(ai, bj, At, Bt) do { __builtin_amdgcn_s_setprio(1); _Pragma("unroll") for (int m = 0; m < 4; ++m) _Pragma("unroll") for (int n = 0; n < 2; ++n) _Pragma("unroll") for (int k = 0; k < 2; ++k) \
        acc[ai][bj][m][n] = __builtin_amdgcn_mfma_f32_16x16x32_bf16(Bt[n][k], At[m][k], acc[ai][bj][m][n], 0, 0, 0); __builtin_amdgcn_s_setprio(0); } while (0)
#define PG8_WAIT_V(n) asm volatile("s_waitcnt vmcnt(" #n ")" ::: "memory")
#define PG8_WAIT_L(n) asm volatile("s_waitcnt lgkmcnt(" #n ")" ::: "memory")
#define PG8_BAR __builtin_amdgcn_s_barrier()
#define PG8_SCHED __builtin_amdgcn_sched_barrier(0)
#define PG8_AOFFS(dst, u) do { _Pragma("unroll") for (int _i = 0; _i < 2; ++_i) { int R_, C_; stage_rc(tid * 16 + _i * 8192, R_, C_); _Pragma("unroll") for (int _h = 0; _h < 2; ++_h) dst[_h][_i] = (S.arow(u, _h * HALF + R_) * (unsigned)K + (unsigned)C_) * 2u; } } while (0)
    Unit cur, nxt; int ui = 0;
    if (!S.next(0, cur)) return;
#ifndef GEMM_SKEW_TICKS
#define GEMM_SKEW_TICKS 0
#endif
    if (GEMM_SKEW_TICKS > 0) {
        const unsigned long long t0_ = __builtin_amdgcn_s_memrealtime(), dl_ = (unsigned long long)(blockIdx.x % NXCD) * GEMM_SKEW_TICKS;
        while (__builtin_amdgcn_s_memrealtime() - t0_ < dl_) __builtin_amdgcn_s_sleep(4);
    }
    f32x4 acc[2][2][4][2];
#pragma unroll
    for (int a = 0; a < 2; ++a)
#pragma unroll
        for (int b = 0; b < 2; ++b)
#pragma unroll
            for (int m = 0; m < 4; ++m)
#pragma unroll
                for (int n = 0; n < 2; ++n) acc[a][b][m][n] = (f32x4){0.f, 0.f, 0.f, 0.f};
    bf16x8 At[4][2], B0[2][2], B1[2][2];
    constexpr bool GA = Sched::GATHER_A;
    unsigned vcur[2][2], vnxt[2][2];
    const char* const Ab = (const char*)Abase;
    const char* cA = Ab;
    if constexpr (GA) { PG8_AOFFS(vcur, cur); }
    else {
#pragma unroll
        for (int i = 0; i < 2; ++i) { int R_, C_; stage_rc(tid * 16 + i * 8192, R_, C_); vcur[0][i] = (unsigned)(R_ * K + C_) * 2u; vcur[1][i] = vcur[0][i]; }
        cA = Ab + (size_t)S.arow0(cur) * K * 2;
    }
    const size_t ah = GA ? (size_t)0 : hstep;
    const char* cB = S.bptr(cur);
    typename Epi::Meta meta = E.prefetch(cur, wr, fr);
    PG8_STAGE(PG8_SB(0, 0), cB, voffB); PG8_STAGE(PG8_SB(0, 1), cB + hstep, voffB); PG8_STAGE(PG8_SA(0, 0), cA, vcur[0]); PG8_STAGE(PG8_SA(0, 1), cA + ah, vcur[1]);
    if (wr == 1) PG8_BAR;
    PG8_WAIT_V(2); PG8_BAR;
    PG8_STAGE(PG8_SB(1, 0), cB + kstep, voffB); PG8_STAGE(PG8_SA(1, 0), cA + kstep, vcur[0]); PG8_STAGE(PG8_SB(1, 1), cB + hstep + kstep, voffB);
    PG8_WAIT_V(6); PG8_BAR;
    for (;;) {
        const bool has_next = S.next(ui + 1, nxt);
        const char* nB = cB; const char* nA = cA;
        if (has_next) { nB = S.bptr(nxt);
            if constexpr (GA) {
                const int* lp_ = S.lptr(nxt); const int cn_ = S.lcnt(nxt);
#pragma unroll
                for (int i = 0; i < 2; ++i) { int R_, C_; stage_rc(tid * 16 + i * 8192, R_, C_);
#pragma unroll
                    for (int h = 0; h < 2; ++h) { int rt_ = h * HALF + R_; rt_ = rt_ < cn_ ? rt_ : 0; const int* p_ = lp_ + rt_; asm volatile("global_load_dword %0, %1, off" : "=v"(vnxt[h][i]) : "v"(p_) : "memory"); } }
            } else nA = Ab + (size_t)S.arow0(nxt) * K * 2; }
        else if constexpr (GA) {
#pragma unroll
            for (int h = 0; h < 2; ++h)
#pragma unroll
                for (int i = 0; i < 2; ++i) vnxt[h][i] = vcur[h][i];
        }
#pragma unroll 1
        for (int t = 0; t < nt; t += 2) {
            const bool last = (t == nt - 2);
            const char* a1 = cA + (size_t)(t + 1) * kstep;
            const char* a2 = last ? nA : cA + (size_t)(t + 2) * kstep; const char* b2 = last ? nB : cB + (size_t)(t + 2) * kstep;
            const char* a3 = a2 + kstep; const char* b3 = b2 + kstep;
            if constexpr (GA) { if (last && has_next) {
                asm volatile("" : "+v"(vnxt[0][0]), "+v"(vnxt[0][1]), "+v"(vnxt[1][0]), "+v"(vnxt[1][1]));
#pragma unroll
                for (int i = 0; i < 2; ++i) { int R_, C_; stage_rc(tid * 16 + i * 8192, R_, C_);
#pragma unroll
                    for (int h = 0; h < 2; ++h) vnxt[h][i] = ((vnxt[h][i] >> 3) * (unsigned)K + (unsigned)C_) * 2u; } } }
            unsigned v2[2][2];
#pragma unroll
            for (int h = 0; h < 2; ++h)
#pragma unroll
                for (int i = 0; i < 2; ++i) v2[h][i] = (GA && last) ? vnxt[h][i] : vcur[h][i];
            PG8_LDB(B0, 0, 0); PG8_LDB(B1, 0, 1); PG8_SCHED; PG8_LDA(At, 0, 0); PG8_STAGE(PG8_SA(1, 1), a1 + ah, vcur[1]);
            PG8_WAIT_V(8); PG8_WAIT_L(0); PG8_BAR; PG8_MMA(0, 0, At, B0); PG8_MMA(0, 1, At, B1); PG8_BAR; PG8_SCHED;
            PG8_LDA(At, 0, 1); PG8_STAGE(PG8_SB(0, 0), b2, voffB); PG8_STAGE(PG8_SB(0, 1), b2 + hstep, voffB); PG8_STAGE(PG8_SA(0, 0), a2, v2[0]);
            PG8_WAIT_V(8); PG8_WAIT_L(0); PG8_BAR; PG8_MMA(1, 0, At, B0); PG8_MMA(1, 1, At, B1); PG8_BAR; PG8_SCHED;
            PG8_LDB(B0, 1, 0); PG8_LDB(B1, 1, 1); PG8_SCHED; PG8_LDA(At, 1, 0); PG8_STAGE(PG8_SA(0, 1), a2 + ah, v2[1]);
            PG8_WAIT_V(8); PG8_WAIT_L(0); PG8_BAR; PG8_MMA(0, 0, At, B0); PG8_MMA(0, 1, At, B1); PG8_BAR; PG8_SCHED;
            PG8_LDA(At, 1, 1); PG8_STAGE(PG8_SB(1, 0), b3, voffB); PG8_STAGE(PG8_SB(1, 1), b3 + hstep, voffB); PG8_STAGE(PG8_SA(1, 0), a3, v2[0]);
            PG8_WAIT_V(8); PG8_WAIT_L(0); PG8_BAR; PG8_MMA(1, 0, At, B0); PG8_MMA(1, 1, At, B1); PG8_BAR; PG8_SCHED;
        }
        if (wr == 0) PG8_BAR;
        { int fr_ = fr, fq_ = fq; asm volatile("" : "+v"(fr_), "+v"(fq_));
          E(acc, cur, wr, wc, fr_, fq_, meta); }
        if (!has_next) break;
#pragma unroll
        for (int a = 0; a < 2; ++a)
#pragma unroll
            for (int b = 0; b < 2; ++b)
#pragma unroll
                for (int m = 0; m < 4; ++m)
#pragma unroll
                    for (int n = 0; n < 2; ++n) acc[a][b][m][n] = (f32x4){0.f, 0.f, 0.f, 0.f};
        cur = nxt; cB = nB; cA = nA; ++ui;
        meta = E.prefetch(cur, wr, fr);
        if constexpr (GA) {
#pragma unroll
            for (int h = 0; h < 2; ++h)
#pragma unroll
                for (int i = 0; i < 2; ++i) vcur[h][i] = vnxt[h][i];
        }
        if (wr == 1) PG8_BAR;
    }
    PG8_WAIT_V(0);
    PG8_BAR;
#undef PG8_SA
#undef PG8_SB
#undef PG8_STAGE
#undef PG8_LDA
#undef PG8_LDB
#undef PG8_MMA
#undef PG8_WAIT_V
#undef PG8_WAIT_L
#undef PG8_BAR
#undef PG8_SCHED
#undef PG8_AOFFS
}
}
DI u32x4 pk8(f32x4 a, f32x4 b) { u32x4 o; o.x = pk2(a[0], a[1]); o.y = pk2(a[2], a[3]); o.z = pk2(b[0], b[1]); o.w = pk2(b[2], b[3]); return o; }
struct EpiDown {
    const LAS int* cntl; const int* LIST; const float* LISTW; unsigned char* YT;
    struct Meta { int raw[2][4]; float w[2][4]; unsigned ok; };
    DI Meta prefetch(const pg8::Unit& u, int wr, int fr) const {
        Meta m; m.ok = 0u;
        if (u.e == NEXP) {
#pragma unroll
            for (int ai = 0; ai < 2; ++ai)
#pragma unroll
                for (int mm = 0; mm < 4; ++mm) { const int i = u.pm * 256 + ai * 128 + wr * 64 + mm * 16 + fr; m.raw[ai][mm] = (i << 3) | 6; m.w[ai][mm] = 1.0f; }
            m.ok = 0xffu;
        } else {
            const int cn = cntl[u.e] - u.pm * 256; const size_t base = (size_t)u.e * LISTCAP + u.pm * 256;
#pragma unroll
            for (int ai = 0; ai < 2; ++ai)
#pragma unroll
                for (int mm = 0; mm < 4; ++mm) { const int rt = ai * 128 + wr * 64 + mm * 16 + fr; const bool ok = rt < cn; m.ok |= ok ? (1u << (ai * 4 + mm)) : 0u;
                    const int* p1 = LIST + base + (ok ? rt : 0); const float* p2 = LISTW + base + (ok ? rt : 0);
                    asm volatile("global_load_dword %0, %1, off" : "=v"(m.raw[ai][mm]) : "v"(p1) : "memory");
                    asm volatile("global_load_dword %0, %1, off" : "=v"(m.w[ai][mm]) : "v"(p2) : "memory"); }
        }
        return m;
    }
    DI void operator()(const f32x4 (&acc)[2][2][4][2], const pg8::Unit& u, int wr, int wc, int fr, int fq, const Meta& m0) const {
        Meta m = m0;
        asm volatile("" : "+v"(m.raw[0][0]), "+v"(m.raw[0][1]), "+v"(m.raw[0][2]), "+v"(m.raw[0][3]), "+v"(m.raw[1][0]), "+v"(m.raw[1][1]), "+v"(m.raw[1][2]), "+v"(m.raw[1][3]));
        asm volatile("" : "+v"(m.w[0][0]), "+v"(m.w[0][1]), "+v"(m.w[0][2]), "+v"(m.w[0][3]), "+v"(m.w[1][0]), "+v"(m.w[1][1]), "+v"(m.w[1][2]), "+v"(m.w[1][3]));
#pragma unroll
        for (int ai = 0; ai < 2; ++ai)
#pragma unroll
            for (int mm = 0; mm < 4; ++mm) { const int v = m.raw[ai][mm]; const float w = m.w[ai][mm] * YSCALE;
                if ((m.ok >> (ai * 4 + mm)) & 1u) { unsigned char* p = YT + (size_t)((v >> 3) * 7 + (v & 7)) * 1024 + u.pn * 256 + wc * 32 + 8 * fq;
#pragma unroll
                    for (int bj = 0; bj < 2; ++bj) { const f32x4 a0 = acc[ai][bj][mm][0] * w, a1 = acc[ai][bj][mm][1] * w; u32x2 o;
                        int t = __builtin_amdgcn_cvt_pk_fp8_f32(a0[0], a0[1], 0, false); t = __builtin_amdgcn_cvt_pk_fp8_f32(a0[2], a0[3], t, true); o.x = (unsigned)t;
                        t = __builtin_amdgcn_cvt_pk_fp8_f32(a1[0], a1[1], 0, false); t = __builtin_amdgcn_cvt_pk_fp8_f32(a1[2], a1[3], t, true); o.y = (unsigned)t;
                        *(u32x2*)(p + 128 * bj) = o; } } }
    }
};
DI float dot4(f32x4 a) { return (a[0] * a[0] + a[1] * a[1]) + (a[2] * a[2] + a[3] * a[3]); }
DI void rope8(f32x4& v0, f32x4& v1, const float* ct, const float* st, size_t row, int p) {
    const f32x4 cs = *(const f32x4*)(ct + row * 16 + p), sn = *(const f32x4*)(st + row * 16 + p);
    float a, b;
    a = v0[0]; b = v0[1]; v0[0] = a * cs[0] - b * sn[0]; v0[1] = b * cs[0] + a * sn[0];
    a = v0[2]; b = v0[3]; v0[2] = a * cs[1] - b * sn[1]; v0[3] = b * cs[1] + a * sn[1];
    a = v1[0]; b = v1[1]; v1[0] = a * cs[2] - b * sn[2]; v1[1] = b * cs[2] + a * sn[2];
    a = v1[2]; b = v1[3]; v1[2] = a * cs[3] - b * sn[3]; v1[3] = b * cs[3] + a * sn[3];
}

struct EpiIn1 {
    const float* bias; bf16_t* Q1; bf16_t* K1; bf16_t* V1; float* GL; unsigned* NRM;
    typedef pg8::NoMeta Meta;
    DI Meta prefetch(const pg8::Unit&, int, int) const { return Meta{}; }
    DI void operator()(const f32x4 (&acc)[2][2][4][2], const pg8::Unit& u, int wr, int wc, int fr, int fq, const Meta&) const {
        const int nt = u.pn, c = wc * 32 + 8 * fq;
        const pg8::Bias4 bb = pg8::load_bias4(bias, nt * 256 + c);
        float mx0 = 0.f, mx1 = 0.f;
#pragma unroll
        for (int ai = 0; ai < 2; ++ai)
#pragma unroll
            for (int m = 0; m < 4; ++m) { int r_ = ai * 128 + wr * 64 + m * 16 + fr; asm volatile("" : "+v"(r_));
                const size_t row = (size_t)u.pm * 256 + r_;
                f32x4 l0 = acc[ai][0][m][0] + bb.b[0], l1 = acc[ai][0][m][1] + bb.b[1], h0 = acc[ai][1][m][0] + bb.b[2], h1 = acc[ai][1][m][1] + bb.b[3];
                if (nt < 4) { l0 = l0 * C2_FOX; l1 = l1 * C2_FOX; h0 = h0 * C2_FOX; h1 = h1 * C2_FOX;
                    *(u32x4*)(Q1 + row * 1024 + nt * 256 + c) = pk8(l0, l1); *(u32x4*)(Q1 + row * 1024 + nt * 256 + 128 + c) = pk8(h0, h1); }
                else if (nt < 8) { *(u32x4*)(K1 + row * 1024 + (nt - 4) * 256 + c) = pk8(l0, l1); *(u32x4*)(K1 + row * 1024 + (nt - 4) * 256 + 128 + c) = pk8(h0, h1); }
                else if (nt < 12) { *(u32x4*)(V1 + row * 1024 + (nt - 8) * 256 + c) = pk8(l0, l1); *(u32x4*)(V1 + row * 1024 + (nt - 8) * 256 + 128 + c) = pk8(h0, h1); }
                else if (c < 16) {
#pragma unroll
                    for (int i = 0; i < 4; ++i) { float x = l0[i]; l0[i] = fminf(x, 0.f) - log1pf(__expf(-fabsf(x))); x = l1[i]; l1[i] = fminf(x, 0.f) - log1pf(__expf(-fabsf(x))); }
                    *(f32x4*)(GL + row * 16 + c) = l0; *(f32x4*)(GL + row * 16 + c + 4) = l1; }
                if (nt < 8) { float s0 = dot4(l0) + dot4(l1), s1 = dot4(h0) + dot4(h1);
                    s0 += __shfl_xor(s0, 16); s0 += __shfl_xor(s0, 32); s1 += __shfl_xor(s1, 16); s1 += __shfl_xor(s1, 32);
                    mx0 = fmaxf(mx0, s0); mx1 = fmaxf(mx1, s1); }
                asm volatile("" ::: "memory"); }
        if (nt < 8) {
#pragma unroll
            for (int o = 1; o < 16; o <<= 1) { mx0 = fmaxf(mx0, __shfl_xor(mx0, o)); mx1 = fmaxf(mx1, __shfl_xor(mx1, o)); }
            if (fr == 0 && fq == 0) { const int b = u.pm >> 4, which = nt >> 2, head0 = (nt & 3) * 4 + (wc >> 1), half = wc & 1;
                atomicMax(NRM + ((which * 8 + b) * 16 + head0) * 2 + half, __float_as_uint(mx0)); atomicMax(NRM + ((which * 8 + b) * 16 + head0 + 2) * 2 + half, __float_as_uint(mx1)); }
        }
    }
};

typedef short v4i16_t __attribute__((ext_vector_type(4)));
DI s16x4 lds_tr(const LAS unsigned char* p) { return __builtin_bit_cast(s16x4, __builtin_amdgcn_ds_read_tr16_b64_v4i16((LAS v4i16_t*)p)); }
constexpr int MLA_KS = 208, MLA_KB = 64 * MLA_KS, MLA_BUF = MLA_KB + 8192, MLA_LDS = 2 * MLA_BUF;
DI void attn_mla_unit(LAS unsigned char* lds, const bf16_t* Q, const bf16_t* K, const bf16_t* V, bf16_t* O, int b, int h, int qb) {
    constexpr int DK = 96, QP = 768, KP = 768, VP = 512, OP = 1024;
    int tid_ = threadIdx.x; asm volatile("" : "+v"(tid_));
    const int tid = tid_, lane = tid & 63, wid = tid >> 6, r32 = lane & 31, hi = lane >> 5;
    const size_t rowbase = (size_t)b * SEQ; const int q0 = qb * 256, qw = q0 + 32 * wid, hq = h * 96, hv = h * 64, ho = 512 + h * 64;
    bf16x8 qr[DK / 16];
#pragma unroll
    for (int d0 = 0; d0 < DK / 16; ++d0) qr[d0] = *(const bf16x8*)(Q + (rowbase + qw + r32) * QP + hq + 16 * d0 + 8 * hi);
    f32x16 o0, o1;
#pragma unroll
    for (int i = 0; i < 16; ++i) { o0[i] = 0.f; o1[i] = 0.f; }
    float mhat = 0.f, l = 0.f; bool first = true;
    const int ntile = (q0 + 256) / 64;
    const int kr0 = tid / 12, kc0 = tid % 12, kr1 = (tid + 512) / 12, kc1 = (tid + 512) % 12; const bool k1 = tid < 256;
    const int vr_ = tid >> 3, vc_ = tid & 7;
    const bf16_t* kp0 = K + (rowbase + kr0) * KP + hq + kc0 * 8; const bf16_t* kp1 = K + (rowbase + kr1) * KP + hq + kc1 * 8; const bf16_t* vp = V + (rowbase + vr_) * VP + hv + vc_ * 8;
    const int ko0 = kr0 * MLA_KS + kc0 * 16, ko1 = kr1 * MLA_KS + kc1 * 16, vo = MLA_KB + (vc_ >> 2) * 4096 + vr_ * 64 + (vc_ & 3) * 16;
    u32x4 ka = *(const u32x4*)kp0, kb = (u32x4){0u, 0u, 0u, 0u}, va = *(const u32x4*)vp; if (k1) kb = *(const u32x4*)kp1;
    __syncthreads();
    *(LAS u32x4*)(lds + ko0) = ka; if (k1) *(LAS u32x4*)(lds + ko1) = kb; *(LAS u32x4*)(lds + vo) = va;
    __syncthreads();
    const int vrd = ((lane >> 4) & 1) * 32 + (lane & 3) * 8 + (4 * hi + ((lane & 15) >> 2)) * 64;
    for (int jt = 0; jt < ntile; ++jt) {
        const int kv0 = jt * 64;
        if (jt + 1 < ntile) { const size_t adv = (size_t)(kv0 + 64); ka = *(const u32x4*)(kp0 + adv * KP); if (k1) kb = *(const u32x4*)(kp1 + adv * KP); va = *(const u32x4*)(vp + adv * VP); }
        const LAS unsigned char* Kb = lds + (jt & 1) * MLA_BUF; const LAS unsigned char* Vb = Kb + MLA_KB;
        if (kv0 <= qw + 31) {
            f32x16 p0, p1; const float nm = -mhat;
#pragma unroll
            for (int i = 0; i < 16; ++i) { p0[i] = nm; p1[i] = nm; }
#pragma unroll
            for (int d0 = 0; d0 < DK / 16; ++d0) {
                const bf16x8 a0 = *(const LAS bf16x8*)(Kb + r32 * MLA_KS + (16 * d0 + 8 * hi) * 2), a1 = *(const LAS bf16x8*)(Kb + (32 + r32) * MLA_KS + (16 * d0 + 8 * hi) * 2);
                p0 = mfma32(a0, qr[d0], p0); p1 = mfma32(a1, qr[d0], p1);
            }
            if (kv0 + 63 > qw) { const int q = qw + r32;
#pragma unroll
                for (int i = 0; i < 16; ++i) { const int kv = kv0 + crow(i, hi); if (kv > q) p0[i] = -INFINITY; if (kv + 32 > q) p1[i] = -INFINITY; } }
            float rm = fmaxf(p0[0], p1[0]);
#pragma unroll
            for (int i = 1; i < 16; ++i) rm = fmaxf(rm, fmaxf(p0[i], p1[i]));
            rm = fmaxf(rm, __shfl_xor(rm, 32));
            if (first) {
                first = false; mhat = rm;
#pragma unroll
                for (int i = 0; i < 16; ++i) { p0[i] -= rm; p1[i] -= rm; }
            } else if (__any(rm > 8.0f)) {
                const float dl = fmaxf(rm, 0.f); mhat += dl;
                const float f = __builtin_amdgcn_exp2f(-dl); l *= f;
#pragma unroll
                for (int i = 0; i < 16; ++i) { p0[i] -= dl; p1[i] -= dl; const float fi = __shfl(f, crow(i, hi)); o0[i] *= fi; o1[i] *= fi; }
            }
            float rs = 0.f;
#pragma unroll
            for (int i = 0; i < 16; ++i) { p0[i] = __builtin_amdgcn_exp2f(p0[i]); p1[i] = __builtin_amdgcn_exp2f(p1[i]); rs += p0[i] + p1[i]; }
            l += rs;
            bf16x8 pf[4];
            pf[0] = __builtin_bit_cast(bf16x8, pk8((f32x4){p0[0], p0[1], p0[2], p0[3]}, (f32x4){p0[4], p0[5], p0[6], p0[7]}));
            pf[1] = __builtin_bit_cast(bf16x8, pk8((f32x4){p0[8], p0[9], p0[10], p0[11]}, (f32x4){p0[12], p0[13], p0[14], p0[15]}));
            pf[2] = __builtin_bit_cast(bf16x8, pk8((f32x4){p1[0], p1[1], p1[2], p1[3]}, (f32x4){p1[4], p1[5], p1[6], p1[7]}));
            pf[3] = __builtin_bit_cast(bf16x8, pk8((f32x4){p1[8], p1[9], p1[10], p1[11]}, (f32x4){p1[12], p1[13], p1[14], p1[15]}));
#pragma unroll
            for (int ks = 0; ks < 4; ++ks) {
                { const s16x4 lo = lds_tr(Vb + vrd + ks * 1024), hh = lds_tr(Vb + vrd + ks * 1024 + 512);
                  o0 = mfma32(pf[ks], __builtin_shufflevector(lo, hh, 0, 1, 2, 3, 4, 5, 6, 7), o0); }
                { const s16x4 lo = lds_tr(Vb + 4096 + vrd + ks * 1024), hh = lds_tr(Vb + 4096 + vrd + ks * 1024 + 512);
                  o1 = mfma32(pf[ks], __builtin_shufflevector(lo, hh, 0, 1, 2, 3, 4, 5, 6, 7), o1); }
            }
        }
        if (jt + 1 < ntile) { LAS unsigned char* nb = lds + ((jt + 1) & 1) * MLA_BUF; *(LAS u32x4*)(nb + ko0) = ka; if (k1) *(LAS u32x4*)(nb + ko1) = kb; *(LAS u32x4*)(nb + vo) = va; }
        __syncthreads();
    }
    l += __shfl_xor(l, 32);
    const float inv = 1.0f / l;
#pragma unroll
    for (int i = 0; i < 16; ++i) { const float ii = __shfl(inv, crow(i, hi)); const size_t row = rowbase + qw + crow(i, hi);
        O[row * OP + ho + r32] = f2bf(o0[i] * ii); O[row * OP + ho + 32 + r32] = f2bf(o1[i] * ii); }
}

namespace attn_fox {
using bf16=unsigned short;
constexpr int BATCH=8,NHEAD=16,SEQ=4096,D=64,DM=NHEAD*D;
constexpr int NW=8,QBLK=32,QB=QBLK*NW,KVBLK=64,NQB=SEQ/QB;
constexpr int ATTN_PITCH=DM, ATTN_UNIT_ROWS=QB;
__device__ __forceinline__ int crow(int r,int hi){return (r&3)+8*(r>>2)+4*hi;}
#define SBAR() __builtin_amdgcn_sched_barrier(0)
__device__ __forceinline__ void cmask(f32x16&p0,f32x16&p1,int jb,int qrel,int hi){
  const float NEG=-INFINITY; int kb=64*jb+4*hi;
  #pragma unroll
  for(int r=0;r<16;++r){int kv=kb+(r&3)+8*(r>>2); if(kv>qrel)p0[r]=NEG; if(kv+32>qrel)p1[r]=NEG;}
}

constexpr int NSLOT=3, SLOTB=8192;
constexpr int LDS_K=0, LDS_V=NSLOT*SLOTB, LDS_WS=2*NSLOT*SLOTB, LDS_OST=LDS_WS+NW*64*4, LDS_CK=LDS_OST+NW*4096, LDS_BYTES=LDS_CK+SEQ*4;
constexpr float C2=0.125f*1.4426950408889634f;
__device__ __forceinline__ void glds16(const void*gsrc,unsigned lds_dst){unsigned keep;
  asm volatile("s_mov_b32 %0, m0\n\ts_mov_b32 m0, %2\n\ts_nop 0\n\tglobal_load_lds_dwordx4 %1, off\n\ts_mov_b32 m0, %0":"=&s"(keep):"v"(gsrc),"s"(lds_dst):"memory");}
__device__ __forceinline__ float max3f(float a,float b,float c){float r;asm("v_max3_f32 %0, %1, %2, %3":"=v"(r):"v"(a),"v"(b),"v"(c));return r;}
__device__ __forceinline__ float max2f(float a,float b){float r;asm("v_max_f32_e32 %0, %1, %2":"=v"(r):"v"(a),"v"(b));return r;}
__device__ __forceinline__ float fadd_s(float a,float b){float r;asm("v_add_f32_e32 %0, %1, %2":"=v"(r):"v"(a),"v"(b));return r;}
__device__ __forceinline__ float fsub_s(float a,float b){float r;asm("v_sub_f32_e32 %0, %1, %2":"=v"(r):"v"(a),"v"(b));return r;}
typedef float f32x2_t __attribute__((ext_vector_type(2))); typedef __bf16 bf16x2_t __attribute__((ext_vector_type(2)));
__device__ __forceinline__ unsigned cvtpk_s(float lo,float hi){f32x2_t v={lo,hi};bf16x2_t b=__builtin_convertvector(v,bf16x2_t);return __builtin_bit_cast(unsigned,b);}
#define WAIT_BAR(N) asm volatile("s_waitcnt vmcnt(" #N ") lgkmcnt(0)\n\ts_barrier":::"memory")

__device__ __forceinline__ void qkt(f32x16&p0,f32x16&p1,const char*Kslot,const bf16x8*qr,int r32,int hi){
  const char*kb=Kslot+hi*1024+r32*16;
  #pragma unroll
  for(int d0=0;d0<4;++d0){
    const bf16x8 b0=*reinterpret_cast<const bf16x8*>(kb+d0*2048);
    const bf16x8 b1=*reinterpret_cast<const bf16x8*>(kb+d0*2048+512);
    p0=__builtin_amdgcn_mfma_f32_32x32x16_bf16(b0,qr[d0],p0,0,0,0);p1=__builtin_amdgcn_mfma_f32_32x32x16_bf16(b1,qr[d0],p1,0,0,0);}
}
typedef __attribute__((address_space(3))) const char* lds_cptr;
typedef __attribute__((address_space(3))) const float* lds_fptr;
typedef short v4i16_t __attribute__((ext_vector_type(4)));
__device__ __forceinline__ void kload8(bf16x8*kf,lds_cptr kp){
  kf[0]=*(const __attribute__((address_space(3))) bf16x8*)(kp);      kf[1]=*(const __attribute__((address_space(3))) bf16x8*)(kp+512);
  kf[2]=*(const __attribute__((address_space(3))) bf16x8*)(kp+2048); kf[3]=*(const __attribute__((address_space(3))) bf16x8*)(kp+2560);
  kf[4]=*(const __attribute__((address_space(3))) bf16x8*)(kp+4096); kf[5]=*(const __attribute__((address_space(3))) bf16x8*)(kp+4608);
  kf[6]=*(const __attribute__((address_space(3))) bf16x8*)(kp+6144); kf[7]=*(const __attribute__((address_space(3))) bf16x8*)(kp+6656);
}
__device__ __forceinline__ void kload2(bf16x8*kf,lds_cptr kp,int j){ kf[2*j]=*(const __attribute__((address_space(3))) bf16x8*)(kp+j*2048); kf[2*j+1]=*(const __attribute__((address_space(3))) bf16x8*)(kp+j*2048+512); }
__device__ __forceinline__ s16x4 vtr(lds_cptr p){ return __builtin_bit_cast(s16x4,__builtin_amdgcn_ds_read_tr16_b64_v4i16((__attribute__((address_space(3))) v4i16_t*)p)); }
__device__ __forceinline__ float rowmax(const f32x16&p0,const f32x16&p1){
  float a=max3f(p0[0],p0[1],p1[0]),b=max3f(p0[2],p0[3],p1[1]);a=max3f(a,p1[2],p1[3]);
  #pragma unroll
  for(int r=4;r<16;r+=4){a=max3f(a,p0[r],p0[r+1]);b=max3f(b,p0[r+2],p0[r+3]);a=max3f(a,p1[r],p1[r+1]);b=max3f(b,p1[r+2],p1[r+3]);}
  const float m=max2f(a,b);
  auto rr=__builtin_amdgcn_permlane32_swap(__float_as_uint(m),__float_as_uint(m),false,false);
  return max2f(__uint_as_float(rr[0]),__uint_as_float(rr[1]));
}
__device__ __forceinline__ void pv(f32x16*o,int vb,bf16x8 pa0,bf16x8 pa1,bf16x8 pa2,bf16x8 pa3){
  #pragma unroll
  for(int d0=0;d0<2;++d0){s16x4 lo[4],hi[4];
    #pragma unroll
    for(int ks=0;ks<4;++ks){
      asm volatile("ds_read_b64_tr_b16 %0,%1 offset:%c2":"=&v"(lo[ks]):"v"(vb),"i"(d0*4096+ks*1024):"memory");
      asm volatile("ds_read_b64_tr_b16 %0,%1 offset:%c2":"=&v"(hi[ks]):"v"(vb),"i"(d0*4096+ks*1024+512):"memory");}
    asm volatile("s_waitcnt lgkmcnt(0)":::"memory");SBAR();
    #define PK(k) (bf16x8){lo[k][0],lo[k][1],lo[k][2],lo[k][3],hi[k][0],hi[k][1],hi[k][2],hi[k][3]}
    o[d0]=__builtin_amdgcn_mfma_f32_32x32x16_bf16(pa0,PK(0),o[d0],0,0,0);
    o[d0]=__builtin_amdgcn_mfma_f32_32x32x16_bf16(pa1,PK(1),o[d0],0,0,0);
    o[d0]=__builtin_amdgcn_mfma_f32_32x32x16_bf16(pa2,PK(2),o[d0],0,0,0);
    o[d0]=__builtin_amdgcn_mfma_f32_32x32x16_bf16(pa3,PK(3),o[d0],0,0,0);
    #undef PK
  }
}

#ifndef ATTN_STORE16
#define ATTN_STORE16(p,v) (*(u32x4*)(p)=(v))
#endif
template<int THRL> __device__ __forceinline__ void attn_unit(int b,int h,int qb,const bf16*Q,const bf16*__restrict__ K,const bf16*__restrict__ V,bf16*O,const float*__restrict__ CKH,const float*__restrict__ NRM,char*shm){
  const int tid=threadIdx.x,lane=tid&63,r32=lane&31,hi=lane>>5; const int wid=__builtin_amdgcn_readfirstlane(tid>>6);
  const long rowbase=(long)b*SEQ; const int q0=qb*QB;
  const bf16*Qw=Q+(rowbase+q0+wid*QBLK)*DM+h*D;
  const bf16*Kh=K+rowbase*DM+h*D,*Vh=V+rowbase*DM+h*D;
  const unsigned lds0=(unsigned)(uintptr_t)shm;
  float*wsf=(float*)(shm+LDS_WS)+wid*64;
  const bf16*ksrc=Kh+(long)lane*DM+wid*8;
  const bf16*vsrc=Vh+(long)(16*(wid&3)+(lane>>2))*DM+(wid>>2)*32+(lane&3)*8;
  const unsigned kdst=lds0+LDS_K+wid*1024, vdst=lds0+LDS_V+wid*1024;
  #define DMA_K(t,slot) glds16(ksrc+(long)((t)+T0)*KVBLK*DM,(unsigned)__builtin_amdgcn_readfirstlane(kdst+(slot)))
  #define DMA_V(t,slot) glds16(vsrc+(long)((t)+T0)*KVBLK*DM,(unsigned)__builtin_amdgcn_readfirstlane(vdst+(slot)))
  const int vb0=(int)(lds0+LDS_V)+((lane>>4)&1)*32+(lane&3)*8+(4*hi+((lane&15)>>2))*64;
  const char*Kbase=shm+LDS_K; bf16x8 kf[8];
  const lds_cptr shm3=(lds_cptr)shm; const lds_cptr kp0=shm3+LDS_K+hi*1024+r32*16; const lds_cptr vp0=shm3+LDS_V+((lane>>4)&1)*32+(lane&3)*8+(4*hi+((lane&15)>>2))*64;
  const int NT=(q0+QB)/KVBLK;
  const float*ckg=CKH+((long)b*NHEAD+h)*SEQ; float*ckl=(float*)(shm+LDS_CK); const lds_fptr ckl3=(lds_fptr)(shm3+LDS_CK);
  f32x4 ckv0=f32x4{0.f,0.f,0.f,0.f},ckv1=f32x4{0.f,0.f,0.f,0.f}; if(tid*4<q0+QB)ckv0=*reinterpret_cast<const f32x4*>(ckg+tid*4); if(2048+tid*4<q0+QB)ckv1=*reinterpret_cast<const f32x4*>(ckg+2048+tid*4);
  int T0;
  { const float*nr=NRM+((long)b*NHEAD+h)*2; const float qn=nr[0]+nr[1], kn=nr[BATCH*NHEAD*2]+nr[BATCH*NHEAD*2+1];
    const float bnd=__builtin_sqrtf(qn)*__builtin_sqrtf(kn)*1.02f+1.0f; const float cq0=ckg[q0];
    const float cj=(lane<NT)?ckg[64*lane+63]:0.f; const bool sk=(lane<NT)&&(bnd+cq0-cj<-160.f);
    const int ns=__builtin_popcountll(__ballot(sk)); T0=ns&~1; if(T0>NT-4)T0=NT-4; T0=__builtin_amdgcn_readfirstlane(T0); }
  const int NTL=NT-T0;
  const float cq=ckg[q0+wid*QBLK+r32];
  DMA_K(0,0);DMA_V(0,0);DMA_K(1,SLOTB);
  bf16x8 qr[4];
  #pragma unroll
  for(int d0=0;d0<4;++d0)qr[d0]=*reinterpret_cast<const bf16x8*>(&Qw[(long)r32*DM+d0*16+hi*8]);
  float mhat=-cq,l_reg=0.f;f32x16 o[2];o[0]=f32x16{};o[1]=f32x16{};
  const int qrel=wid*QBLK+r32;
  #define CMASK(P0,P1,t) do{int jb_=(t)-(NTL-4); if(jb_>=0)cmask(P0,P1,jb_,qrel,hi);}while(0)
  bool resc=false;
  #define START(P0,P1) do{ const float rm=rowmax(P0,P1); resc=false; \
    { const float dl=__builtin_fmaxf(rm,0.f); mhat=fadd_s(mhat,dl); \
      _Pragma("unroll") for(int r=0;r<16;++r){P0[r]=fsub_s(P0[r],dl);P1[r]=fsub_s(P1[r],dl);} } \
    _Pragma("unroll") for(int r=0;r<16;++r)P0[r]=__builtin_amdgcn_exp2f(P0[r]); }while(0)
  #define RESC() do{ if(resc){ asm volatile("s_waitcnt lgkmcnt(0)":::"memory"); \
      _Pragma("unroll") for(int d_=0;d_<2;++d_) _Pragma("unroll") for(int r=0;r<16;++r)o[d_][r]*=wsf[crow(r,hi)]; } }while(0)
  #define BGRP(X,g,base) do{ const f32x4 cv_=*(const __attribute__((address_space(3))) f32x4*)(ckl3+(base)+8*(g)+4*hi); const float nm_=-mhat; \
      X[4*(g)]=nm_-cv_[0]; X[4*(g)+1]=nm_-cv_[1]; X[4*(g)+2]=nm_-cv_[2]; X[4*(g)+3]=nm_-cv_[3]; }while(0)
  #define BINIT(X0,X1,tt) do{ _Pragma("unroll") for(int g_=0;g_<4;++g_){ BGRP(X0,g_,64*((tt)+T0)); BGRP(X1,g_,64*((tt)+T0)+32); } }while(0)
  f32x16 pA0,pA1,pB0,pB1;
  int sl_prev=0,sl_cur=0,sl_next=SLOTB;
  #define ROT() do{sl_prev=sl_cur;sl_cur=sl_next;sl_next=(sl_next==(NSLOT-1)*SLOTB)?0:sl_next+SLOTB;}while(0)
  DMA_K(2,2*SLOTB);
  *reinterpret_cast<f32x4*>(ckl+tid*4)=ckv0; *reinterpret_cast<f32x4*>(ckl+2048+tid*4)=ckv1;
  WAIT_BAR(3);
  BINIT(pA0,pA1,0);
  qkt(pA0,pA1,Kbase,qr,r32,hi);asm volatile("s_nop 15\n\ts_nop 7":"+v"(pA0),"+v"(pA1));CMASK(pA0,pA1,0);
  START(pA0,pA1);
  _Pragma("unroll") for(int r=0;r<16;++r)pA1[r]=__builtin_amdgcn_exp2f(pA1[r]);
  BINIT(pB0,pB1,1);
  WAIT_BAR(0);
  DMA_K(3,0);DMA_V(1,SLOTB);
  ROT();
  kload8(kf,kp0+sl_cur);
  WAIT_BAR(2);
  s16x4 vlo[8],vhi[8]; u32x4 pw0,pw1,pw2,pw3;
  #define PKW(P,B) cvtpk_s(P[B],P[B+1])
  #define PAF(k) __builtin_bit_cast(bf16x8,pw##k)
  #define VFR(i) (bf16x8){vlo[i][0],vlo[i][1],vlo[i][2],vlo[i][3],vhi[i][0],vhi[i][1],vhi[i][2],vhi[i][3]}
  #define PIN(x) asm volatile("":"+v"(x))
  #define MX3(a,b,c) __builtin_fmaxf(__builtin_fmaxf((a),(b)),(c))
  #define GAPA(MF,A0,A1,A2,A3,W0,W1,PW) do{ MF; sacc+=A0; sacc+=A1; sacc+=A2; sacc+=A3; PIN(sacc); W0; W1; PIN(PW); SBAR(); }while(0)
  #define EX(v) __builtin_amdgcn_exp2f(v)
  #define GAPB(MF,X,B) do{ MF; X[B]=EX(X[B]); X[B+1]=EX(X[B+1]); X[B+2]=EX(X[B+2]); X[B+3]=EX(X[B+3]); PIN(X); SBAR(); }while(0)
  #define VRD(i) do{ vlo[i]=vtr(vp_+(((i)>>2)*4096+((i)&3)*1024)); vhi[i]=vtr(vp_+(((i)>>2)*4096+((i)&3)*1024+512)); }while(0)
  #define KRD(G,j) do{ if(G){ kload2(kf,kp0+sl_next,j); SBAR(); } }while(0)
  #define NXB(G,X,g,tt,off) do{ if(G){ BGRP(X,g,64*((tt)+T0)+(off)); PIN(X); SBAR(); } }while(0)
  #define STEP(C0,C1,P0,P1,t,GK,GV,GL) do{ SBAR(); \
    const lds_cptr vp_=vp0+sl_prev; \
    VRD(0); SBAR(); float sacc=(P0[0]+P0[1]); \
    GAPA(C0=__builtin_amdgcn_mfma_f32_32x32x16_bf16(kf[0],qr[0],C0,0,0,0), P0[2],P0[3],P0[4],P0[5],     pw0[0]=PKW(P0,0), pw0[1]=PKW(P0,2), pw0); \
    VRD(4); SBAR(); GAPA(C1=__builtin_amdgcn_mfma_f32_32x32x16_bf16(kf[1],qr[0],C1,0,0,0), P0[6],P0[7],P0[8],P0[9],     pw0[2]=PKW(P0,4), pw0[3]=PKW(P0,6), pw0); \
    VRD(1); SBAR(); GAPA(C0=__builtin_amdgcn_mfma_f32_32x32x16_bf16(kf[2],qr[1],C0,0,0,0),   P0[10],P0[11],P0[12],P0[13], pw1[0]=PKW(P0,8), pw1[1]=PKW(P0,10), pw1); \
    VRD(5); SBAR(); GAPA(C1=__builtin_amdgcn_mfma_f32_32x32x16_bf16(kf[3],qr[1],C1,0,0,0),   P0[14],P0[15],P1[0],P1[1],   pw1[2]=PKW(P0,12),pw1[3]=PKW(P0,14), pw1); \
    VRD(2); SBAR(); GAPA(C0=__builtin_amdgcn_mfma_f32_32x32x16_bf16(kf[4],qr[2],C0,0,0,0),   P1[2],P1[3],P1[4],P1[5],     pw2[0]=PKW(P1,0), pw2[1]=PKW(P1,2), pw2); \
    VRD(6); SBAR(); GAPA(C1=__builtin_amdgcn_mfma_f32_32x32x16_bf16(kf[5],qr[2],C1,0,0,0),   P1[6],P1[7],P1[8],P1[9],     pw2[2]=PKW(P1,4), pw2[3]=PKW(P1,6), pw2); \
    VRD(3); SBAR(); GAPA(C0=__builtin_amdgcn_mfma_f32_32x32x16_bf16(kf[6],qr[3],C0,0,0,0),   P1[10],P1[11],P1[12],P1[13], pw3[0]=PKW(P1,8), pw3[1]=PKW(P1,10), pw3); \
    VRD(7); SBAR(); GAPA(C1=__builtin_amdgcn_mfma_f32_32x32x16_bf16(kf[7],qr[3],C1,0,0,0),   P1[14],P1[15],0.f,0.f,       pw3[2]=PKW(P1,12),pw3[3]=PKW(P1,14), pw3); \
    l_reg+=sacc; \
    if(GK){DMA_K((t)+3,sl_cur);} if(GV){DMA_V((t)+1,sl_next);} \
    CMASK(C0,C1,t); \
    { float a=MX3(C0[0],C0[1],C1[0]),b=MX3(C0[2],C0[3],C1[1]); a=MX3(a,C1[2],C1[3]); \
      _Pragma("unroll") for(int r=4;r<16;r+=4){a=MX3(a,C0[r],C0[r+1]);b=MX3(b,C0[r+2],C0[r+3]);a=MX3(a,C1[r],C1[r+1]);b=MX3(b,C1[r+2],C1[r+3]);} \
      float rm=__builtin_fmaxf(a,b); { auto rr=__builtin_amdgcn_permlane32_swap(__float_as_uint(rm),__float_as_uint(rm),false,false); rm=__builtin_fmaxf(__uint_as_float(rr[0]),__uint_as_float(rr[1])); } \
      resc=false; \
      if(__builtin_expect(__any(rm>(float)THRL),0)){ const float dl=__builtin_fmaxf(rm,0.f); mhat+=dl; \
        _Pragma("unroll") for(int r=0;r<16;++r){C0[r]-=dl;C1[r]-=dl;} \
        const float f=__builtin_amdgcn_exp2f(-dl); l_reg*=f; if(hi==0)wsf[r32]=f; resc=true; } } \
    SBAR(); \
    GAPB(o[0]=__builtin_amdgcn_mfma_f32_32x32x16_bf16(PAF(0),VFR(0),o[0],0,0,0), C0,0);  NXB(GL,P0,0,(t)+1,0); \
    GAPB(o[1]=__builtin_amdgcn_mfma_f32_32x32x16_bf16(PAF(0),VFR(4),o[1],0,0,0), C0,4);  NXB(GL,P0,1,(t)+1,0); \
    KRD(GL,0); GAPB(o[0]=__builtin_amdgcn_mfma_f32_32x32x16_bf16(PAF(1),VFR(1),o[0],0,0,0), C0,8);  NXB(GL,P0,2,(t)+1,0); \
    KRD(GL,1); GAPB(o[1]=__builtin_amdgcn_mfma_f32_32x32x16_bf16(PAF(1),VFR(5),o[1],0,0,0), C0,12); NXB(GL,P0,3,(t)+1,0); \
    KRD(GL,2); GAPB(o[0]=__builtin_amdgcn_mfma_f32_32x32x16_bf16(PAF(2),VFR(2),o[0],0,0,0), C1,0);  NXB(GL,P1,0,(t)+1,32); \
    KRD(GL,3); GAPB(o[1]=__builtin_amdgcn_mfma_f32_32x32x16_bf16(PAF(2),VFR(6),o[1],0,0,0), C1,4);  NXB(GL,P1,1,(t)+1,32); \
    GAPB(o[0]=__builtin_amdgcn_mfma_f32_32x32x16_bf16(PAF(3),VFR(3),o[0],0,0,0), C1,8);  NXB(GL,P1,2,(t)+1,32); \
    GAPB(o[1]=__builtin_amdgcn_mfma_f32_32x32x16_bf16(PAF(3),VFR(7),o[1],0,0,0), C1,12); NXB(GL,P1,3,(t)+1,32); \
    }while(0)
  int t=1;
  #undef CMASK
  #define CMASK(P0,P1,t) do{}while(0)
  for(;t+5<NTL;t+=2){
    STEP(pB0,pB1,pA0,pA1,t,true,true,true);     WAIT_BAR(2); RESC(); ROT();
    STEP(pA0,pA1,pB0,pB1,t+1,true,true,true);   WAIT_BAR(2); RESC(); ROT();
  }
  #undef CMASK
  #define CMASK(P0,P1,t) do{int jb_=(t)-(NTL-4); if(jb_>=0)cmask(P0,P1,jb_,qrel,hi);}while(0)
  #define ENDW(tt) do{ if((tt)+3<NTL){WAIT_BAR(2);} else if((tt)+2<NTL){WAIT_BAR(1);} else {WAIT_BAR(0);} }while(0)
  for(;t+1<NTL;t+=2){
    STEP(pB0,pB1,pA0,pA1,t,(t+3<NTL),(t+1<NTL),(t+1<NTL));       ENDW(t);   RESC(); ROT();
    STEP(pA0,pA1,pB0,pB1,t+1,(t+4<NTL),(t+2<NTL),(t+2<NTL));     ENDW(t+1); RESC(); ROT();
  }
  STEP(pB0,pB1,pA0,pA1,NTL-1,false,false,false); RESC();
  { float sacc=pB0[0]+pB0[1]; _Pragma("unroll") for(int r=2;r<16;++r)sacc+=pB0[r]; _Pragma("unroll") for(int r=0;r<16;++r)sacc+=pB1[r]; l_reg+=sacc;
    pw0=(u32x4){PKW(pB0,0),PKW(pB0,2),PKW(pB0,4),PKW(pB0,6)};pw1=(u32x4){PKW(pB0,8),PKW(pB0,10),PKW(pB0,12),PKW(pB0,14)};pw2=(u32x4){PKW(pB1,0),PKW(pB1,2),PKW(pB1,4),PKW(pB1,6)};pw3=(u32x4){PKW(pB1,8),PKW(pB1,10),PKW(pB1,12),PKW(pB1,14)};
    SBAR(); pv(o,vb0+sl_cur,PAF(0),PAF(1),PAF(2),PAF(3)); }
  #undef PKW
  #undef PAF
  #undef VFR
  #undef PIN
  #undef MX3
  #undef GAPA
  #undef GAPB
  #undef EX
  #undef VRD
  #undef KRD
  #undef NXB
  #undef STEP
  #undef ENDW
  {auto rr=__builtin_amdgcn_permlane32_swap(__float_as_uint(l_reg),__float_as_uint(l_reg),false,false);l_reg=__uint_as_float(rr[0])+__uint_as_float(rr[1]);}
  if(hi==0)wsf[32+r32]=l_reg;asm volatile("s_waitcnt lgkmcnt(0)":::"memory");
  float rli[16];
  #pragma unroll
  for(int r=0;r<16;++r)rli[r]=__builtin_amdgcn_rcpf(wsf[32+crow(r,hi)]);
  bf16*Ow=O+(rowbase+q0+wid*QBLK)*DM+h*D;
  { bf16*stg=(bf16*)(shm+LDS_OST)+wid*2048;
    #pragma unroll
    for(int r=0;r<16;++r){const int orow=crow(r,hi);
      #pragma unroll
      for(int d0=0;d0<2;++d0)stg[orow*64+d0*32+r32]=(bf16)(cvtpk_s(o[d0][r]*rli[r],0.f)&0xffffu);}
    asm volatile("s_waitcnt lgkmcnt(0)":::"memory");
    #pragma unroll
    for(int i=0;i<4;++i){const int row=i*8+(lane>>3),ch=lane&7; const u32x4 v=*(const u32x4*)(stg+row*64+ch*8); ATTN_STORE16(Ow+(long)row*DM+ch*8,v);} }
  asm volatile("s_waitcnt lgkmcnt(0)\n\ts_barrier":::"memory");
  #undef DMA_K
  #undef DMA_V
  #undef BINIT
  #undef BGRP
  #undef CMASK
  #undef START
  #undef RESC
  #undef ROT
}
constexpr int ATTN_LDS_BYTES=LDS_BYTES;
struct AttnTensors { const bf16* Q; const bf16* K; const bf16* V; bf16* O; const float* CKH; const float* NRM; };
struct AttnUnit { int bh; int qb; };
struct StaticOrder {
  int G,c;
  __device__ __forceinline__ StaticOrder(int grid,int block):G(grid),c(block){}
  __device__ __forceinline__ bool next(int i,AttnUnit&u)const{ int L=i*G+c;
#ifdef FOX_TWICE
    if(L>=2*BATCH*NHEAD*NQB)return false; L%=BATCH*NHEAD*NQB;
#else
    if(L>=BATCH*NHEAD*NQB)return false;
#endif
    const int ii=L>>8,g=L&255,s=g>>7,base=2*(ii>>1)+s; u.bh=g&127; u.qb=(ii&1)?(NQB-1-base):base; return true; }
  __device__ __forceinline__ void a_ready(const AttnUnit&)const{}
  __device__ __forceinline__ void done(const AttnUnit&)const{}
};
template<class Sched,int THRL=8> __device__ __forceinline__ void attn_phase(char*lds,const AttnTensors&T,const Sched&S){
  AttnUnit u;
  for(int i=0;S.next(i,u);++i){ S.a_ready(u); attn_unit<THRL>(u.bh/NHEAD,u.bh%NHEAD,u.qb,T.Q,T.K,T.V,T.O,T.CKH,T.NRM,lds); S.done(u); }
}
#undef SBAR
#undef WAIT_BAR
}

DI void ln_rows(const float* src, const float* g, const float* b, float* dst, bf16_t* xb, int gw, int ngw, int lane) {
    f32x4 gv[4], bv[4];
#pragma unroll
    for (int j = 0; j < 4; ++j) { gv[j] = *(const f32x4*)(g + lane * 4 + 256 * j); bv[j] = *(const f32x4*)(b + lane * 4 + 256 * j); }
    for (int row = gw; row < NTOK; row += ngw) {
        f32x4 v[4]; float s = 0.f;
#pragma unroll
        for (int j = 0; j < 4; ++j) { v[j] = *(const f32x4*)(src + (size_t)row * DM + lane * 4 + 256 * j); s += (v[j][0] + v[j][1]) + (v[j][2] + v[j][3]); }
        const float mean = wave_sum(s) * (1.f / DM); float s2 = 0.f;
#pragma unroll
        for (int j = 0; j < 4; ++j) { v[j] = v[j] - mean; s2 += (v[j][0] * v[j][0] + v[j][1] * v[j][1]) + (v[j][2] * v[j][2] + v[j][3] * v[j][3]); }
        const float rstd = 1.0f / sqrtf(wave_sum(s2) * (1.f / DM) + LN_EPS);
#pragma unroll
        for (int j = 0; j < 4; ++j) { const f32x4 y = v[j] * rstd * gv[j] + bv[j];
            if (dst) *(f32x4*)(dst + (size_t)row * DM + lane * 4 + 256 * j) = y;
            if (xb) *(u32x2*)(xb + (size_t)row * DM + lane * 4 + 256 * j) = pk4(y); }
    }
}

DI void moe_tables(const unsigned* cnt, LAS int* tstart, LAS int* cntl) {
    __syncthreads();
    if (threadIdx.x == 0) {
        int t = 0;
        for (int e = 0; e < NEXP; ++e) { const int c = (int)cnt[e]; cntl[e] = c; tstart[e] = t; t += (c + 255) >> 8; }
        tstart[NEXP] = t;
    }
    __syncthreads();
}

#define XB_TMO      128
#define XB_XCNT(j)  (256  + 64 * (j))
#define XB_XSUB(j)  (1280 + 64 * (j))
#define XB_XGEN(j)  (2304 + 64 * (j))
#define XB_TOP      3328
#define XB_TOPGEN   3392
#define XCD_BAR_WORDS 3456
#define XB_SPIN_CAP (1u << 18)
__device__ __forceinline__ unsigned xb_ld(unsigned* p)              { return __hip_atomic_load(p, __ATOMIC_RELAXED, __HIP_MEMORY_SCOPE_AGENT); }
__device__ __forceinline__ unsigned xb_add(unsigned* p, unsigned v) { return __hip_atomic_fetch_add(p, v, __ATOMIC_RELAXED, __HIP_MEMORY_SCOPE_AGENT); }
__device__ __forceinline__ unsigned xb_xcc_id() { return (unsigned)__builtin_amdgcn_s_getreg((3 << 11) | 20) & 0xFu; }
#define XB_SPIN(cond, bar) do { unsigned _sp = 0; while (cond) { __builtin_amdgcn_s_sleep(1); \
    if ((++_sp & 255u) == 0u) { if (xb_ld(&(bar)[XB_TMO])) break; if (_sp > XB_SPIN_CAP) { atomicAdd(&(bar)[XB_TMO], 1u); break; } } } } while (0)
struct XcdBarrier { unsigned* bar; unsigned x; volatile LAS unsigned* st; };
__device__ __forceinline__ XcdBarrier xcd_barrier_post(unsigned* bar, volatile LAS unsigned* st) {
    XcdBarrier b; b.bar = bar; b.x = xb_xcc_id(); b.st = st;
    if (threadIdx.x == 0) (void)xb_add(&bar[XB_XCNT(b.x)], 1u);
    return b;
}
__device__ __forceinline__ void xcd_barrier_complete(unsigned* bar, unsigned x, unsigned& nloc, unsigned& nx) {
    const unsigned G = gridDim.x * gridDim.y * gridDim.z;
    unsigned sum, cnt, mine, sp = 0u;
    for (;;) {
        sum = 0u; cnt = 0u; mine = 0u;
#pragma unroll
        for (unsigned j = 0; j < 16; ++j) { const unsigned c = xb_ld(&bar[XB_XCNT(j)]); sum += c; cnt += (c > 0u) ? 1u : 0u; mine = (j == x) ? c : mine; }
        if (sum == G) break;
        __builtin_amdgcn_s_sleep(1);
        if ((++sp & 255u) == 0u) { if (xb_ld(&bar[XB_TMO])) break; if (sp > XB_SPIN_CAP) { atomicAdd(&bar[XB_TMO], 1u); break; } }
    }
    nloc = mine > 0u ? mine : 1u; nx = cnt > 0u ? cnt : 1u;
}
__device__ __forceinline__ void xcd_barrier(const XcdBarrier& b) {
    asm volatile("s_waitcnt vmcnt(0)" ::: "memory");
    __syncthreads();
    if (threadIdx.x == 0) {
        unsigned* bar = b.bar;
        __builtin_amdgcn_s_waitcnt(0);
        unsigned nloc = b.st[0], nx = b.st[1];
        if (nloc == 0u) { xcd_barrier_complete(bar, b.x, nloc, nx); b.st[0] = nloc; b.st[1] = nx; }
        const unsigned old = xb_add(&bar[XB_XSUB(b.x)], 1u);
        const unsigned gen = old / nloc;
        if (old + 1u == (gen + 1u) * nloc) {
            __builtin_amdgcn_fence(__ATOMIC_RELEASE, "agent");
            asm volatile("s_waitcnt vmcnt(0)" ::: "memory");
            const unsigned og = xb_add(&bar[XB_TOP], 1u);
            const unsigned tg = og / nx;
            if (og + 1u == (tg + 1u) * nx) xb_add(&bar[XB_TOPGEN], 1u);
            else XB_SPIN(xb_ld(&bar[XB_TOPGEN]) == tg, bar);
            __builtin_amdgcn_fence(__ATOMIC_ACQUIRE, "agent");
            xb_add(&bar[XB_XGEN(b.x)], 1u);
            asm volatile("s_waitcnt vmcnt(0)" ::: "memory");
        } else {
            XB_SPIN(xb_ld(&bar[XB_XGEN(b.x)]) == gen, bar);
            __builtin_amdgcn_fence(__ATOMIC_ACQUIRE, "agent");
            asm volatile("s_waitcnt vmcnt(0)" ::: "memory");
        }
    }
    __syncthreads();
}

template <int PH> DI void run_phase(const Args& a, LAS unsigned char* lds) {
    int tid_ = threadIdx.x; asm volatile("" : "+v"(tid_));
    const int tid = tid_, lane = tid & 63, wid = tid >> 6;
    const int G = gridDim.x, bid = blockIdx.x;
    const int gw = bid * 8 + wid, ngw = G * 8, gtid = bid * 512 + tid, gthreads = G * 512;
    unsigned char* ws = a.ws;
    constexpr int L = (PH >= 10) ? 1 : 0;
    constexpr int IB_MOE = L ? 32 : 16;
    unsigned* cnt = (unsigned*)(ws + WS_CTL) + 64 * L;
    bf16_t* XB = (bf16_t*)(ws + WS_XB);
    LAS unsigned char* misc = lds + 131072;
    LAS int* tstart = (LAS int*)misc; LAS int* cntl = tstart + 72;
    float* SSQ_Q = (float*)(ws + WS_CTL + 256 * 1024); float* SSQ_KV = (float*)(ws + WS_TAB + 128 * 1024);

    if constexpr (PH == 0) {
        LAS float* scr = (LAS float*)(lds + wid * 8448);
        constexpr int I_IN = (1024 / 64) * (N_IN0 / 64), I_UQ = (256 / 64) * (768 / 64), I_UKV = (256 / 64) * (1280 / 64), I_OUT = (1024 / 64) * (1024 / 64);
        for (int it = gw; it < I_IN + I_UQ + I_UKV + I_OUT; it += ngw) {
            int r = it;
            if (r < I_IN) { prep_item((const float*)a.in(2), nullptr, 1440, 1024, nullptr, (bf16_t*)(ws + W_IN), 1024, N_IN0, map_in0, scr, r, lane); continue; } r -= I_IN;
            if (r < I_UQ) { prep_item((const float*)a.in(9), nullptr, 768, 256, (const float*)a.in(8), (bf16_t*)(ws + W_UQ), 256, 768, map_q, scr, r, lane); continue; } r -= I_UQ;
            if (r < I_UKV) { prep_item((const float*)a.in(11), nullptr, 1024, 128, (const float*)a.in(10), (bf16_t*)(ws + W_UKV), 256, 1280, map_kv, scr, r, lane); continue; } r -= I_UKV;
            prep_item((const float*)a.in(12), nullptr, 1024, 1024, nullptr, (bf16_t*)(ws + W_OUT), 1024, 1024, map_ident, scr, r, lane);
        }
        prep_moe(a, 16, scr, gw, ngw, lane, gtid, gthreads);
        float* b0 = (float*)(ws + WS_TAB); float* b1 = (float*)(ws + WS_TAB + 8192);
        for (int n = gtid; n < N_IN0; n += gthreads) { const int s = map_in0(n); b0[n] = s >= 0 ? ((const float*)a.in(3))[s] : 0.f; }
        for (int n = gtid; n < N_IN1; n += gthreads) b1[n] = n < 3088 ? ((const float*)a.in(27))[n] : 0.f;
        float* ct = (float*)(ws + WS_COS); float* st = (float*)(ws + WS_SIN); const int* pos = (const int*)a.in(1);
        for (int idx = gtid; idx < NTOK * 16; idx += gthreads) {
            const int t = idx >> 4, p = idx & 15;
            const float inv = 1.0f / exp2f((float)p * (13.287712379549449f / 16.0f));
            const float ang = (float)pos[t] * inv;
            double rev = (double)ang * 0.15915494309189535; rev -= rint(rev);
            ct[idx] = __builtin_amdgcn_cosf((float)rev); st[idx] = __builtin_amdgcn_sinf((float)rev);
        }
        const float* x = (const float*)a.in(0);
        for (int idx = gtid; idx < NTOK * DM / 8; idx += gthreads) {
            const f32x4 v0 = *(const f32x4*)(x + (size_t)idx * 8), v1 = *(const f32x4*)(x + (size_t)idx * 8 + 4);
            u32x4 o; o.x = pk2(v0[0], v0[1]); o.y = pk2(v0[2], v0[3]); o.z = pk2(v1[0], v1[1]); o.w = pk2(v1[2], v1[3]);
            *(u32x4*)(XB + (size_t)idx * 8) = o;
        }
    }
    else if constexpr (PH == 1) {
        const bf16_t* Bt = (const bf16_t*)(ws + W_IN); const float* bias = (const float*)(ws + WS_TAB);
        bf16_t* UPRE = (bf16_t*)(ws + B_UPRE); bf16_t* QL = (bf16_t*)(ws + B_QL); bf16_t* KVL = (bf16_t*)(ws + B_KVL);
        pg8::DenseOrder S; S.init(NTOK, N_IN0, 1024, Bt, G, bid);
        auto cf = [=](const pg8::Unit& u, int c) { return pg8::load_bias4(bias, u.pn * 256 + c); };
        auto f = [=](const pg8::Bias4& bb, const pg8::Unit& u, int r, int c, f32x4 l0, f32x4 l1, f32x4 h0, f32x4 h1) {
            const int nt = u.pn; const size_t row = (size_t)u.pm * 256 + r;
            l0 = l0 + bb.b[0]; l1 = l1 + bb.b[1]; h0 = h0 + bb.b[2]; h1 = h1 + bb.b[3];
            if (nt < 4) {
#pragma unroll
                for (int i = 0; i < 4; ++i) { l0[i] = l0[i] * sigmoidf_(h0[i]); l1[i] = l1[i] * sigmoidf_(h1[i]); }
                *(u32x4*)(UPRE + row * 512 + nt * 128 + c) = pk8(l0, l1);
            } else {
                bf16_t* dst = QL + (size_t)(nt - 4) * (B_KVL - B_QL) / 2;
                *(u32x4*)(dst + row * 256 + c) = pk8(l0, l1); *(u32x4*)(dst + row * 256 + 128 + c) = pk8(h0, h1);
                float ss = dot4(l0) + dot4(l1); if (nt == 4) ss += dot4(h0) + dot4(h1);
                ss += __shfl_xor(ss, 16); ss += __shfl_xor(ss, 32);
                if ((lane >> 4) == 0) { if (nt == 4) SSQ_Q[row * 4 + (c >> 5)] = ss; else SSQ_KV[row * 4 + (c >> 5)] = ss; }
            }
        };
        pg8::gemm_phase(lds, XB, 1024, S, pg8::make_epi<8>(cf, f));
    }
    else if constexpr (PH == 2) {
        const bf16_t* UPRE = (const bf16_t*)(ws + B_UPRE); bf16_t* UO = (bf16_t*)(ws + B_UO);
        {
            const float* cw = (const float*)a.in(4); const float* cb = (const float*)a.in(5); const float* lg = (const float*)a.in(6); const float* lb = (const float*)a.in(7);
            LAS bf16_t* U = (LAS bf16_t*)lds;
            LAS float* CO = (LAS float*)(lds + 94 * 512 * 2);
            float w[31];
#pragma unroll
            for (int j = 0; j < 31; ++j) w[j] = cw[j * 512 + tid];
            const float bch = cb[tid];
            f32x4 g0 = *(const f32x4*)(lg + lane * 8), g1 = *(const f32x4*)(lg + lane * 8 + 4), b0 = *(const f32x4*)(lb + lane * 8), b1 = *(const f32x4*)(lb + lane * 8 + 4);
            for (int u = bid; u < NTOK / 64; u += G) {
                const int tok0 = u * 64, s0 = tok0 % SEQ;
                __syncthreads();
                for (int c = tid; c < 94 * 64; c += 512) { const int r = c >> 6, ch = c & 63; const int s = s0 - 30 + r;
                    u32x4 v = (u32x4){0u, 0u, 0u, 0u}; if (s >= 0) v = *(const u32x4*)(UPRE + (size_t)(tok0 - 30 + r) * 512 + ch * 8);
                    *(LAS u32x4*)(U + r * 512 + ch * 8) = v; }
                __syncthreads();
                for (int sub = 0; sub < 4; ++sub) {
                    for (int tt = 0; tt < 16; ++tt) { const int tl = sub * 16 + tt; float acc = bch;
#pragma unroll
                        for (int j = 0; j < 31; ++j) acc += w[j] * bf2f(U[(tl + j) * 512 + tid]);
                        CO[tt * 512 + tid] = acc; }
                    __syncthreads();
#pragma unroll
                    for (int k = 0; k < 2; ++k) { const int tt = 2 * wid + k;
                        f32x4 v0 = *(LAS f32x4*)(CO + tt * 512 + lane * 8), v1 = *(LAS f32x4*)(CO + tt * 512 + lane * 8 + 4);
                        const float mean = wave_sum((v0[0] + v0[1]) + (v0[2] + v0[3]) + (v1[0] + v1[1]) + (v1[2] + v1[3])) * (1.f / 512.f);
                        v0 = v0 - mean; v1 = v1 - mean;
                        const float var = wave_sum((v0[0] * v0[0] + v0[1] * v0[1]) + (v0[2] * v0[2] + v0[3] * v0[3]) + (v1[0] * v1[0] + v1[1] * v1[1]) + (v1[2] * v1[2] + v1[3] * v1[3])) * (1.f / 512.f);
                        const float rstd = 1.0f / sqrtf(var + LN_EPS);
                        f32x4 y0 = v0 * rstd * g0 + b0, y1 = v1 * rstd * g1 + b1;
#pragma unroll
                        for (int i = 0; i < 4; ++i) { y0[i] = siluf_(y0[i]); y1[i] = siluf_(y1[i]); }
                        u32x4 o; o.x = pk2(y0[0], y0[1]); o.y = pk2(y0[2], y0[3]); o.z = pk2(y1[0], y1[1]); o.w = pk2(y1[2], y1[3]);
                        *(u32x4*)(UO + (size_t)(tok0 + sub * 16 + tt) * 1024 + lane * 8) = o; }
                    __syncthreads();
                }
            }
        }
        const float* ct = (const float*)(ws + WS_COS); const float* st = (const float*)(ws + WS_SIN);
        {
            const bf16_t* QL = (const bf16_t*)(ws + B_QL); bf16_t* Q0 = (bf16_t*)(ws + B_Q0);
            pg8::DenseOrder S; S.init(NTOK, 768, 256, (const bf16_t*)(ws + W_UQ), G, bid);
            auto f = [=](const pg8::NoCtx&, const pg8::Unit& u, int r, int c, f32x4 l0, f32x4 l1, f32x4 h0, f32x4 h1) {
                const size_t row = (size_t)u.pm * 256 + r; const f32x4 sq = *(const f32x4*)(SSQ_Q + row * 4); const float s = 1.0f / sqrtf(((sq[0] + sq[1]) + (sq[2] + sq[3])) * (1.f / 256.f) + RMS_EPS);
#pragma unroll
                for (int hh = 0; hh < 2; ++hh) { f32x4 v0 = (hh ? h0 : l0) * s, v1 = (hh ? h1 : l1) * s; const int col = u.pn * 256 + c + 128 * hh; const int d = col % 96;
                    if (d >= 64) rope8(v0, v1, ct, st, row, (d - 64) >> 1);
                    *(u32x4*)(Q0 + row * 768 + col) = pk8(v0 * C2_MLA, v1 * C2_MLA); }
            };
            pg8::gemm_phase(lds, QL, 256, S, pg8::make_epi<2>([](const pg8::Unit&, int) { return pg8::NoCtx{}; }, f));
        }
        {
            const bf16_t* KVL = (const bf16_t*)(ws + B_KVL); bf16_t* K0 = (bf16_t*)(ws + B_K0); bf16_t* V0 = (bf16_t*)(ws + B_V0);
            pg8::DenseOrder S; S.init(NTOK, 1280, 256, (const bf16_t*)(ws + W_UKV), G, bid);
            auto f = [=](const pg8::NoCtx&, const pg8::Unit& u, int r, int c, f32x4 l0, f32x4 l1, f32x4 h0, f32x4 h1) {
                const size_t row = (size_t)u.pm * 256 + r; const f32x4 sq = *(const f32x4*)(SSQ_KV + row * 4); const float s = 1.0f / sqrtf(((sq[0] + sq[1]) + (sq[2] + sq[3])) * (1.f / 128.f) + RMS_EPS);
#pragma unroll
                for (int hh = 0; hh < 2; ++hh) { f32x4 v0 = (hh ? h0 : l0), v1 = (hh ? h1 : l1); const int col = u.pn * 256 + c + 128 * hh;
                    if (col < 768) { const int d = col % 96;
                        if (d >= 64) rope8(v0, v1, ct, st, row, (d - 64) >> 1); else { v0 = v0 * s; v1 = v1 * s; }
                        *(u32x4*)(K0 + row * 768 + col) = pk8(v0, v1); }
                    else *(u32x4*)(V0 + row * 512 + (col - 768)) = pk8(v0 * s, v1 * s); }
            };
            pg8::gemm_phase(lds, KVL, 256, S, pg8::make_epi<2>([](const pg8::Unit&, int) { return pg8::NoCtx{}; }, f));
        }
    }
    else if constexpr (PH == 3) {
        const bf16_t* Q0 = (const bf16_t*)(ws + B_Q0); const bf16_t* K0 = (const bf16_t*)(ws + B_K0); const bf16_t* V0 = (const bf16_t*)(ws + B_V0); bf16_t* UO = (bf16_t*)(ws + B_UO);
        for (int u = bid; u < 64 * 16; u += G) {
            const int i = u >> 8, gp = u & 255, s = gp >> 6, bh = gp & 63, base = 4 * (i >> 1) + s, qb = (i & 1) ? 15 - base : base;
            const int b = bh >> 3, h = bh & 7;
            attn_mla_unit(lds, Q0, K0, V0, UO, b, h, qb);
        }
    }
    else if constexpr (PH == 4 || PH == 13) {
        const bf16_t* A = (const bf16_t*)(ws + (L ? B_O1 : B_UO));
        const float* bias = (const float*)a.in(L ? 29 : 13); const float* xres = L ? (const float*)a.out : (const float*)a.in(0); float* pre = a.out;
        pg8::DenseOrder S; S.init(NTOK, 1024, 1024, (const bf16_t*)(ws + W_OUT), G, bid);
        auto cf = [=](const pg8::Unit& u, int c) { return pg8::load_bias4(bias, u.pn * 256 + c); };
        auto f = [=](const pg8::Bias4& bb, const pg8::Unit& u, int r, int c, f32x4 l0, f32x4 l1, f32x4 h0, f32x4 h1) {
            const int col = u.pn * 256 + c; const size_t off = ((size_t)u.pm * 256 + r) * 1024 + col;
            const f32x4 x0 = *(const f32x4*)(xres + off), x1 = *(const f32x4*)(xres + off + 4), x2 = *(const f32x4*)(xres + off + 128), x3 = *(const f32x4*)(xres + off + 132);
            *(f32x4*)(pre + off) = x0 * ALPHA + l0 + bb.b[0]; *(f32x4*)(pre + off + 4) = x1 * ALPHA + l1 + bb.b[1];
            *(f32x4*)(pre + off + 128) = x2 * ALPHA + h0 + bb.b[2]; *(f32x4*)(pre + off + 132) = x3 * ALPHA + h1 + bb.b[3];
        };
        pg8::gemm_phase(lds, A, 1024, S, pg8::make_epi<4>(cf, f));
    }
    else if constexpr (PH == 5 || PH == 14) {
        ln_rows(a.out, (const float*)a.in(L ? 30 : 14), (const float*)a.in(L ? 31 : 15), a.out, XB, gw, ngw, lane);
    }
    else if constexpr (PH == 6 || PH == 15) {
        {
            const float* x1 = a.out; const bf16_t* rhi = (const bf16_t*)(ws + W_RHI); const bf16_t* rlo = (const bf16_t*)(ws + W_RLO);
            const float* rbias = (const float*)a.in(IB_MOE + 1);
            int* LIST = (int*)(ws + B_LIST); float* LISTW = (float*)(ws + B_LISTW);
            LAS float* lgl = (LAS float*)(lds + 49152);
            LAS int* lcnt = (LAS int*)(lds + 49152 + 33280);
            LAS int* lbase = lcnt + 64;
            LAS int* sel_e = lbase + 64;
            LAS int* sel_p = sel_e + 768;
            LAS float* sel_w = (LAS float*)(sel_p + 768);
            const int fr = lane & 15, fq = lane >> 4;
            const float mybias = rbias[lane];
            for (int u = bid; u < NTOK / 128; u += G) {
                const int t0 = u * 128;
                f32x4 acc[4];
#pragma unroll
                for (int n = 0; n < 4; ++n) acc[n] = (f32x4){0.f, 0.f, 0.f, 0.f};
                const int sr = tid >> 2, sc = (tid & 3) * 8;
                const float* xp = x1 + (size_t)(t0 + sr) * 1024 + sc; const bf16_t* wp = (tid < 256 ? rhi : rlo) + (size_t)((tid & 255) >> 2) * 1024 + (tid & 3) * 8;
                f32x4 v0, v1; u32x4 wv;
#define RT_WRITE(b) do { LAS unsigned char* base_ = lds + (b) * 24576; u32x4 h, lo_; \
                    h.x = pk2(v0[0], v0[1]); h.y = pk2(v0[2], v0[3]); h.z = pk2(v1[0], v1[1]); h.w = pk2(v1[2], v1[3]); \
                    lo_.x = pk2(v0[0] - __uint_as_float(h.x << 16), v0[1] - __uint_as_float(h.x & 0xffff0000u)); \
                    lo_.y = pk2(v0[2] - __uint_as_float(h.y << 16), v0[3] - __uint_as_float(h.y & 0xffff0000u)); \
                    lo_.z = pk2(v1[0] - __uint_as_float(h.z << 16), v1[1] - __uint_as_float(h.z & 0xffff0000u)); \
                    lo_.w = pk2(v1[2] - __uint_as_float(h.w << 16), v1[3] - __uint_as_float(h.w & 0xffff0000u)); \
                    *(LAS u32x4*)(base_ + sr * 64 + sc * 2) = h; *(LAS u32x4*)(base_ + 8192 + sr * 64 + sc * 2) = lo_; \
                    *(LAS u32x4*)(base_ + (tid < 256 ? 16384 : 20480) + ((tid & 255) >> 2) * 64 + (tid & 3) * 16) = wv; } while (0)
                v0 = *(const f32x4*)(xp); v1 = *(const f32x4*)(xp + 4); wv = *(const u32x4*)(wp);
                __syncthreads();
                RT_WRITE(0);
                __syncthreads();
                for (int kt = 0; kt < 32; ++kt) {
                    if (kt + 1 < 32) { v0 = *(const f32x4*)(xp + (kt + 1) * 32); v1 = *(const f32x4*)(xp + (kt + 1) * 32 + 4); wv = *(const u32x4*)(wp + (kt + 1) * 32); }
                    LAS unsigned char* base = lds + (kt & 1) * 24576;
                    const bf16x8 ah = *(LAS bf16x8*)(base + (16 * wid + fr) * 64 + fq * 16), al = *(LAS bf16x8*)(base + 8192 + (16 * wid + fr) * 64 + fq * 16);
#pragma unroll
                    for (int n = 0; n < 4; ++n) { const bf16x8 bh = *(LAS bf16x8*)(base + 16384 + (16 * n + fr) * 64 + fq * 16), bl = *(LAS bf16x8*)(base + 20480 + (16 * n + fr) * 64 + fq * 16);
                        acc[n] = mfma16(bh, ah, acc[n]); acc[n] = mfma16(bh, al, acc[n]); acc[n] = mfma16(bl, ah, acc[n]); }
                    if (kt + 1 < 32) RT_WRITE((kt + 1) & 1);
                    __syncthreads();
                }
#undef RT_WRITE
#pragma unroll
                for (int n = 0; n < 4; ++n)
#pragma unroll
                    for (int j = 0; j < 4; ++j) lgl[(16 * wid + fr) * 65 + 16 * n + 4 * fq + j] = acc[n][j];
                if (tid < 64) lcnt[tid] = 0;
                __syncthreads();
                for (int tt = 0; tt < 16; ++tt) {
                    const int tl = 16 * wid + tt;
                    const float sg = sigmoidf_(lgl[tl * 65 + lane]); const float ch = sg + mybias;
                    const int g = lane >> 3; int rk = 0;
#pragma unroll
                    for (int jj = 0; jj < 8; ++jj) { const int oj = (lane & ~7) + jj; const float o = __shfl(ch, oj); rk += ((o > ch) || (o == ch && oj < lane)) ? 1 : 0; }
                    float top = rk < 2 ? ch : 0.f; top += __shfl_xor(top, 1); top += __shfl_xor(top, 2); top += __shfl_xor(top, 4);
                    int grk = 0;
#pragma unroll
                    for (int gg = 0; gg < 8; ++gg) { const float o = __shfl(top, gg * 8); grk += ((o > top) || (o == top && gg < g)) ? 1 : 0; }
                    const bool gsel = grk < 4; const float mv = gsel ? ch : -INFINITY; int erk = 0;
#pragma unroll 8
                    for (int j = 0; j < 64; ++j) { const float o = __shfl(mv, j); erk += ((o > mv) || (o == mv && j < lane)) ? 1 : 0; }
                    const bool sel = gsel && erk < TOPK;
                    const float tot = wave_sum(sel ? sg : 0.f); const float w = sg / tot * 2.5f;
                    if (sel) { const int lp = __hip_atomic_fetch_add(lcnt + lane, 1, __ATOMIC_RELAXED, __HIP_MEMORY_SCOPE_WORKGROUP);
                        sel_e[tl * 6 + erk] = lane; sel_p[tl * 6 + erk] = lp; sel_w[tl * 6 + erk] = w; }
                }
                __syncthreads();
                if (tid < 64) { const int c = lcnt[tid]; lbase[tid] = c ? (int)atomicAdd(cnt + tid, (unsigned)c) : 0; }
                __syncthreads();
                for (int idx = tid; idx < 768; idx += 512) { const int e = sel_e[idx], pos = lbase[e] + sel_p[idx], tl = idx / 6, j = idx % 6; LIST[(size_t)e * LISTCAP + pos] = ((t0 + tl) << 3) | j; LISTW[(size_t)e * LISTCAP + pos] = sel_w[idx]; }
                __syncthreads();
            }
        }
        {
            bf16_t* SH = (bf16_t*)(ws + B_SH);
            pg8::DenseOrder S; S.init(NTOK, 512, 1024, (const bf16_t*)(ws + W_SGU), G, bid);
            auto f = [=](const pg8::NoCtx&, const pg8::Unit& u, int r, int c, f32x4 l0, f32x4 l1, f32x4 h0, f32x4 h1) {
#pragma unroll
                for (int i = 0; i < 4; ++i) { l0[i] = siluf_(l0[i]) * h0[i]; l1[i] = siluf_(l1[i]) * h1[i]; }
                *(u32x4*)(SH + ((size_t)u.pm * 256 + r) * 256 + u.pn * 128 + c) = pk8(l0, l1); };
            pg8::gemm_phase(lds, XB, 1024, S, pg8::make_epi<8>([](const pg8::Unit&, int) { return pg8::NoCtx{}; }, f));
        }
    }
    else if constexpr (PH == 7 || PH == 16) {
        moe_tables(cnt, tstart, cntl);
        bf16_t* H = (bf16_t*)(ws + B_H);
        pg8::GroupedOrder<true> S{tstart, cntl, 2, G, bid, (const char*)(ws + W_GU), (size_t)512 * 1024 * 2, (size_t)256 * 1024 * 2, (const int*)(ws + B_LIST), 0};
        auto f = [=](const pg8::NoCtx&, const pg8::Unit& u, int r, int c, f32x4 l0, f32x4 l1, f32x4 h0, f32x4 h1) {
#pragma unroll
            for (int i = 0; i < 4; ++i) { l0[i] = siluf_(l0[i]) * h0[i]; l1[i] = siluf_(l1[i]) * h1[i]; }
            *(u32x4*)(H + ((size_t)(tstart[u.e] + u.pm) * 256 + r) * 256 + u.pn * 128 + c) = pk8(l0, l1); };
        pg8::gemm_phase(lds, XB, 1024, S, pg8::make_epi<8>([](const pg8::Unit&, int) { return pg8::NoCtx{}; }, f));
    }
    else if constexpr (PH == 8 || PH == 17) {
        moe_tables(cnt, tstart, cntl);
        pg8::GroupedOrder<false> S{tstart, cntl, 4, G, bid, (const char*)(ws + W_D), (size_t)1024 * 256 * 2, (size_t)256 * 256 * 2, (const int*)(ws + B_LIST), NTOK / 256};
        EpiDown E{cntl, (const int*)(ws + B_LIST), (const float*)(ws + B_LISTW), ws + B_YT};
        pg8::gemm_phase(lds, (const bf16_t*)(ws + B_H), 256, S, E);
    }
    else if constexpr (PH == 9 || PH == 18) {
        {
            const unsigned char* YT = ws + B_YT; float* xo = a.out;
            const float* g = (const float*)a.in(IB_MOE + 8); const float* b = (const float*)a.in(IB_MOE + 9);
            f32x4 gv[4], bv[4];
#pragma unroll
            for (int j = 0; j < 4; ++j) { gv[j] = *(const f32x4*)(g + lane * 16 + 4 * j); bv[j] = *(const f32x4*)(b + lane * 16 + 4 * j); }
            for (int row = gw; row < NTOK; row += ngw) {
                f32x4 v[4]; u32x4 y[7];
#pragma unroll
                for (int j = 0; j < 4; ++j) v[j] = *(const f32x4*)(xo + (size_t)row * DM + lane * 16 + 4 * j);
#pragma unroll
                for (int s = 0; s < 7; ++s) y[s] = *(const u32x4*)(YT + ((size_t)row * 7 + s) * 1024 + lane * 16);
                f32x4 acc[4];
#pragma unroll
                for (int j = 0; j < 4; ++j) acc[j] = (f32x4){0.f, 0.f, 0.f, 0.f};
#pragma unroll
                for (int s = 0; s < 7; ++s)
#pragma unroll
                    for (int j = 0; j < 4; ++j) { const f32x2_t lo = __builtin_amdgcn_cvt_pk_f32_fp8((int)y[s][j], false), hi = __builtin_amdgcn_cvt_pk_f32_fp8((int)y[s][j], true);
                        acc[j][0] += lo[0]; acc[j][1] += lo[1]; acc[j][2] += hi[0]; acc[j][3] += hi[1]; }
                float sm = 0.f;
#pragma unroll
                for (int j = 0; j < 4; ++j) { v[j] = v[j] * ALPHA + acc[j] * (1.0f / YSCALE); sm += (v[j][0] + v[j][1]) + (v[j][2] + v[j][3]); }
                const float mean = wave_sum(sm) * (1.f / DM); float s2 = 0.f;
#pragma unroll
                for (int j = 0; j < 4; ++j) { v[j] = v[j] - mean; s2 += (v[j][0] * v[j][0] + v[j][1] * v[j][1]) + (v[j][2] * v[j][2] + v[j][3] * v[j][3]); }
                const float rstd = 1.0f / sqrtf(wave_sum(s2) * (1.f / DM) + LN_EPS);
#pragma unroll
                for (int j = 0; j < 4; ++j) { v[j] = v[j] * rstd * gv[j] + bv[j]; *(f32x4*)(xo + (size_t)row * DM + lane * 16 + 4 * j) = v[j]; }
                if (PH == 9) { *(u32x4*)(XB + (size_t)row * DM + lane * 16) = pk8(v[0], v[1]); *(u32x4*)(XB + (size_t)row * DM + lane * 16 + 8) = pk8(v[2], v[3]); }
            }
        }
        if constexpr (PH == 9) {
            LAS float* scr = nullptr;
            constexpr int I_IN = (1024 / 64) * (N_IN1 / 64), I_OUT = (1024 / 64) * (1024 / 64);
            for (int it = gw; it < I_IN + I_OUT; it += ngw) {
                int r = it;
                if (r < I_IN) { prep_item((const float*)a.in(26), nullptr, 3088, 1024, nullptr, (bf16_t*)(ws + W_IN), 1024, N_IN1, map_in1, scr, r, lane); continue; } r -= I_IN;
                prep_item((const float*)a.in(28), nullptr, 1024, 1024, nullptr, (bf16_t*)(ws + W_OUT), 1024, 1024, map_ident, scr, r, lane);
            }
            prep_moe(a, 32, scr, gw, ngw, lane, gtid, gthreads);
        }
    }
    else if constexpr (PH == 10) {
        pg8::DenseOrder S; S.init(NTOK, N_IN1, 1024, (const bf16_t*)(ws + W_IN), G, bid);
        EpiIn1 E{(const float*)(ws + WS_TAB + 8192), (bf16_t*)(ws + B_Q1), (bf16_t*)(ws + B_K1), (bf16_t*)(ws + B_V1), (float*)(ws + B_GL), (unsigned*)(ws + WS_CTL + 8192)};
        pg8::gemm_phase(lds, XB, 1024, S, E);
    }
    else if constexpr (PH == 11) {
        const float* GL = (const float*)(ws + B_GL); float* CK = (float*)(ws + B_CK);
        for (int sq = gw; sq < NBATCH * 16; sq += ngw) {
            const int b = sq >> 4, h = sq & 15; float v[64];
            const float* gp = GL + ((size_t)b * SEQ + lane * 64) * 16 + h;
#pragma unroll
            for (int i = 0; i < 64; ++i) v[i] = gp[i * 16];
#pragma unroll
            for (int i = 1; i < 64; ++i) v[i] += v[i - 1];
            const float tot = v[63]; float inc = tot;
#pragma unroll
            for (int o = 1; o < 64; o <<= 1) { const float n = __shfl_up(inc, o); if (lane >= o) inc += n; }
            const float excl = inc - tot;
            float* op = CK + ((size_t)b * 16 + h) * SEQ + lane * 64;
#pragma unroll
            for (int i = 0; i < 16; ++i) { f32x4 o; o[0] = (v[4 * i] + excl) * LOG2E; o[1] = (v[4 * i + 1] + excl) * LOG2E; o[2] = (v[4 * i + 2] + excl) * LOG2E; o[3] = (v[4 * i + 3] + excl) * LOG2E; *(f32x4*)(op + 4 * i) = o; }
        }
    }
    else if constexpr (PH == 12) {
        static_assert(attn_fox::ATTN_LDS_BYTES <= 131072, "attention LDS");
        const attn_fox::AttnTensors AT{(const bf16_t*)(ws + B_Q1), (const bf16_t*)(ws + B_K1), (const bf16_t*)(ws + B_V1), (bf16_t*)(ws + B_O1), (const float*)(ws + B_CK), (const float*)(ws + WS_CTL + 8192)};
        const attn_fox::StaticOrder S(G, bid);
        attn_fox::attn_phase<attn_fox::StaticOrder>((char*)lds, AT, S);
    }
}

constexpr int LDS_BYTES = 147456;
constexpr int CW_BAR = 4096;
constexpr int NPHASE = 19;
template <int PH, int END> struct RunAll {
    static DI void run(const Args& a, LAS unsigned char* lds, const XcdBarrier& bar) {
#ifdef PROBE_REP_PH
        if constexpr (PH == PROBE_REP_PH) { int reps_; asm volatile("s_mov_b32 %0, 2" : "=s"(reps_));
            for (int rep_ = 0; rep_ < reps_; ++rep_) { run_phase<PH>(a, lds); if (rep_ + 1 < reps_) xcd_barrier(bar); } }
        else
#endif
        run_phase<PH>(a, lds);
#ifdef PROBE_MASK
        if constexpr ((PROBE_MASK >> PH) & 1u) { xcd_barrier(bar); run_phase<PH>(a, lds); }
#endif
        if (PH + 1 < END) xcd_barrier(bar);
        RunAll<PH + 1, END>::run(a, lds, bar);
    }
};
template <int END> struct RunAll<END, END> { static DI void run(const Args&, LAS unsigned char*, const XcdBarrier&) {} };

__global__ void __launch_bounds__(512, 2) k_all(KArgs ka) {
    extern __shared__ __attribute__((aligned(16))) unsigned char lds_raw[];
    LAS unsigned char* lds = (LAS unsigned char*)lds_raw;
    Args a; a.tab = (LAS unsigned long long*)(lds + 131072 + 1024); a.out = ka.out; a.ws = ka.ws;
    { const int t_ = threadIdx.x;
#pragma unroll
      for (int k = 0; k < 42; ++k) if (t_ == k) a.tab[k] = (unsigned long long)ka.in[k]; }
    volatile LAS unsigned* st = (volatile LAS unsigned*)(lds + LDS_BYTES - 16);
    if (threadIdx.x == 0) { st[0] = 0u; st[1] = 0u; st[2] = 0u; st[3] = 0u; }
    __syncthreads();
    const XcdBarrier bar = xcd_barrier_post((unsigned*)(a.ws + WS_CTL) + CW_BAR, st);
    RunAll<0, NPHASE>::run(a, lds, bar);
}

extern "C" void kernel_launch(void* const* d_in, const int* in_sizes, int n_in, void* d_out, int out_size, void* d_ws, size_t ws_size, hipStream_t stream) {
    static int grid = 0;
    if (grid == 0) {
        if (n_in != 42 || out_size != NTOK * DM || ws_size < WS_END) { fprintf(stderr, "kernel_launch: unexpected shapes (n_in %d, out %d, ws %zu < %zu)\n", n_in, out_size, ws_size, (size_t)WS_END); grid = -1; return; }
        int dev = 0, cus = 0, per_cu = 0;
        (void)hipGetDevice(&dev); (void)hipDeviceGetAttribute(&cus, hipDeviceAttributeMultiprocessorCount, dev);
        (void)hipFuncSetAttribute((const void*)k_all, hipFuncAttributeMaxDynamicSharedMemorySize, LDS_BYTES);
        if (hipOccupancyMaxActiveBlocksPerMultiprocessor(&per_cu, (const void*)k_all, 512, LDS_BYTES) != hipSuccess || per_cu < 1) { fprintf(stderr, "kernel_launch: occupancy query reports %d blocks per CU\n", per_cu); per_cu = 1; }
        (void)hipGetLastError();
        grid = cus > 0 ? cus : 256;
    }
    if (grid < 0) return;
    (void)hipMemsetAsync((char*)d_ws + WS_CTL, 0, 1 * MiB, stream);
    KArgs a{};
    for (int i = 0; i < 42; ++i) a.in[i] = d_in[i];
    a.out = (float*)d_out; a.ws = (unsigned char*)d_ws;
    hipLaunchKernelGGL(k_all, dim3(grid), dim3(512), LDS_BYTES, stream, a);
}
```
